# Optimizing an MI355X kernel written in HIP

```python
import jax, jax.numpy as jnp
from jax import lax
import numpy as np

D_MODEL = 4096
BATCH = 4
SEQ = 2048
DEPTH = 2
DEC_BATCH = 8
DEC_SEQ = 32
PAST_LEN = 4096

CHUNK = 64
LA_BLOCK = 64
BRANCH_WIDTH = D_MODEL // 2
HG_WIDTH = BRANCH_WIDTH
HG_HEAD_DIM = 128
HG_HEADS = HG_WIDTH // HG_HEAD_DIM
LRU_WIDTH = BRANCH_WIDTH
LRU_BLOCKS = 16
LRU_BLOCK_DIM = LRU_WIDTH // LRU_BLOCKS
CONV_WIDTH = 4
LRU_C = 8.0
GLA_V_WIDTH = BRANCH_WIDTH
GLA_K_WIDTH = GLA_V_WIDTH // 2
GLA_HEADS = 4
GLA_DK = GLA_K_WIDTH // GLA_HEADS
GLA_DV = GLA_V_WIDTH // GLA_HEADS
GLA_RANK = 16
GLA_TAU = 16.0
N_BRANCH = 3
EPS = 1e-6
F_FLOOR = 1e-6
SPLIT_SIZES = (HG_WIDTH, HG_WIDTH, HG_WIDTH, HG_WIDTH,
               LRU_WIDTH, LRU_WIDTH,
               GLA_K_WIDTH, GLA_K_WIDTH, GLA_V_WIDTH, GLA_RANK, GLA_V_WIDTH,
               N_BRANCH * D_MODEL)
IN_COLS = sum(SPLIT_SIZES)
SPLIT_POINTS = tuple(sum(SPLIT_SIZES[:i + 1]) for i in range(len(SPLIT_SIZES) - 1))

kernel_name = "hybrid_hgrn2_rglru_gla_stream_step"

F32 = jnp.float32


def rms_norm(x, w):
    xf = x.astype(F32)
    y = xf * lax.rsqrt(jnp.mean(xf * xf, axis=-1, keepdims=True) + EPS)
    return (y * w.astype(F32)).astype(x.dtype)


def head_rmsnorm_gate(o, w, gate):
    B, T, H, dh = o.shape
    on = o * lax.rsqrt(jnp.mean(o * o, axis=-1, keepdims=True) + EPS)
    return on.reshape(B, T, H * dh) * w.astype(F32) * jax.nn.silu(gate.astype(F32))


def chunked_gated_linear_attention(q, k, v, log_g, s0):
    B, T, H, _ = q.shape
    dv = v.shape[-1]
    n_blk = -(-T // LA_BLOCK)
    pad = n_blk * LA_BLOCK - T

    def prep(a):
        a = jnp.pad(a.astype(F32), ((0, 0), (0, pad), (0, 0), (0, 0)))
        return a.reshape(B, n_blk, LA_BLOCK, H, a.shape[-1]).swapaxes(0, 1)

    qb, kb, vb, gb = prep(q), prep(k), prep(v), prep(log_g)
    causal = jnp.tril(jnp.ones((LA_BLOCK, LA_BLOCK), dtype=bool))[None, :, :, None, None]

    def step(s, blk):
        qc, kc, vc, gc = blk
        b = jnp.cumsum(gc, axis=1)
        diff = b[:, :, None] - b[:, None, :]
        decay = jnp.where(causal, jnp.exp(jnp.where(causal, diff, 0.0)), 0.0)
        attn = jnp.einsum('btshd,bshd->bhts', qc[:, :, None] * decay, kc)
        o = (jnp.einsum('bhts,bshv->bthv', attn, vc)
             + jnp.einsum('bthd,bhdv->bthv', qc * jnp.exp(b), s))
        b_last = b[:, -1]
        s_new = (jnp.exp(b_last)[..., None] * s
                 + jnp.einsum('bshd,bshv->bhdv', kc * jnp.exp(b_last[:, None] - b), vc))
        return s_new, o

    s_fin, ob = lax.scan(step, s0.astype(F32), (qb, kb, vb, gb))
    o = ob.swapaxes(0, 1).reshape(B, n_blk * LA_BLOCK, H, dv)[:, :T]
    return o, s_fin


def hgrn2_branch(q_in, f_in, i_in, s0, lb):
    B, T, _ = q_in.shape
    z = f_in.astype(F32)
    lbf = lb.astype(F32)
    f = lbf + (1.0 - lbf) * jax.nn.sigmoid(z)
    log_f = jnp.log(jnp.maximum(f, F_FLOOR))
    k = 1.0 - f
    q = jax.nn.silu(q_in.astype(F32))

    def heads(a):
        return a.reshape(B, T, HG_HEADS, HG_HEAD_DIM)

    return chunked_gated_linear_attention(heads(q), heads(k), heads(i_in), heads(log_f), s0)


def rglru_branch(xb, conv_state, h0, conv_w, conv_b, wa, ba, wx, bx, lam):
    B, T, W = xb.shape
    xp = jnp.concatenate([conv_state.astype(xb.dtype), xb], axis=1)
    xc = conv_b.astype(F32)
    for j in range(CONV_WIDTH):
        xc = xc + xp[:, j:j + T].astype(F32) * conv_w[j].astype(F32)
    new_conv = xp[:, T:]
    xh = xc.reshape(B, T, LRU_BLOCKS, LRU_BLOCK_DIM)
    r = jax.nn.sigmoid(jnp.einsum('bthi,hij->bthj', xh, wa.astype(F32)).reshape(B, T, W) + ba.astype(F32))
    i = jax.nn.sigmoid(jnp.einsum('bthi,hij->bthj', xh, wx.astype(F32)).reshape(B, T, W) + bx.astype(F32))
    log_a = -LRU_C * r * jax.nn.softplus(-lam.astype(F32))
    a = jnp.exp(log_a)
    u = jnp.sqrt(jnp.maximum(-jnp.expm1(2.0 * log_a), 0.0)) * (i * xc)
    u = u.at[:, 0].add(a[:, 0] * h0.astype(F32))

    def combine(left, right):
        a1, b1 = left
        a2, b2 = right
        return a1 * a2, a2 * b1 + b2

    _, h = lax.associative_scan(combine, (a, u), axis=1)
    return h, new_conv, h[:, -1]


def trunk_layer(x, hg_state, lru_h, lru_conv, gla_state, lb, norm_pre, norm_post, w_in,
                hg_norm, conv_w, conv_b, wa, ba, wx, bx, lam, gla_w2, gla_b2, gla_norm,
                w_branch, w_out):
    B, T, _ = x.shape
    z = rms_norm(x, norm_pre)
    proj = jnp.einsum('btd,dc->btc', z, w_in)
    (hq, hf, hi, hgate, lx, lgate, cq, ck, cv, clr, cgate, mgate) = jnp.split(proj, SPLIT_POINTS, axis=-1)

    oa, new_hg = hgrn2_branch(hq, hf, hi, hg_state, lb)
    ya = head_rmsnorm_gate(oa, hg_norm, hgate)

    hb, new_conv, new_h = rglru_branch(lx, lru_conv, lru_h, conv_w, conv_b, wa, ba, wx, bx, lam)
    yb = hb * jax.nn.silu(lgate.astype(F32))

    gate_logits = jnp.einsum('btr,rk->btk', clr.astype(F32), gla_w2.astype(F32)) + gla_b2.astype(F32)
    log_alpha = jax.nn.log_sigmoid(gate_logits) / GLA_TAU
    qg = cq.astype(F32).reshape(B, T, GLA_HEADS, GLA_DK) * (GLA_DK ** -0.5)
    kg = ck.reshape(B, T, GLA_HEADS, GLA_DK)
    vg = cv.reshape(B, T, GLA_HEADS, GLA_DV)
    oc, new_gla = chunked_gated_linear_attention(qg, kg, vg, log_alpha.reshape(B, T, GLA_HEADS, GLA_DK), gla_state)
    yc = head_rmsnorm_gate(oc, gla_norm, cgate)

    mg = mgate.reshape(B, T, N_BRANCH, D_MODEL)
    merged = jnp.zeros((B, T, D_MODEL), F32)
    for n, yn in enumerate((ya, yb, yc)):
        un = jnp.einsum('btc,cd->btd', yn.astype(x.dtype), w_branch[n]).astype(F32)
        merged = merged + jax.nn.sigmoid(mg[:, :, n].astype(F32)) * un
    out = jnp.einsum('btd,de->bte', merged.astype(x.dtype), w_out)
    y = x + rms_norm(out, norm_post)
    return (y, new_hg.astype(hg_state.dtype), new_h.astype(lru_h.dtype),
            new_conv.astype(lru_conv.dtype), new_gla.astype(gla_state.dtype))


def setup_inputs(seed: int = 0) -> dict:
    key = jax.random.key(seed)
    ks = jax.random.split(key, 24)
    nrm = jax.random.normal
    d = D_MODEL
    a_target = jax.random.uniform(ks[17], (DEPTH, LRU_WIDTH), F32, 0.9, 0.999)
    s = a_target ** (1.0 / LRU_C)
    lru_lambda = jnp.log(s) - jnp.log1p(-s)
    return {
        "x_prompt": nrm(ks[0], (BATCH, SEQ, d), F32),
        "x_sample": nrm(ks[1], (DEC_BATCH, DEC_SEQ, d), F32),
        "state_hgrn": 0.5 * nrm(ks[2], (DEPTH, DEC_BATCH, HG_HEADS, HG_HEAD_DIM, HG_HEAD_DIM), F32),
        "state_lru_h": 0.5 * nrm(ks[3], (DEPTH, DEC_BATCH, LRU_WIDTH), F32),
        "state_lru_conv": nrm(ks[4], (DEPTH, DEC_BATCH, CONV_WIDTH - 1, LRU_WIDTH), F32),
        "state_gla": nrm(ks[5], (DEPTH, DEC_BATCH, GLA_HEADS, GLA_DK, GLA_DV), F32),
        "norm_pre": 1.0 + 0.02 * nrm(ks[6], (DEPTH, d), F32),
        "norm_post": 1.0 + 0.02 * nrm(ks[7], (DEPTH, d), F32),
        "w_in": nrm(ks[8], (DEPTH, d, IN_COLS), F32) * d ** -0.5,
        "hg_lb_logits": 0.1 * nrm(ks[9], (DEPTH, HG_WIDTH), F32),
        "hg_norm": 1.0 + 0.02 * nrm(ks[10], (DEPTH, HG_WIDTH), F32),
        "lru_conv_w": nrm(ks[11], (DEPTH, CONV_WIDTH, LRU_WIDTH), F32) * CONV_WIDTH ** -0.5,
        "lru_conv_b": 0.01 * nrm(ks[12], (DEPTH, LRU_WIDTH), F32),
        "lru_wa": nrm(ks[13], (DEPTH, LRU_BLOCKS, LRU_BLOCK_DIM, LRU_BLOCK_DIM), F32) * LRU_BLOCK_DIM ** -0.5,
        "lru_ba": 0.01 * nrm(ks[14], (DEPTH, LRU_WIDTH), F32),
        "lru_wx": nrm(ks[15], (DEPTH, LRU_BLOCKS, LRU_BLOCK_DIM, LRU_BLOCK_DIM), F32) * LRU_BLOCK_DIM ** -0.5,
        "lru_bx": 0.01 * nrm(ks[16], (DEPTH, LRU_WIDTH), F32),
        "lru_lambda": lru_lambda,
        "gla_w2": nrm(ks[18], (DEPTH, GLA_RANK, GLA_K_WIDTH), F32) * GLA_RANK ** -0.5,
        "gla_b2": 0.01 * nrm(ks[19], (DEPTH, GLA_K_WIDTH), F32),
        "gla_norm": 1.0 + 0.02 * nrm(ks[20], (DEPTH, GLA_V_WIDTH), F32),
        "w_branch": nrm(ks[21], (DEPTH, N_BRANCH, BRANCH_WIDTH, d), F32) * BRANCH_WIDTH ** -0.5,
        "w_out": nrm(ks[22], (DEPTH, d, d), F32) * d ** -0.5,
    }


def reference(x_prompt, x_sample, state_hgrn, state_lru_h, state_lru_conv, state_gla,
              norm_pre, norm_post, w_in, hg_lb_logits, hg_norm, lru_conv_w, lru_conv_b,
              lru_wa, lru_ba, lru_wx, lru_bx, lru_lambda, gla_w2, gla_b2, gla_norm,
              w_branch, w_out):
    lb_sm = jax.nn.softmax(hg_lb_logits.astype(F32), axis=0)
    lb_all = jnp.cumsum(lb_sm, axis=0) - lb_sm[0:1]

    dt = x_prompt.dtype
    hp = jnp.zeros((BATCH, HG_HEADS, HG_HEAD_DIM, HG_HEAD_DIM), dt)
    lhp = jnp.zeros((BATCH, LRU_WIDTH), dt)
    lcp = jnp.zeros((BATCH, CONV_WIDTH - 1, LRU_WIDTH), dt)
    gp = jnp.zeros((BATCH, GLA_HEADS, GLA_DK, GLA_DV), dt)

    yp, ys = x_prompt, x_sample
    hg_p, hg_s, lh_p, lh_s, lc_p, lc_s, gl_p, gl_s = [], [], [], [], [], [], [], []
    for l in range(DEPTH):
        lp = (lb_all[l], norm_pre[l], norm_post[l], w_in[l], hg_norm[l], lru_conv_w[l],
              lru_conv_b[l], lru_wa[l], lru_ba[l], lru_wx[l], lru_bx[l], lru_lambda[l],
              gla_w2[l], gla_b2[l], gla_norm[l], w_branch[l], w_out[l])
        yp, a1, a2, a3, a4 = trunk_layer(yp, hp, lhp, lcp, gp, *lp)
        hg_p.append(a1); lh_p.append(a2); lc_p.append(a3); gl_p.append(a4)
        ys, b1, b2, b3, b4 = trunk_layer(ys, state_hgrn[l], state_lru_h[l], state_lru_conv[l], state_gla[l], *lp)
        hg_s.append(b1); lh_s.append(b2); lc_s.append(b3); gl_s.append(b4)

    new_hgrn_p = jnp.stack(hg_p)
    new_hgrn_s = jnp.stack(hg_s)
    new_lru_h_p = jnp.stack(lh_p)
    new_lru_h_s = jnp.stack(lh_s)
    new_lru_conv_p = jnp.stack(lc_p)
    new_lru_conv_s = jnp.stack(lc_s)
    new_gla_p = jnp.stack(gl_p)
    new_gla_s = jnp.stack(gl_s)
    return (yp, ys, new_hgrn_p, new_hgrn_s, new_lru_h_p, new_lru_h_s,
            new_lru_conv_p, new_lru_conv_s, new_gla_p, new_gla_s)
```

```cpp
#include <hip/hip_runtime.h>
#include <cstdio>
#include <cstdint>
#define N_LAUNCH_MODE 1
#ifndef PG8_WGM
#define PG8_WGM 8
#endif
namespace pg8 {
#define PG8_LAS __attribute__((address_space(3)))
typedef unsigned short bf16_t;
typedef short bf16x8 __attribute__((ext_vector_type(8)));
typedef float f32x4 __attribute__((ext_vector_type(4)));
typedef unsigned u32x4 __attribute__((ext_vector_type(4)));
typedef int i32x4 __attribute__((ext_vector_type(4)));
typedef int i32x8 __attribute__((ext_vector_type(8)));
constexpr int BM = 256, BK = 64, HALF = 128, HTB = HALF * BK * 2  , STAGE_BYTES = 8 * HTB, NXCD = 8, WGM = PG8_WGM;

__host__ __device__ __forceinline__ int lds_byte(int r, int c) { const int st = (r >> 4) * 2 + (c >> 5), rr = r & 15, cc = c & 31, ob = rr * 64 + cc * 2; return st * 1024 + (ob ^ (((ob >> 9) & 1) << 5)); }
__host__ __device__ __forceinline__ void stage_rc(int b, int& R, int& C) { const int st = b / 1024, sb = b % 1024, swz = sb ^ (((sb >> 9) & 1) << 5); R = (st >> 1) * 16 + swz / 64; C = (st & 1) * 32 + (swz % 64) / 2; }
__host__ __device__ __forceinline__ int perm32(int rho) { const int n = rho >> 4, i = rho & 15; return 8 * (i >> 2) + 4 * n + (i & 3); }

struct Unit { int pm, pn, ko; };
struct Gemm { const bf16_t* A; const bf16_t* Bt; int M, N, K, lda, ldb; };

struct StaticOrder {
    int nM, nN, nwg, G, c;
    __host__ __device__ __forceinline__ void init(int M, int N, int G_, int c_) { nM = M / BM; nN = N / BM; nwg = nM * nN; G = G_; c = c_; }
    __host__ __device__ __forceinline__ bool next(int i, Unit& u) const {
        const long L = (long)i * G + c; if (L >= nwg) return false;
        int wgid = (int)L; { const int q = nwg / NXCD, r = nwg % NXCD, xcd = wgid % NXCD, off = wgid / NXCD; wgid = (xcd < r ? xcd * (q + 1) : r * (q + 1) + (xcd - r) * q) + off; }
        const int nig = WGM * nN, gid = wgid / nig, fm = gid * WGM, w_ = wgid - gid * nig, rem = (nM % WGM) ? (nM % WGM) : 1;
        if ((nM - fm) < WGM) { u.pm = fm + (w_ % rem); u.pn = w_ / rem; } else { u.pm = fm + (w_ % WGM); u.pn = w_ / WGM; }
        u.ko = 0; return true;
    }
    __device__ __forceinline__ void a_ready(const Unit&) const {}
    __device__ __forceinline__ void done(const Unit&) const {}
    __device__ __forceinline__ bool zero_after(const Unit&) const { return true; }
};

template <class Epi, class Sched, bool ALIGN_EPI = false, bool SP2 = false, bool F8 = false>
__device__ __forceinline__ void gemm_phase(PG8_LAS unsigned char* lds, const Gemm g, const Sched& S, const Epi& E, f32x4 (&acc)[2][2][4][2]) {
    int tid_ = threadIdx.x; asm volatile("" : "+v"(tid_));
    const int tid = tid_, wid = __builtin_amdgcn_readfirstlane(tid >> 6), lane = tid & 63, wr = wid >> 2, wc = wid & 3, fr = lane & 15, fq = lane >> 4;
    const int K = g.K, nt = K / BK;
    unsigned voffA[2], voffB[2];
#pragma unroll
    for (int i = 0; i < 2; ++i) { int R, C; stage_rc(tid * 16 + i * 8192, R, C); const int Rb = Epi::PERM ? ((R & ~31) + perm32(R & 31)) : R;
        voffA[i] = (unsigned)(R * g.lda + C) * 2u; voffB[i] = (unsigned)(Rb * g.ldb + C) * 2u; }
    const size_t kstep = (size_t)(BK * 2);
    const size_t hstepA = (size_t)HALF * g.lda * 2, hstepB = (size_t)HALF * g.ldb * 2;
    const size_t tstepA = 2 * hstepA, tstepB = 2 * hstepB;
    const unsigned ldsw = (unsigned)wid * 1024u;
    const int aoff = lds_byte(wr * 64 + fr, fq * 8), boff = lds_byte(wc * 32 + fr, fq * 8);
#define PG8_SA(b, h) (((b) * 2 + (h)) * HTB)
#define PG8_SB(b, h) ((4 + (b) * 2 + (h)) * HTB)
#define PG8_STAGE(bufoff, gbase, voff) do { _Pragma("unroll") for (int _i = 0; _i < 2; ++_i) \
        __builtin_amdgcn_global_load_lds((const unsigned*)((const char*)(gbase) + (voff)[_i]), (PG8_LAS unsigned*)(lds + (bufoff) + ldsw + _i * 8192), 16, 0, 0); } while (0)
#define PG8_LDA(dst, b, h) do { if constexpr (F8) { _Pragma("unroll") for (int m = 0; m < 4; ++m) dst##8[m] = __builtin_shufflevector(*(const PG8_LAS i32x4*)(lds + PG8_SA(b, h) + aoff + m * 2048), *(const PG8_LAS i32x4*)(lds + PG8_SA(b, h) + aoff + m * 2048 + 1024), 0, 1, 2, 3, 4, 5, 6, 7); } \
        else { _Pragma("unroll") for (int m = 0; m < 4; ++m) _Pragma("unroll") for (int k = 0; k < 2; ++k) dst[m][k] = *(const PG8_LAS bf16x8*)(lds + PG8_SA(b, h) + aoff + m * 2048 + k * 1024); } } while (0)
#define PG8_LDB(dst, b, h) do { if constexpr (F8) { _Pragma("unroll") for (int n = 0; n < 2; ++n) dst##8[n] = __builtin_shufflevector(*(const PG8_LAS i32x4*)(lds + PG8_SB(b, h) + boff + n * 2048), *(const PG8_LAS i32x4*)(lds + PG8_SB(b, h) + boff + n * 2048 + 1024), 0, 1, 2, 3, 4, 5, 6, 7); } \
        else { _Pragma("unroll") for (int n = 0; n < 2; ++n) _Pragma("unroll") for (int k = 0; k < 2; ++k) dst[n][k] = *(const PG8_LAS bf16x8*)(lds + PG8_SB(b, h) + boff + n * 2048 + k * 1024); } } while (0)
#define PG8_CAT8(x0, x1) __builtin_shufflevector(__builtin_bit_cast(i32x4, (x0)), __builtin_bit_cast(i32x4, (x1)), 0, 1, 2, 3, 4, 5, 6, 7)
#define PG8_MMA(ai, bj, At, Bt) do { __builtin_amdgcn_s_setprio(1); \
        if constexpr (F8) { _Pragma("unroll") for (int m = 0; m < 4; ++m) _Pragma("unroll") for (int n = 0; n < 2; ++n) \
            asm volatile("v_mfma_f32_16x16x128_f8f6f4 %0, %1, %2, %0" : "+v"(acc[ai][bj][m][n]) : "v"(Bt##8[n]), "v"(At##8[m])); }   \
        else { _Pragma("unroll") for (int m = 0; m < 4; ++m) _Pragma("unroll") for (int n = 0; n < 2; ++n) _Pragma("unroll") for (int k = 0; k < 2; ++k) \
            acc[ai][bj][m][n] = __builtin_amdgcn_mfma_f32_16x16x32_bf16(Bt[n][k], At[m][k], acc[ai][bj][m][n], 0, 0, 0); } \
        __builtin_amdgcn_s_setprio(0); } while (0)
#define PG8_WAIT_V(n) asm volatile("s_waitcnt vmcnt(" #n ")" ::: "memory")
#define PG8_WAIT_L(n) asm volatile("s_waitcnt lgkmcnt(" #n ")" ::: "memory")
#define PG8_BAR __builtin_amdgcn_s_barrier()
#define PG8_SCHED __builtin_amdgcn_sched_barrier(0)
    Unit cur, nxt; int ui = 0;
    if (!S.next(0, cur)) return;
    bf16x8 At[4][2], B0[2][2], B1[2][2];
    i32x8 At8[4], B08[2], B18[2];
    const char* cA = (const char*)g.A + (size_t)cur.pm * tstepA + (size_t)cur.ko * 2; const char* cB = (const char*)g.Bt + (size_t)cur.pn * tstepB + (size_t)cur.ko * 2;
    S.a_ready(cur);
    if constexpr (SP2) {
        PG8_STAGE(PG8_SB(0, 0), cB, voffB); PG8_STAGE(PG8_SB(0, 1), cB + hstepB, voffB); PG8_STAGE(PG8_SA(0, 0), cA, voffA); PG8_STAGE(PG8_SA(0, 1), cA + hstepA, voffA);
        if (wr == 1) PG8_BAR;
        PG8_WAIT_V(2); PG8_BAR;
        PG8_STAGE(PG8_SB(1, 0), cB + kstep, voffB); PG8_STAGE(PG8_SA(1, 0), cA + kstep, voffA); PG8_STAGE(PG8_SB(1, 1), cB + hstepB + kstep, voffB);
        PG8_WAIT_V(6); PG8_BAR;
    } else {
        PG8_STAGE(PG8_SB(0, 0), cB, voffB); PG8_STAGE(PG8_SA(0, 0), cA, voffA); PG8_STAGE(PG8_SB(0, 1), cB + hstepB, voffB); PG8_STAGE(PG8_SA(0, 1), cA + hstepA, voffA);
        if (wr == 1) PG8_BAR;
        PG8_WAIT_V(4); PG8_BAR;
        PG8_STAGE(PG8_SB(1, 0), cB + kstep, voffB); PG8_STAGE(PG8_SA(1, 0), cA + kstep, voffA); PG8_STAGE(PG8_SB(1, 1), cB + hstepB + kstep, voffB);
        PG8_WAIT_V(6); PG8_BAR;
    }
    for (;;) {
        const bool has_next = S.next(ui + 1, nxt);
        const char* nA = has_next ? (const char*)g.A + (size_t)nxt.pm * tstepA + (size_t)nxt.ko * 2 : cA; const char* nB = has_next ? (const char*)g.Bt + (size_t)nxt.pn * tstepB + (size_t)nxt.ko * 2 : cB;
        for (int t = 0; t < nt; t += 2) {
            const bool last = (t == nt - 2);
            const char* a1 = cA + (size_t)(t + 1) * kstep;
            const char* a2 = last ? nA : cA + (size_t)(t + 2) * kstep; const char* b2 = last ? nB : cB + (size_t)(t + 2) * kstep;
            const char* a3 = a2 + kstep; const char* b3 = b2 + kstep;
            if (last && has_next) S.a_ready(nxt);
            if constexpr (SP2) {
            PG8_LDB(B0, 0, 0); PG8_LDB(B1, 0, 1); PG8_SCHED; PG8_LDA(At, 0, 0); PG8_STAGE(PG8_SA(1, 1), a1 + hstepA, voffA);
            PG8_WAIT_V(8); PG8_WAIT_L(0); PG8_BAR; PG8_MMA(0, 0, At, B0); PG8_MMA(0, 1, At, B1); PG8_BAR; PG8_SCHED;
            PG8_LDA(At, 0, 1); PG8_STAGE(PG8_SB(0, 0), b2, voffB); PG8_STAGE(PG8_SB(0, 1), b2 + hstepB, voffB); PG8_STAGE(PG8_SA(0, 0), a2, voffA);
            PG8_WAIT_V(8); PG8_WAIT_L(0); PG8_BAR; PG8_MMA(1, 0, At, B0); PG8_MMA(1, 1, At, B1); PG8_BAR; PG8_SCHED;
            PG8_LDB(B0, 1, 0); PG8_LDB(B1, 1, 1); PG8_SCHED; PG8_LDA(At, 1, 0); PG8_STAGE(PG8_SA(0, 1), a2 + hstepA, voffA);
            PG8_WAIT_V(8); PG8_WAIT_L(0); PG8_BAR; PG8_MMA(0, 0, At, B0); PG8_MMA(0, 1, At, B1); PG8_BAR; PG8_SCHED;
            PG8_LDA(At, 1, 1); PG8_STAGE(PG8_SB(1, 0), b3, voffB); PG8_STAGE(PG8_SB(1, 1), b3 + hstepB, voffB); PG8_STAGE(PG8_SA(1, 0), a3, voffA);
            PG8_WAIT_V(8); PG8_WAIT_L(0); PG8_BAR; PG8_MMA(1, 0, At, B0); PG8_MMA(1, 1, At, B1); PG8_BAR; PG8_SCHED;
            } else {
            PG8_LDB(B0, 0, 0); PG8_SCHED; PG8_LDA(At, 0, 0); PG8_STAGE(PG8_SA(1, 1), a1 + hstepA, voffA);
            PG8_WAIT_L(8); PG8_BAR; PG8_WAIT_L(0); PG8_MMA(0, 0, At, B0); PG8_BAR; PG8_SCHED;
            PG8_LDB(B1, 0, 1); PG8_STAGE(PG8_SB(0, 0), b2, voffB);
            PG8_BAR; PG8_WAIT_L(0); PG8_MMA(0, 1, At, B1); PG8_BAR;
            PG8_LDA(At, 0, 1); PG8_STAGE(PG8_SA(0, 0), a2, voffA);
            PG8_BAR; PG8_WAIT_L(0); PG8_MMA(1, 0, At, B0); PG8_BAR; PG8_SCHED;
            PG8_STAGE(PG8_SB(0, 1), b2 + hstepB, voffB);
            PG8_WAIT_V(6); PG8_BAR; PG8_MMA(1, 1, At, B1); PG8_BAR;
            PG8_LDB(B0, 1, 0); PG8_SCHED; PG8_LDA(At, 1, 0); PG8_STAGE(PG8_SA(0, 1), a2 + hstepA, voffA);
            PG8_WAIT_L(8); PG8_BAR; PG8_WAIT_L(0); PG8_MMA(0, 0, At, B0); PG8_BAR; PG8_SCHED;
            PG8_LDB(B1, 1, 1); PG8_STAGE(PG8_SB(1, 0), b3, voffB);
            PG8_BAR; PG8_WAIT_L(0); PG8_MMA(0, 1, At, B1); PG8_BAR;
            PG8_LDA(At, 1, 1); PG8_STAGE(PG8_SA(1, 0), a3, voffA);
            PG8_BAR; PG8_WAIT_L(0); PG8_MMA(1, 0, At, B0); PG8_BAR; PG8_SCHED;
            PG8_STAGE(PG8_SB(1, 1), b3 + hstepB, voffB);
            PG8_WAIT_V(6); PG8_BAR; PG8_MMA(1, 1, At, B1); PG8_BAR;
            }
        }
        if constexpr (ALIGN_EPI) { if (wr == 0) PG8_BAR; }
        if constexpr (F8) {
            asm volatile("s_nop 15\n\ts_nop 15\n\ts_nop 7" : "+v"(acc[0][0][0][0]), "+v"(acc[0][0][0][1]), "+v"(acc[0][0][1][0]), "+v"(acc[0][0][1][1]), "+v"(acc[0][0][2][0]), "+v"(acc[0][0][2][1]), "+v"(acc[0][0][3][0]), "+v"(acc[0][0][3][1]), "+v"(acc[0][1][0][0]), "+v"(acc[0][1][0][1]), "+v"(acc[0][1][1][0]), "+v"(acc[0][1][1][1]), "+v"(acc[0][1][2][0]), "+v"(acc[0][1][2][1]), "+v"(acc[0][1][3][0]), "+v"(acc[0][1][3][1]));
            asm volatile("" : "+v"(acc[1][0][0][0]), "+v"(acc[1][0][0][1]), "+v"(acc[1][0][1][0]), "+v"(acc[1][0][1][1]), "+v"(acc[1][0][2][0]), "+v"(acc[1][0][2][1]), "+v"(acc[1][0][3][0]), "+v"(acc[1][0][3][1]), "+v"(acc[1][1][0][0]), "+v"(acc[1][1][0][1]), "+v"(acc[1][1][1][0]), "+v"(acc[1][1][1][1]), "+v"(acc[1][1][2][0]), "+v"(acc[1][1][2][1]), "+v"(acc[1][1][3][0]), "+v"(acc[1][1][3][1])); }
        if constexpr (!Epi::AFTER_DRAIN) { E(acc, cur, wr, wc, fr, fq); S.done(cur); }
        if (!has_next) break;
        if (S.zero_after(cur)) {
#pragma unroll
        for (int a = 0; a < 2; ++a)
#pragma unroll
            for (int b = 0; b < 2; ++b)
#pragma unroll
                for (int m = 0; m < 4; ++m)
#pragma unroll
                    for (int n = 0; n < 2; ++n) acc[a][b][m][n] = (f32x4){0.f, 0.f, 0.f, 0.f};
        }
        cur = nxt; cA = nA; cB = nB; ++ui;
        if constexpr (ALIGN_EPI) { if (wr == 1) PG8_BAR; }
    }
    PG8_WAIT_V(0);
    if constexpr (!ALIGN_EPI) { if (wr == 0) PG8_BAR; }
    PG8_BAR;
    if constexpr (Epi::AFTER_DRAIN) { E.fused(acc, cur, wr, wc, fr, fq, lds, wid, lane); S.done(cur); }
#undef PG8_SA
#undef PG8_SB
#undef PG8_STAGE
#undef PG8_LDA
#undef PG8_LDB
#undef PG8_MMA
#undef PG8_CAT8
#undef PG8_WAIT_V
#undef PG8_WAIT_L
#undef PG8_BAR
#undef PG8_SCHED
}
}
#ifndef REP_IN
#define REP_IN 1
#endif
#ifndef REP_BR
#define REP_BR 1
#endif
#ifndef REP_OUT
#define REP_OUT 1
#endif
#ifndef REP_FIN
#define REP_FIN 1
#endif
#ifndef GEMM_STREAM
#define GEMM_STREAM 3
#endif
#ifndef REP_J0
#define REP_J0 1
#endif
#ifndef REP_J1
#define REP_J1 1
#endif
#ifndef REP_J2
#define REP_J2 1
#endif
#ifndef REP_SCAN
#define REP_SCAN 1
#endif
#ifndef REP_P0
#define REP_P0 1
#endif
#ifndef SEG0
#define SEG0 0
#endif
#ifndef GATELESS
#define GATELESS 1
#endif
#ifndef GEMM_ONEUNIT
#define GEMM_ONEUNIT 1
#endif
#ifndef DIAGSEL
#define DIAGSEL 4095
#endif
#ifndef NO_T4
#define NO_T4 0
#endif
#ifndef NO_T5
#define NO_T5 0
#endif
#ifndef NO_T6
#define NO_T6 0
#endif
#ifndef DIAG_SIMPLE
#define DIAG_SIMPLE 0
#endif
#ifndef GEMM_ALIGN
#define GEMM_ALIGN true
#endif
#ifndef GEMM_SP2
#define GEMM_SP2 true
#endif
#ifndef PHM
#define PHM 127
#endif
#ifndef JOBM
#define JOBM 7
#endif

#define GAS __attribute__((address_space(1)))
#define LAS __attribute__((address_space(3)))
typedef unsigned short bf16;
typedef short bf16x8 __attribute__((ext_vector_type(8)));
typedef short bf16x4 __attribute__((ext_vector_type(4)));
typedef float f32x4 __attribute__((ext_vector_type(4)));
typedef unsigned u32x4 __attribute__((ext_vector_type(4)));
typedef unsigned u32x2 __attribute__((ext_vector_type(2)));
#define DI __device__ __forceinline__
#define LDS_WAIT() asm volatile("s_waitcnt lgkmcnt(0)" ::: "memory")
typedef float f32x2_t __attribute__((ext_vector_type(2)));
typedef __bf16 bf16x2_t __attribute__((ext_vector_type(2)));
DI unsigned pk2(float lo, float hi) { const f32x2_t v = {lo, hi}; const bf16x2_t b = __builtin_convertvector(v, bf16x2_t); return __builtin_bit_cast(unsigned, b); }
DI unsigned pk4f8(float a, float b, float c, float d) { int w = 0; w = __builtin_amdgcn_cvt_pk_fp8_f32(a, b, w, false); w = __builtin_amdgcn_cvt_pk_fp8_f32(c, d, w, true); return (unsigned)w; }
DI unsigned pk4u8(float a, float b, float c, float d) { unsigned w = 0u; w = __builtin_amdgcn_cvt_pk_u8_f32(a, 0, w); w = __builtin_amdgcn_cvt_pk_u8_f32(b, 1, w); w = __builtin_amdgcn_cvt_pk_u8_f32(c, 2, w); w = __builtin_amdgcn_cvt_pk_u8_f32(d, 3, w); return w; }
DI float ub0(unsigned w) { return (float)(w & 0xffu); }
DI float ub1(unsigned w) { return (float)((w >> 8) & 0xffu); }
DI float ub2(unsigned w) { return (float)((w >> 16) & 0xffu); }
DI float ub3(unsigned w) { return (float)(w >> 24); }
DI bf16 f2bf(float f) { return (bf16)(pk2(f, 0.f) & 0xffffu); }
DI float bf2f(unsigned b) { return __uint_as_float(b << 16); }
DI float bflo(unsigned w) { return __uint_as_float(w << 16); }
DI float bfhi(unsigned w) { return __uint_as_float(w & 0xffff0000u); }
DI float sigmoidf_(float x) { return __builtin_amdgcn_rcpf(1.0f + __expf(-x)); }
DI float siluf_(float x) { return x * sigmoidf_(x); }
DI float wave_sum(float v) {
#pragma unroll
    for (int o = 1; o < 64; o <<= 1) v += __shfl_xor(v, o);
    return v;
}
#define MFMA16(a, b, c) __builtin_amdgcn_mfma_f32_16x16x32_bf16((a), (b), (c), 0, 0, 0)

constexpr int DM = 4096, MP = 8192, MS_ = 256, MT = 8448;
constexpr int BW = 2048;
constexpr int NIN = 30976;
constexpr int KBR = 6144;
constexpr float EPS = 1e-6f;
constexpr int NWAVES = 8, NTHR = 512;
constexpr int LDS_BYTES = 147456;
constexpr int MISC_OFF = LDS_BYTES - 256;

constexpr size_t O_YP = 0, O_YS = 33554432, O_HGP = 34603008, O_HGS = 36700160, O_LHP = 40894464, O_LHS = 40910848,
                 O_LCP = 40943616, O_LCS = 40992768, O_GLP = 41091072, O_GLS = 45285376, O_END = 53673984;

constexpr size_t MiB = 1u << 20;
constexpr size_t alup(size_t x) { return (x + MiB - 1) / MiB * MiB; }
constexpr size_t WS_CTL = 0, CTL_ZERO_BYTES = MiB;
constexpr size_t SZ_WIN = alup((size_t)NIN * DM * 2), SZ_WBR = alup((size_t)DM * KBR * 2), SZ_WOU = alup((size_t)DM * DM * 2);
constexpr size_t WS_WIN = MiB, WS_WBR = WS_WIN + 2 * SZ_WIN, WS_WOU = WS_WBR + 2 * SZ_WBR;
constexpr size_t WS_Z = WS_WOU + 2 * SZ_WOU;
constexpr size_t WS_HQ = WS_Z + alup((size_t)MT * DM * 2);
constexpr size_t WS_HG = WS_HQ + alup((size_t)MT * BW * 2);
constexpr size_t WS_HV = WS_HG + alup((size_t)MT * BW * 4);
constexpr size_t WS_HGATE = WS_HV + alup((size_t)MT * BW * 2);
constexpr size_t WS_LX = WS_HGATE + alup((size_t)MT * BW * 2);
constexpr size_t WS_LGATE = WS_LX + alup((size_t)MT * BW * 4);
constexpr size_t WS_CQ = WS_LGATE + alup((size_t)MT * BW * 2);
constexpr size_t WS_CK = WS_CQ + alup((size_t)MT * 1024 * 2);
constexpr size_t WS_CV = WS_CK + alup((size_t)MT * 1024 * 2);
constexpr size_t WS_CGATE = WS_CV + alup((size_t)MT * BW * 2);
constexpr size_t WS_MG = WS_CGATE + alup((size_t)MT * BW * 2);
constexpr size_t WS_CLR = WS_MG + alup((size_t)MT * 12288 * 2);
constexpr size_t WS_Y = WS_CLR + alup((size_t)MT * 16 * 4);
constexpr size_t WS_OC = WS_Y + alup((size_t)MT * KBR * 2);
constexpr size_t WS_SSQ = WS_OC + alup((size_t)MT * 2 * BW * 4);
constexpr size_t WS_MERGED = WS_SSQ + alup((size_t)MT * 32 * 4);
constexpr size_t WS_MB = WS_MERGED + alup((size_t)MT * DM * 4);
constexpr size_t WS_OUT = WS_MB + alup((size_t)MT * DM * 2);
constexpr size_t WS_X1 = WS_OUT + alup((size_t)MT * DM * 4);
constexpr size_t WS_PB = WS_X1 + alup((size_t)MT * DM * 4);
constexpr size_t WS_PO = WS_PB + alup((size_t)3 * 256 * DM * 4);
constexpr int NCHK = 136;
constexpr size_t WS_GQT = WS_PO + alup((size_t)4 * 256 * DM * 4);
constexpr size_t WS_GKT = WS_GQT + alup((size_t)MT * 1024 * 2);
constexpr size_t WS_GKH = WS_GKT + alup((size_t)MT * 1024 * 2);
constexpr size_t WS_GER = WS_GKH + alup((size_t)NCHK * 1024 * 64 * 2);
constexpr size_t WS_GEB = WS_GER + alup((size_t)NCHK * 1024 * 4);
constexpr size_t WS_Z8 = WS_GEB + alup((size_t)NCHK * 1024 * 4);
constexpr size_t SZ_W8 = alup((size_t)12288 * DM);
constexpr size_t WS_W8 = WS_Z8 + alup((size_t)MT * DM);
constexpr size_t WS_END = WS_W8 + 2 * SZ_W8;
constexpr int CW_BAR = 4096;
constexpr int CW_TEAM = 16384;

#define XB_TMO      128
#define XB_XCNT(j)  (256  + 64 * (j))
#define XB_XSUB(j)  (1280 + 64 * (j))
#define XB_XGEN(j)  (2304 + 64 * (j))
#define XB_TOP      3328
#define XB_TOPGEN   3392
#define XCD_BAR_WORDS 3456
#define XB_SPIN_CAP (1u << 18)
__device__ __forceinline__ unsigned xb_ld(unsigned* p)              { return __hip_atomic_load(p, __ATOMIC_RELAXED, __HIP_MEMORY_SCOPE_AGENT); }
__device__ __forceinline__ unsigned xb_add(unsigned* p, unsigned v) { return __hip_atomic_fetch_add(p, v, __ATOMIC_RELAXED, __HIP_MEMORY_SCOPE_AGENT); }
__device__ __forceinline__ unsigned xb_xcc_id() { return (unsigned)__builtin_amdgcn_s_getreg((3 << 11) | 20) & 0xFu; }
#define XB_SPIN(cond, bar) do { unsigned _sp = 0; while (cond) { __builtin_amdgcn_s_sleep(1); \
    if ((++_sp & 255u) == 0u) { if (xb_ld(&(bar)[XB_TMO])) break; if (_sp > XB_SPIN_CAP) { atomicAdd(&(bar)[XB_TMO], 1u); break; } } } } while (0)
struct XcdBarrier { unsigned* bar; unsigned x; volatile LAS unsigned* st; };
__device__ __forceinline__ XcdBarrier xcd_barrier_post(unsigned* bar, volatile LAS unsigned* st) {
    XcdBarrier b; b.bar = bar; b.x = xb_xcc_id(); b.st = st;
    if (threadIdx.x == 0) (void)xb_add(&bar[XB_XCNT(b.x)], 1u);
    return b;
}
__device__ __forceinline__ void xcd_barrier_complete(unsigned* bar, unsigned x, unsigned& nloc, unsigned& nx) {
    const unsigned G = gridDim.x * gridDim.y * gridDim.z;
    unsigned sum, cnt, mine, sp = 0u;
    for (;;) {
        sum = 0u; cnt = 0u; mine = 0u;
#pragma unroll
        for (unsigned j = 0; j < 16; ++j) { const unsigned c = xb_ld(&bar[XB_XCNT(j)]); sum += c; cnt += (c > 0u) ? 1u : 0u; mine = (j == x) ? c : mine; }
        if (sum == G) break;
        __builtin_amdgcn_s_sleep(1);
        if ((++sp & 255u) == 0u) { if (xb_ld(&bar[XB_TMO])) break; if (sp > XB_SPIN_CAP) { atomicAdd(&bar[XB_TMO], 1u); break; } }
    }
    nloc = mine > 0u ? mine : 1u; nx = cnt > 0u ? cnt : 1u;
}
__device__ __forceinline__ void xcd_barrier(const XcdBarrier& b) {
    asm volatile("s_waitcnt vmcnt(0)" ::: "memory");
    __syncthreads();
    if (threadIdx.x == 0) {
        unsigned* bar = b.bar;
        __builtin_amdgcn_s_waitcnt(0);
        unsigned nloc = b.st[0], nx = b.st[1];
        if (nloc == 0u) { xcd_barrier_complete(bar, b.x, nloc, nx); b.st[0] = nloc; b.st[1] = nx; }
        const unsigned old = xb_add(&bar[XB_XSUB(b.x)], 1u);
        const unsigned gen = old / nloc;
        if (old + 1u == (gen + 1u) * nloc) {
            __builtin_amdgcn_fence(__ATOMIC_RELEASE, "agent");
            asm volatile("s_waitcnt vmcnt(0)" ::: "memory");
            const unsigned og = xb_add(&bar[XB_TOP], 1u);
            const unsigned tg = og / nx;
            if (og + 1u == (tg + 1u) * nx) xb_add(&bar[XB_TOPGEN], 1u);
            else XB_SPIN(xb_ld(&bar[XB_TOPGEN]) == tg, bar);
            __builtin_amdgcn_fence(__ATOMIC_ACQUIRE, "agent");
            xb_add(&bar[XB_XGEN(b.x)], 1u);
            asm volatile("s_waitcnt vmcnt(0)" ::: "memory");
        } else {
            XB_SPIN(xb_ld(&bar[XB_XGEN(b.x)]) == gen, bar);
            __builtin_amdgcn_fence(__ATOMIC_ACQUIRE, "agent");
            asm volatile("s_waitcnt vmcnt(0)" ::: "memory");
        }
    }
    __syncthreads();
}

typedef pg8::f32x4 af4;
struct EpiInProj {
    static constexpr bool PERM = true, AFTER_DRAIN = true;
    DI void fused(af4 (&acc)[2][2][4][2], const pg8::Unit& u, int wr, int wc, int fr, int fq, LAS unsigned char*, int, int) const { (*this)(acc, u, wr, wc, fr, fq); }
    bf16 *HQ, *HV, *HGATE, *LGATE, *CQ, *CK, *CV, *CGATE; unsigned char* MG; float *HG, *LX, *CLR; const float* lbl; int layer; float mgs;
    template <int T> DI void body(const af4 (&acc)[2][2][4][2], void* base, const int ld, const int row0, const int col0) const {
        af4 lbv[2][2];
        if (T == 5) {
#pragma unroll
            for (int bj = 0; bj < 2; ++bj)
#pragma unroll
                for (int hh = 0; hh < 2; ++hh) { const af4 a0 = *(const af4*)(lbl + col0 + bj * 128 + 4 * hh), a1 = *(const af4*)(lbl + BW + col0 + bj * 128 + 4 * hh);
#pragma unroll
                    for (int j = 0; j < 4; ++j) { const float mx = fmaxf(a0[j], a1[j]); const float e0 = __expf(a0[j] - mx), e1 = __expf(a1[j] - mx); lbv[bj][hh][j] = layer ? e1 / (e0 + e1) : 0.f; } }
        }
        if (T == 2) {
            int c0 = col0; asm volatile("" : "+v"(c0)); const int odd = (c0 >> 3) & 1;
#pragma unroll
            for (int ai = 0; ai < 2; ++ai)
#pragma unroll
                for (int mp = 0; mp < 2; ++mp)
#pragma unroll
                    for (int bj = 0; bj < 2; ++bj) {
                        unsigned px[2], py[2];
#pragma unroll
                        for (int h = 0; h < 2; ++h) { af4 v0 = acc[ai][bj][2 * mp + h][0], v1 = acc[ai][bj][2 * mp + h][1];
#pragma unroll
                            for (int j = 0; j < 4; ++j) { v0[j] = fmaxf(sigmoidf_(v0[j] * mgs) * 255.0f + 0.5f, 1.0f); v1[j] = fmaxf(sigmoidf_(v1[j] * mgs) * 255.0f + 0.5f, 1.0f); }
                            px[h] = pk4u8(v0[0], v0[1], v0[2], v0[3]); py[h] = pk4u8(v1[0], v1[1], v1[2], v1[3]); __builtin_amdgcn_sched_barrier(0); }
                        const auto rx = __builtin_amdgcn_permlane16_swap(px[0], px[1], false, false); const auto ry = __builtin_amdgcn_permlane16_swap(py[0], py[1], false, false);
                        u32x4 o; o.x = rx[0]; o.y = ry[0]; o.z = rx[1]; o.w = ry[1];
                        *(u32x4*)((unsigned char*)base + (size_t)(row0 + ai * 128 + (2 * mp + odd) * 16) * ld + (c0 - 8 * odd) + bj * 128) = o;
                    }
            return;
        }
#pragma unroll
        for (int ai = 0; ai < 2; ++ai)
#pragma unroll
            for (int m = 0; m < 4; ++m) {
                const size_t rowoff = (size_t)(row0 + ai * 128 + m * 16) * ld;
#pragma unroll
                for (int bj = 0; bj < 2; ++bj) {
                    af4 v0 = acc[ai][bj][m][0], v1 = acc[ai][bj][m][1];
                    const int col = col0 + bj * 128;
                    if (T <= 3) {
#pragma unroll
                        for (int j = 0; j < 4; ++j) {
                            if (T == 1) { v0[j] = siluf_(v0[j]); v1[j] = siluf_(v1[j]); }
                            if (T == 2) { v0[j] = sigmoidf_(v0[j] * mgs); v1[j] = sigmoidf_(v1[j] * mgs); }
                            if (T == 3) { v0[j] *= 0.0625f; v1[j] *= 0.0625f; }
                        }
                        if (T == 2) {
#pragma unroll
                            for (int j = 0; j < 4; ++j) { v0[j] = fmaxf(v0[j] * 255.0f + 0.5f, 1.0f); v1[j] = fmaxf(v1[j] * 255.0f + 0.5f, 1.0f); }
                            u32x2 o; o.x = pk4u8(v0[0], v0[1], v0[2], v0[3]); o.y = pk4u8(v1[0], v1[1], v1[2], v1[3]);
                            *(u32x2*)((unsigned char*)base + rowoff + col) = o;
                        } else {
                        u32x4 o; o.x = pk2(v0[0], v0[1]); o.y = pk2(v0[2], v0[3]); o.z = pk2(v1[0], v1[1]); o.w = pk2(v1[2], v1[3]);
                        *(u32x4*)((bf16*)base + rowoff + col) = o; }
                    } else if (T == 4) {
                        float* p = (float*)base + rowoff + col; *(af4*)p = v0; *(af4*)(p + 4) = v1;
                    } else if (T == 5) {
#pragma unroll
                        for (int j = 0; j < 4; ++j) {
                            const float l0 = lbv[bj][0][j], l1 = lbv[bj][1][j];
                            v0[j] = __logf(fmaxf(l0 + (1.0f - l0) * sigmoidf_(v0[j]), 1e-6f));
                            v1[j] = __logf(fmaxf(l1 + (1.0f - l1) * sigmoidf_(v1[j]), 1e-6f));
                        }
                        float* p = (float*)base + rowoff + col; *(af4*)p = v0; *(af4*)(p + 4) = v1;
                    } else {
                        if (col < 16) { float* p = (float*)base + rowoff + col; *(af4*)p = v0; *(af4*)(p + 4) = v1; }
                    }
                }
            }
    }
    DI void operator()(const af4 (&acc)[2][2][4][2], const pg8::Unit& u, int wr, int wc, int fr, int fq) const {
        const int row0 = u.pm * 256 + wr * 64 + fr, cl = wc * 32 + 8 * fq, pn = u.pn;
        if (pn < 8)        body<1>(acc, HQ, BW, row0, pn * 256 + cl);
        else if (pn < 16)  body<(NO_T5 ? (NO_T4 ? 0 : 4) : 5)>(acc, HG, BW, row0, (pn - 8) * 256 + cl);
        else if (pn < 24)  body<0>(acc, HV, BW, row0, (pn - 16) * 256 + cl);
        else if (pn < 32)  body<1>(acc, HGATE, BW, row0, (pn - 24) * 256 + cl);
        else if (pn < 40)  body<(NO_T4 ? 0 : 4)>(acc, LX, BW, row0, (pn - 32) * 256 + cl);
        else if (pn < 48)  body<1>(acc, LGATE, BW, row0, (pn - 40) * 256 + cl);
        else if (pn < 52)  body<3>(acc, CQ, 1024, row0, (pn - 48) * 256 + cl);
        else if (pn < 56)  body<0>(acc, CK, 1024, row0, (pn - 52) * 256 + cl);
        else if (pn < 64)  body<0>(acc, CV, BW, row0, (pn - 56) * 256 + cl);
        else if (pn < 72)  body<1>(acc, CGATE, BW, row0, (pn - 64) * 256 + cl);
        else if (pn < 120) body<2>(acc, MG, 12288, row0, (pn - 72) * 256 + cl);
        else               { if (!NO_T6) body<6>(acc, CLR, 16, row0, cl); }
    }
};
struct EpiBranchSeg {
    static constexpr bool PERM = true, AFTER_DRAIN = true;
    const unsigned char* MG; bf16* MB; int seg;
    DI void operator()(af4 (&acc)[2][2][4][2], const pg8::Unit& u, int wr, int wc, int fr, int fq) const { const EpiBranchSeg E2{MG, MB, u.ko / BW}; E2.fused(acc, u, wr, wc, fr, fq, nullptr, 0, 0); }
    DI void fused(af4 (&acc)[2][2][4][2], const pg8::Unit& u, int wr, int wc, int fr, int fq, LAS unsigned char*, int, int) const {
        int fqz = fq; asm volatile("" : "+v"(fqz));
        const int odd = fqz & 1;
        const size_t row0 = (size_t)(u.pm * 256 + wr * 64 + fr); const int col0 = u.pn * 256 + wc * 32 + 8 * fqz;
        const unsigned char* gp = MG + (row0 + 16 * odd) * 12288 + (size_t)seg * DM + (col0 - 8 * odd);
#define EB_PTR(p_) (gp + (size_t)((((p_) >> 2) & 1) * 128 + (((p_) >> 1) & 1) * 32) * 12288 + ((p_) & 1) * 128)
#define EB_SPLIT(L_, G0_, G1_) do { const auto rx_ = __builtin_amdgcn_permlane16_swap((L_).x, (L_).z, false, false); const auto ry_ = __builtin_amdgcn_permlane16_swap((L_).y, (L_).w, false, false); \
            G0_.x = rx_[0]; G0_.y = ry_[0]; G1_.x = rx_[1]; G1_.y = ry_[1]; } while (0)
        if (seg < 2) {
            u32x4 a0 = *(const u32x4*)EB_PTR(0), b0 = *(const u32x4*)(EB_PTR(0) + DM), a1 = *(const u32x4*)EB_PTR(1), b1 = *(const u32x4*)(EB_PTR(1) + DM);
#pragma unroll
            for (int p = 0; p < 8; ++p) {
                u32x4 a2 = a1, b2 = b1;
                if (p + 2 < 8) { a2 = *(const u32x4*)EB_PTR(p + 2); b2 = *(const u32x4*)(EB_PTR(p + 2) + DM); }
                u32x2 ga[2], gb[2]; EB_SPLIT(a0, ga[0], ga[1]); EB_SPLIT(b0, gb[0], gb[1]);
#pragma unroll
                for (int h = 0; h < 2; ++h) {
                    af4& v0 = acc[(p >> 2) & 1][p & 1][((p >> 1) & 1) * 2 + h][0]; af4& v1 = acc[(p >> 2) & 1][p & 1][((p >> 1) & 1) * 2 + h][1];
                    v0[0] *= ub0(ga[h].x) * __builtin_amdgcn_rcpf(ub0(gb[h].x)); v0[1] *= ub1(ga[h].x) * __builtin_amdgcn_rcpf(ub1(gb[h].x));
                    v0[2] *= ub2(ga[h].x) * __builtin_amdgcn_rcpf(ub2(gb[h].x)); v0[3] *= ub3(ga[h].x) * __builtin_amdgcn_rcpf(ub3(gb[h].x));
                    v1[0] *= ub0(ga[h].y) * __builtin_amdgcn_rcpf(ub0(gb[h].y)); v1[1] *= ub1(ga[h].y) * __builtin_amdgcn_rcpf(ub1(gb[h].y));
                    v1[2] *= ub2(ga[h].y) * __builtin_amdgcn_rcpf(ub2(gb[h].y)); v1[3] *= ub3(ga[h].y) * __builtin_amdgcn_rcpf(ub3(gb[h].y));
                    asm volatile("" : "+v"(v0), "+v"(v1) :: "memory");
                }
                asm volatile("" : "+v"(a1), "+v"(b1), "+v"(a2), "+v"(b2) :: "memory");
                a0 = a1; b0 = b1; a1 = a2; b1 = b2;
            }
        } else {
            constexpr float Q = 1.0f / 255.0f;
            u32x4 a0 = *(const u32x4*)EB_PTR(0), a1 = *(const u32x4*)EB_PTR(1);
#pragma unroll
            for (int p = 0; p < 8; ++p) {
                u32x4 a2 = a1;
                if (p + 2 < 8) a2 = *(const u32x4*)EB_PTR(p + 2);
                u32x2 gw[2]; EB_SPLIT(a0, gw[0], gw[1]);
#pragma unroll
                for (int h = 0; h < 2; ++h) {
                    const int m = ((p >> 1) & 1) * 2 + h; const size_t ro = (size_t)(((p >> 2) & 1) * 128 + m * 16);
                    af4 v0 = acc[(p >> 2) & 1][p & 1][m][0], v1 = acc[(p >> 2) & 1][p & 1][m][1];
                    v0[0] *= ub0(gw[h].x) * Q; v0[1] *= ub1(gw[h].x) * Q; v0[2] *= ub2(gw[h].x) * Q; v0[3] *= ub3(gw[h].x) * Q;
                    v1[0] *= ub0(gw[h].y) * Q; v1[1] *= ub1(gw[h].y) * Q; v1[2] *= ub2(gw[h].y) * Q; v1[3] *= ub3(gw[h].y) * Q;
                    u32x4 o; o.x = pk2(v0[0], v0[1]); o.y = pk2(v0[2], v0[3]); o.z = pk2(v1[0], v1[1]); o.w = pk2(v1[2], v1[3]);
                    *(u32x4*)(MB + (row0 + ro) * DM + col0 + (p & 1) * 128) = o;
                }
                asm volatile("" : "+v"(a1), "+v"(a2) :: "memory");
                a0 = a1; a1 = a2;
            }
        }
#undef EB_SPLIT
#undef EB_PTR
    }
};
struct EpiGateSlab {
    static constexpr bool PERM = true, AFTER_DRAIN = true;
    const unsigned char* MG; float* PB; int seg;
    DI void fused(af4 (&acc)[2][2][4][2], const pg8::Unit& u, int wr, int wc, int fr, int fq, LAS unsigned char*, int, int) const {
        const size_t row0 = (size_t)(u.pm * 256 + wr * 64 + fr); const int col0 = u.pn * 256 + wc * 32 + 8 * fq;
        const unsigned char* gp = MG + row0 * 12288 + (size_t)seg * DM + col0;
        float* pb = PB + ((size_t)seg * 256 + (size_t)(wr * 64 + fr)) * DM + col0;
#pragma unroll
        for (int ai = 0; ai < 2; ++ai)
#pragma unroll
            for (int m = 0; m < 4; ++m) {
#pragma unroll
                for (int bj = 0; bj < 2; ++bj) {
                    const size_t ro = (size_t)(ai * 128 + m * 16);
                    const u32x2 gw = *(const u32x2*)(gp + ro * 12288 + bj * 128); constexpr float Q = 1.0f / 255.0f;
                    af4 v0 = acc[ai][bj][m][0], v1 = acc[ai][bj][m][1];
                    v0[0] *= ub0(gw.x) * Q; v0[1] *= ub1(gw.x) * Q; v0[2] *= ub2(gw.x) * Q; v0[3] *= ub3(gw.x) * Q;
                    v1[0] *= ub0(gw.y) * Q; v1[1] *= ub1(gw.y) * Q; v1[2] *= ub2(gw.y) * Q; v1[3] *= ub3(gw.y) * Q;
                    float* q = pb + ro * DM + bj * 128; *(af4*)q = v0; *(af4*)(q + 4) = v1;
                    asm volatile("" ::: "memory");
                }
            }
    }
};
struct EpiSimple {
    static constexpr bool PERM = true, AFTER_DRAIN = true;
    DI void fused(af4 (&acc)[2][2][4][2], const pg8::Unit& u, int wr, int wc, int fr, int fq, LAS unsigned char*, int, int) const { (*this)(acc, u, wr, wc, fr, fq); }
    bf16* O; int ldc;
    DI void operator()(const af4 (&acc)[2][2][4][2], const pg8::Unit& u, int wr, int wc, int fr, int fq) const {
        const int row0 = u.pm * 256 + wr * 64 + fr, col0 = u.pn * 256 + wc * 32 + 8 * fq;
#pragma unroll
        for (int ai = 0; ai < 2; ++ai)
#pragma unroll
            for (int m = 0; m < 4; ++m) {
                bf16* rp = O + (size_t)(row0 + ai * 128 + m * 16) * ldc + col0;
#pragma unroll
                for (int bj = 0; bj < 2; ++bj) { af4 v0 = acc[ai][bj][m][0], v1 = acc[ai][bj][m][1];
#pragma unroll
                    for (int j = 0; j < 4; ++j) { v0[j] = siluf_(v0[j]); v1[j] = siluf_(v1[j]); }
                    u32x4 o; o.x = pk2(v0[0], v0[1]); o.y = pk2(v0[2], v0[3]); o.z = pk2(v1[0], v1[1]); o.w = pk2(v1[2], v1[3]); *(u32x4*)(rp + bj * 128) = o; }
            }
    }
};
struct EpiBf {
    static constexpr bool PERM = true, AFTER_DRAIN = true;
    DI void fused(af4 (&acc)[2][2][4][2], const pg8::Unit& u, int wr, int wc, int fr, int fq, LAS unsigned char*, int, int) const { (*this)(acc, u, wr, wc, fr, fq); }
    bf16* O; int ldc;
    DI void operator()(const af4 (&acc)[2][2][4][2], const pg8::Unit& u, int wr, int wc, int fr, int fq) const {
        const int row0 = u.pm * 256 + wr * 64 + fr, col0 = u.pn * 256 + wc * 32 + 8 * fq;
#pragma unroll
        for (int ai = 0; ai < 2; ++ai)
#pragma unroll
            for (int m = 0; m < 4; ++m) {
                bf16* rp = O + (size_t)(row0 + ai * 128 + m * 16) * ldc + col0;
#pragma unroll
                for (int bj = 0; bj < 2; ++bj) { const af4 v0 = acc[ai][bj][m][0], v1 = acc[ai][bj][m][1];
                    u32x4 o; o.x = pk2(v0[0], v0[1]); o.y = pk2(v0[2], v0[3]); o.z = pk2(v1[0], v1[1]); o.w = pk2(v1[2], v1[3]); *(u32x4*)(rp + bj * 128) = o; }
            }
    }
};
struct EpiF32 {
    static constexpr bool PERM = true, AFTER_DRAIN = true;
    DI void fused(af4 (&acc)[2][2][4][2], const pg8::Unit& u, int wr, int wc, int fr, int fq, LAS unsigned char*, int, int) const { (*this)(acc, u, wr, wc, fr, fq); }
    float* C; int ldc;
    DI void operator()(const af4 (&acc)[2][2][4][2], const pg8::Unit& u, int wr, int wc, int fr, int fq) const {
        const int row0 = u.pm * 256 + wr * 64 + fr, col0 = u.pn * 256 + wc * 32 + 8 * fq;
#pragma unroll
        for (int ai = 0; ai < 2; ++ai)
#pragma unroll
            for (int m = 0; m < 4; ++m) {
                float* rp = C + (size_t)(row0 + ai * 128 + m * 16) * ldc + col0;
#pragma unroll
                for (int bj = 0; bj < 2; ++bj) { *(af4*)(rp + bj * 128) = acc[ai][bj][m][0]; *(af4*)(rp + bj * 128 + 4) = acc[ai][bj][m][1]; }
            }
    }
};

struct OneUnit {
    pg8::StaticOrder S; int i;
    DI bool next(int k, pg8::Unit& u) const { return k == 0 ? S.next(i, u) : false; }
    DI void a_ready(const pg8::Unit&) const {}
    DI void done(const pg8::Unit&) const {}
    DI bool zero_after(const pg8::Unit&) const { return true; }
};
struct InOrderA {
    pg8::StaticOrder S;
    DI bool next(int i, pg8::Unit& u) const { if (!S.next(i, u)) return false; if (u.pn == 72) u.pn = 120; return true; }
    DI void a_ready(const pg8::Unit&) const {}
    DI void done(const pg8::Unit&) const {}
    DI bool zero_after(const pg8::Unit&) const { return true; }
};
struct InOrder8 {
    pg8::StaticOrder S;
    DI bool next(int i, pg8::Unit& u) const { if (!S.next(i, u)) return false; u.pn += 72; return true; }
    DI void a_ready(const pg8::Unit&) const {}
    DI void done(const pg8::Unit&) const {}
    DI bool zero_after(const pg8::Unit&) const { return true; }
};
struct BranchOrder {
    pg8::StaticOrder S;
    DI bool next(int i, pg8::Unit& u) const { const int t = i / 3; if (!S.next(t, u)) return false; u.ko = (i - 3 * t) * BW; return true; }
    DI void a_ready(const pg8::Unit&) const {}
    DI void done(const pg8::Unit&) const {}
    DI bool zero_after(const pg8::Unit& u) const { return u.ko == 2 * BW; }
};
struct FixedUnit {
    pg8::Unit u0;
    DI bool next(int k, pg8::Unit& u) const { u = u0; return k == 0; }
    DI void a_ready(const pg8::Unit&) const {}
    DI void done(const pg8::Unit&) const {}
    DI bool zero_after(const pg8::Unit&) const { return true; }
};
DI void team_barrier(unsigned* cnt, unsigned n) {
    asm volatile("s_waitcnt vmcnt(0)" ::: "memory");
    __syncthreads();
    if (threadIdx.x == 0) {
        __builtin_amdgcn_fence(__ATOMIC_RELEASE, "agent");
        asm volatile("s_waitcnt vmcnt(0)" ::: "memory");
        (void)xb_add(cnt, 1u);
        unsigned sp = 0u;
        while (xb_ld(cnt) < n) { __builtin_amdgcn_s_sleep(2); if (++sp > (1u << 20)) break; }
        __builtin_amdgcn_fence(__ATOMIC_ACQUIRE, "agent");
        asm volatile("s_waitcnt vmcnt(0)" ::: "memory");
    }
    __syncthreads();
}
DI void team_arrive(unsigned* cnt) {
    asm volatile("s_waitcnt vmcnt(0)" ::: "memory");
    __syncthreads();
    if (threadIdx.x == 0) { __builtin_amdgcn_fence(__ATOMIC_RELEASE, "agent"); asm volatile("s_waitcnt vmcnt(0)" ::: "memory"); (void)xb_add(cnt, 1u); }
}
DI void zero_acc(af4 (&acc)[2][2][4][2]) {
#pragma unroll
    for (int a = 0; a < 2; ++a)
#pragma unroll
        for (int b = 0; b < 2; ++b)
#pragma unroll
            for (int mm = 0; mm < 4; ++mm)
#pragma unroll
                for (int n = 0; n < 2; ++n) acc[a][b][mm][n] = (af4){0.f, 0.f, 0.f, 0.f};
}
template <class E> struct NoDrain : E { static constexpr bool AFTER_DRAIN = false; };
template <class Epi> DI void gemm_stream(LAS unsigned char* lds, const pg8::Gemm& g, const pg8::StaticOrder& S, const Epi& E) {
    af4 acc[2][2][4][2]; zero_acc(acc); const NoDrain<Epi> E2{E};
    pg8::gemm_phase<NoDrain<Epi>, pg8::StaticOrder, GEMM_ALIGN, GEMM_SP2>(lds, g, S, E2, acc);
}
template <class Epi> DI void gemm_units(LAS unsigned char* lds, const pg8::Gemm& g, const pg8::StaticOrder& S, const Epi& E) {
    pg8::Unit u;
    for (int i = 0; S.next(i, u); ++i) { af4 acc[2][2][4][2]; zero_acc(acc); OneUnit O{S, i}; pg8::gemm_phase<Epi, OneUnit, false, GEMM_SP2>(lds, g, O, E, acc); }
}
DI int win_src_col(int n) { return n < 16384 ? n : (n < 30720 ? n + 16 : (n < 30736 ? n - 30720 + 16384 : -1)); }
template <bool WIN> DI void tr_item(LAS unsigned char* lds, const float* W, int ldsrc, bf16* WT, size_t ldd, int k0, int n0, int dcol0, int lane) {
    const int n = n0 + 2 * lane;
    const int sc = WIN ? win_src_col(n) : n;
    const unsigned so = (unsigned)(sc >= 0 ? sc : 0);
    f32x2_t v[64];
#pragma unroll
    for (int i = 0; i < 64; ++i) { const float* rowp = W + (size_t)(k0 + i) * ldsrc; v[i] = *(const f32x2_t*)(rowp + so); }
    if (sc < 0) {
#pragma unroll
        for (int i = 0; i < 64; ++i) v[i] = (f32x2_t){0.f, 0.f};
    }
    LAS unsigned char* slab = lds + __builtin_amdgcn_readfirstlane((int)(threadIdx.x >> 6)) * 16384;
    LAS u32x4* w0 = (LAS u32x4*)(slab + lane * 256);
#pragma unroll
    for (int j = 0; j < 8; ++j) { u32x4 o; o.x = pk2(v[8 * j].x, v[8 * j + 1].x); o.y = pk2(v[8 * j + 2].x, v[8 * j + 3].x); o.z = pk2(v[8 * j + 4].x, v[8 * j + 5].x); o.w = pk2(v[8 * j + 6].x, v[8 * j + 7].x); w0[j] = o; }
#pragma unroll
    for (int j = 0; j < 8; ++j) { u32x4 o; o.x = pk2(v[8 * j].y, v[8 * j + 1].y); o.y = pk2(v[8 * j + 2].y, v[8 * j + 3].y); o.z = pk2(v[8 * j + 4].y, v[8 * j + 5].y); o.w = pk2(v[8 * j + 6].y, v[8 * j + 7].y); w0[8 + j] = o; }
    bf16* dst = WT + (size_t)(n0 + (lane >> 3)) * ldd + dcol0 + k0 + (lane & 7) * 8;
#pragma unroll
    for (int s_ = 0; s_ < 16; ++s_) { const u32x4 o = *(const LAS u32x4*)(slab + s_ * 1024 + lane * 16); *(u32x4*)(dst + (size_t)(8 * s_) * ldd) = o; }
}
DI void tr_item8(LAS unsigned char* lds, const float* W, int ldsrc, unsigned char* W8, int k0, int nl0, int lane) {
    const unsigned so = (unsigned)(18448 + nl0 + lane);
    float v[128];
#pragma unroll
    for (int i = 0; i < 128; ++i) { const float* rowp = W + (size_t)(k0 + i) * ldsrc; v[i] = rowp[so]; }
    LAS unsigned char* slab = lds + __builtin_amdgcn_readfirstlane((int)(threadIdx.x >> 6)) * 16384;
    LAS u32x4* w0 = (LAS u32x4*)(slab + lane * 128);
#pragma unroll
    for (int j = 0; j < 8; ++j) { u32x4 o; o.x = pk4f8(v[16 * j] * 64.f, v[16 * j + 1] * 64.f, v[16 * j + 2] * 64.f, v[16 * j + 3] * 64.f); o.y = pk4f8(v[16 * j + 4] * 64.f, v[16 * j + 5] * 64.f, v[16 * j + 6] * 64.f, v[16 * j + 7] * 64.f);
        o.z = pk4f8(v[16 * j + 8] * 64.f, v[16 * j + 9] * 64.f, v[16 * j + 10] * 64.f, v[16 * j + 11] * 64.f); o.w = pk4f8(v[16 * j + 12] * 64.f, v[16 * j + 13] * 64.f, v[16 * j + 14] * 64.f, v[16 * j + 15] * 64.f); w0[j] = o; }
    unsigned char* dst = W8 + (size_t)(nl0 + (lane >> 3)) * DM + k0 + (lane & 7) * 16;
#pragma unroll
    for (int s_ = 0; s_ < 8; ++s_) { const u32x4 o = *(const LAS u32x4*)(slab + s_ * 1024 + lane * 16); *(u32x4*)(dst + (size_t)(8 * s_) * DM) = o; }
}
constexpr int CV_INB = 64 * 146, CV_IN8 = 32 * 192, CV_IN = CV_INB + CV_IN8, CV_BR = 3 * 32 * 32, CV_OU = 64 * 32, CV_L = CV_IN + CV_BR + CV_OU;
#ifndef CVX_ITEMS
#define CVX_ITEMS 5000
#endif
constexpr int CVX = CVX_ITEMS;
DI void convert_items(LAS unsigned char* lds, const float* w_in, const float* w_branch, const float* w_out, unsigned char* ws, int l, int it0, int it1, int gw, int NGW, int lane) {
    for (int it = it0 + gw; it < it1; it += NGW) {
        int r = it;
        if (r < CV_INB) { const int kb = r / 146, nb = r % 146; const int n0 = nb < 144 ? nb * 128 : 30720 + (nb - 144) * 128;
            tr_item<true>(lds, w_in + (size_t)l * DM * 30736, 30736, (bf16*)(ws + WS_WIN + l * SZ_WIN), DM, kb * 64, n0, 0, lane); continue; }
        r -= CV_INB;
        if (r < CV_IN8) { const int kb = r / 192, nb = r % 192;
            tr_item8(lds, w_in + (size_t)l * DM * 30736, 30736, ws + WS_W8 + l * SZ_W8, kb * 128, nb * 64, lane); continue; }
        r -= CV_IN8;
        if (r < CV_BR) { const int n = r / (32 * 32), rr = r % (32 * 32), kb = rr / 32, nb = rr % 32;
            tr_item<false>(lds, w_branch + ((size_t)l * 3 + n) * BW * DM, DM, (bf16*)(ws + WS_WBR + l * SZ_WBR), KBR, kb * 64, nb * 128, n * BW, lane); continue; }
        r -= CV_BR;
        { const int kb = r / 32, nb = r % 32;
            tr_item<false>(lds, w_out + (size_t)l * DM * DM, DM, (bf16*)(ws + WS_WOU + l * SZ_WOU), DM, kb * 64, nb * 128, 0, lane); }
    }
}
DI void tail_convert(LAS unsigned char* lds, const float* w_in, const float* w_branch, const float* w_out, unsigned char* ws, int l, int it0, int it1, int nunits, int G, int bx, int wave, int lane_in) {
    int lane = lane_in; asm volatile("" : "+v"(lane));
    const int rounds = (nunits + G - 1) / G, busy = nunits - (rounds - 1) * G, idle = G - busy;
    if (idle > 0) { if (bx >= busy) convert_items(lds, w_in, w_branch, w_out, ws, l, it0, it1, (bx - busy) * NWAVES + wave, idle * NWAVES, lane); }
    else convert_items(lds, w_in, w_branch, w_out, ws, l, it0, it1, bx * NWAVES + wave, G * NWAVES, lane);
}
DI void norm_rows(const float* xp, const float* xs, const float* nw, bf16* Z, unsigned char* Z8, int gw, int NGW, int lane) {
    asm volatile("" : "+v"(lane), "+s"(gw));
    for (int m = gw; m < MT; m += NGW) {
        const f32x4* xr = (const f32x4*)(m < MP ? xp + (size_t)m * DM : xs + (size_t)(m - MP) * DM) + lane;
        f32x4 v[16]; float s = 0.f;
#pragma unroll
        for (int j = 0; j < 16; ++j) { v[j] = xr[64 * j]; s += (v[j].x * v[j].x + v[j].y * v[j].y) + (v[j].z * v[j].z + v[j].w * v[j].w); }
        const float rstd = 1.0f / sqrtf(wave_sum(s) * (1.0f / DM) + EPS);
        u32x2* o8 = (u32x2*)(Z + (size_t)m * DM) + lane; unsigned* q8 = (unsigned*)(Z8 + (size_t)m * DM) + lane;
#pragma unroll
        for (int j = 0; j < 16; ++j) { const f32x4 w4 = ((const f32x4*)nw)[lane + 64 * j]; const float z0 = v[j].x * rstd * w4.x, z1 = v[j].y * rstd * w4.y, z2 = v[j].z * rstd * w4.z, z3 = v[j].w * rstd * w4.w;
            u32x2 o; o.x = pk2(z0, z1); o.y = pk2(z2, z3); o8[64 * j] = o; q8[64 * j] = pk4f8(z0, z1, z2, z3); }
    }
}
DI void sum_slabs_rows(const float* PB, bf16* MB, int gw, int NGW, int lane) {
    asm volatile("" : "+v"(lane), "+s"(gw));
    for (int r = gw; r < 256; r += NGW) {
        const f32x4* a = (const f32x4*)(PB + (size_t)r * DM) + lane; const f32x4* b = a + (size_t)256 * DM / 4; const f32x4* c = b + (size_t)256 * DM / 4;
        u32x2* o8 = (u32x2*)(MB + (size_t)(MP + r) * DM) + lane;
#pragma unroll
        for (int j = 0; j < 16; ++j) { const f32x4 v = (a[64 * j] + b[64 * j]) + c[64 * j]; u32x2 o; o.x = pk2(v.x, v.y); o.y = pk2(v.z, v.w); o8[64 * j] = o; }
    }
}
template <bool XB, bool YB> DI void final_rows(const void* xp_, const void* xs_, const bf16* OUT, const float* PO, const float* npost, void* ydst_, const float* npre_next, bf16* Z, unsigned char* Z8, int gw, int NGW, int lane) {
    asm volatile("" : "+v"(lane), "+s"(gw));
    for (int m = gw; m < MT; m += NGW) {
        const f32x4* xr = (const f32x4*)(m < MP ? (const float*)xp_ + (size_t)m * DM : (const float*)xs_ + (size_t)(m - MP) * DM) + lane;
        const u32x2* xrb = (const u32x2*)(m < MP ? (const bf16*)xp_ + (size_t)m * DM : (const bf16*)xs_ + (size_t)(m - MP) * DM) + lane;
        f32x4 v[16]; float s = 0.f;
        if (PO && m >= MP) { const f32x4* p0 = (const f32x4*)(PO + (size_t)(m - MP) * DM) + lane; const f32x4* p1 = p0 + (size_t)256 * DM / 4; const f32x4* p2 = p1 + (size_t)256 * DM / 4; const f32x4* p3 = p2 + (size_t)256 * DM / 4;
#pragma unroll
            for (int j = 0; j < 16; ++j) v[j] = (p0[64 * j] + p1[64 * j]) + (p2[64 * j] + p3[64 * j]); }
        else { const u32x2* orow = (const u32x2*)(OUT + (size_t)m * DM) + lane;
#pragma unroll
            for (int j = 0; j < 16; ++j) { const u32x2 ov = orow[64 * j]; v[j] = (f32x4){bflo(ov.x), bfhi(ov.x), bflo(ov.y), bfhi(ov.y)}; } }
#pragma unroll
        for (int j = 0; j < 16; ++j) s += (v[j].x * v[j].x + v[j].y * v[j].y) + (v[j].z * v[j].z + v[j].w * v[j].w);
        const float rstd = 1.0f / sqrtf(wave_sum(s) * (1.0f / DM) + EPS);
        f32x4* yo = (f32x4*)((float*)ydst_ + (size_t)m * DM) + lane; u32x2* yob = (u32x2*)((bf16*)ydst_ + (size_t)m * DM) + lane; float s2 = 0.f;
#pragma unroll
        for (int j = 0; j < 16; ++j) { const f32x4 w4 = ((const f32x4*)npost)[lane + 64 * j]; f32x4 x4;
            if constexpr (XB) { const u32x2 xb = xrb[64 * j]; x4 = (f32x4){bflo(xb.x), bfhi(xb.x), bflo(xb.y), bfhi(xb.y)}; } else x4 = xr[64 * j];
            v[j] = x4 + v[j] * rstd * w4;
            if constexpr (YB) { u32x2 yb; yb.x = pk2(v[j].x, v[j].y); yb.y = pk2(v[j].z, v[j].w); yob[64 * j] = yb; } else yo[64 * j] = v[j];
            s2 += (v[j].x * v[j].x + v[j].y * v[j].y) + (v[j].z * v[j].z + v[j].w * v[j].w); }
        if (Z) {
            const float r2 = 1.0f / sqrtf(wave_sum(s2) * (1.0f / DM) + EPS);
            u32x2* o8 = (u32x2*)(Z + (size_t)m * DM) + lane; unsigned* q8 = (unsigned*)(Z8 + (size_t)m * DM) + lane;
#pragma unroll
            for (int j = 0; j < 16; ++j) { const f32x4 w4 = ((const f32x4*)npre_next)[lane + 64 * j]; const float z0 = v[j].x * r2 * w4.x, z1 = v[j].y * r2 * w4.y, z2 = v[j].z * r2 * w4.z, z3 = v[j].w * r2 * w4.w;
                u32x2 o; o.x = pk2(z0, z1); o.y = pk2(z2, z3); o8[64 * j] = o; q8[64 * j] = pk4f8(z0, z1, z2, z3); }
        }
    }
}
DI void mix_fix_rows(const bf16* OA, const float* SSQ, const float* hnw, const bf16* HGATE, const float* gnw, const bf16* CGATE, bf16* Y, int m0, int m1, int gw, int NGW, int lane) {
    asm volatile("" : "+v"(lane), "+s"(gw));
    for (int m = m0 + gw; m < m1; m += NGW) {
        const f32x4* sq = (const f32x4*)(SSQ + (size_t)m * 32);
        float rs[4];
#pragma unroll
        for (int h = 0; h < 4; ++h) { const f32x4 s = sq[4 + h]; rs[h] = 1.0f / sqrtf(((s.x + s.y) + (s.z + s.w)) * (1.0f / 512.0f) + EPS); }
#pragma unroll
        for (int j = 0; j < 8; ++j) { const int col = 4 * (lane + 64 * j);
            const u32x2 ob = *(const u32x2*)(OA + (size_t)m * (2 * BW) + BW + col); const f32x4 o = (f32x4){bflo(ob.x), bfhi(ob.x), bflo(ob.y), bfhi(ob.y)}, w4 = *(const f32x4*)(gnw + col); const u32x2 g = *(const u32x2*)(CGATE + (size_t)m * BW + col);
            const float r = rs[j >> 1]; u32x2 y; y.x = pk2(o.x * r * w4.x * bflo(g.x), o.y * r * w4.y * bfhi(g.x)); y.y = pk2(o.z * r * w4.z * bflo(g.y), o.w * r * w4.w * bfhi(g.y));
            *(u32x2*)(Y + (size_t)m * KBR + 2 * BW + col) = y; }
    }
}
DI void gl_rows(const float* CLR, const float* w2, const float* b2, float* GL, int bx, int G, int tid_in) {
    int tid = tid_in; asm volatile("" : "+v"(tid));
    float wa[16], wb[16];
#pragma unroll
    for (int r = 0; r < 16; ++r) { wa[r] = w2[r * 1024 + tid]; wb[r] = w2[r * 1024 + 512 + tid]; }
    const float ba = b2[tid], bb = b2[512 + tid];
    for (int m = bx; m < MT; m += G) {
        const f32x4* cp = (const f32x4*)(CLR + (size_t)m * 16); float xa = ba, xb = bb;
#pragma unroll
        for (int q = 0; q < 4; ++q) { const f32x4 cv = cp[q];
            xa += cv.x * wa[4 * q] + cv.y * wa[4 * q + 1] + cv.z * wa[4 * q + 2] + cv.w * wa[4 * q + 3];
            xb += cv.x * wb[4 * q] + cv.y * wb[4 * q + 1] + cv.z * wb[4 * q + 2] + cv.w * wb[4 * q + 3]; }
        GL[(size_t)m * 1024 + tid] = -(fmaxf(-xa, 0.f) + __logf(1.0f + __expf(-fabsf(xa)))) * 0.0625f;
        GL[(size_t)m * 1024 + 512 + tid] = -(fmaxf(-xb, 0.f) + __logf(1.0f + __expf(-fabsf(xb)))) * 0.0625f;
    }
}

template <int DK> struct SL {
    static constexpr int QS = (DK + 8) * 2;
    static constexpr int KHS = 72 * 2;
    static constexpr int VS = 136 * 2;
    static constexpr int QT = 0, KT = QT + 64 * QS, KH = KT + 64 * QS, VT = KH + DK * KHS, PP = VT + 64 * VS;
    static constexpr int PTOT = PP + 64 * KHS, ER = PTOT + 2048, EBL = ER + DK * 4, SSQ = EBL + DK * 4, END = SSQ + 2048;
};
static_assert(SL<256>::END <= MISC_OFF, "scan LDS map");
struct LaArgs {
    const bf16* Q; int ldq;
    const float* G; int ldg;
    const bf16* K;
    const bf16* V;
    int row0, T;
    const float* S0; float* S1; int lds;
    const float* nw; const bf16* gate; bf16* Y;
};
template <int DK, bool GLA>
DI void la_job(LAS unsigned char* lds, const int tid_in, const LaArgs& A) {
    int tid = tid_in; asm volatile("" : "+v"(tid));
    typedef SL<DK> L;
    constexpr int NPART = 512 / DK, TPT = 64 / NPART, NDKT = DK / 16, NKS = DK / 32, NQ = DK / 64;
    const int lane = tid & 63, w = __builtin_amdgcn_readfirstlane(tid >> 6), fr = lane & 15, fq = lane >> 4;
    const int d = tid % DK, part = __builtin_amdgcn_readfirstlane(tid / DK);
    f32x4 S[NDKT];
#pragma unroll
    for (int k = 0; k < NDKT; ++k) {
        if (A.S0) {
#pragma unroll
            for (int j = 0; j < 4; ++j) S[k][j] = A.S0[(size_t)(16 * k + 4 * fq + j) * A.lds + 16 * w + fr];
        } else S[k] = (f32x4){0.f, 0.f, 0.f, 0.f};
    }
    const int nchunk = (A.T + 63) >> 6;
    const f32x4 nw4 = *(const f32x4*)(A.nw + 16 * w + 4 * fq);
    u32x4 pq[NQ], pk[NQ], pv[2]; float pg[TPT];
    constexpr int RPI = 512 / (DK / 8);
    const int tq = tid / (DK / 8), cq = tid % (DK / 8), tv = tid >> 4, cv = tid & 15;
    int b_q = L::QT + fr * L::QS + 16 * fq, b_q4 = L::QT + fr * L::QS + 8 * fq, b_k = L::KT + fr * L::QS + 16 * fq, b_kh = L::KH + fr * L::KHS + 16 * fq, b_p = L::PP + fr * L::KHS + 16 * fq, b_e = 16 * fq;
    asm volatile("" : "+v"(b_q), "+v"(b_q4), "+v"(b_k), "+v"(b_kh), "+v"(b_p), "+v"(b_e));
    const unsigned qoff = (unsigned)(tq * A.ldq + cq * 8), koff = (unsigned)(tq * 1024 + cq * 8), voff = (unsigned)(tv * BW + cv * 8);
#define LA_PREFETCH(cc) do { int t0_ = (cc) * 64; asm volatile("" : "+s"(t0_)); const size_t rowc_ = (size_t)A.row0 + t0_; const int nval_ = (A.T - t0_) < 64 ? (A.T - t0_) : 64; \
        _Pragma("unroll") for (int i_ = 0; i_ < NQ; ++i_) { const bf16* qb_ = A.Q + (rowc_ + RPI * i_) * A.ldq; \
            pq[i_] = (u32x4){0u, 0u, 0u, 0u}; if (tq + RPI * i_ < nval_) pq[i_] = *(const u32x4*)(qb_ + qoff); \
            } \
        _Pragma("unroll") for (int i_ = 0; i_ < 2; ++i_) { const bf16* vb_ = A.V + (rowc_ + 32 * i_) * BW; \
            pv[i_] = (u32x4){0u, 0u, 0u, 0u}; if (tv + 32 * i_ < nval_) pv[i_] = *(const u32x4*)(vb_ + voff); } \
        } while (0)
#define LA_LOAD_G(rowc_, nval_) do { _Pragma("unroll") for (int i_ = 0; i_ < TPT; ++i_) { const int t_ = part * TPT + i_; const float* gb_ = A.G + ((rowc_) + t_) * A.ldg; pg[i_] = (t_ < (nval_)) ? gb_[d] : 0.f; } } while (0)
#define LA_PREFETCH_G(cc) do { int t0_ = (cc) * 64; asm volatile("" : "+s"(t0_)); const size_t rowc_ = (size_t)A.row0 + t0_; const int nval_ = (A.T - t0_) < 64 ? (A.T - t0_) : 64; \
        if constexpr (GLA) { _Pragma("unroll") for (int i_ = 0; i_ < NQ; ++i_) { const bf16* kb_ = A.K + (rowc_ + RPI * i_) * 1024; pk[i_] = (u32x4){0u, 0u, 0u, 0u}; if (tq + RPI * i_ < nval_) pk[i_] = *(const u32x4*)(kb_ + koff); } } \
        if constexpr (!GLA) { LA_LOAD_G(rowc_, nval_); } } while (0)
    LA_PREFETCH(0); LA_PREFETCH_G(0);
    for (int c = 0; c < nchunk; ++c) {
        const int t0 = c * 64; const size_t rowc = (size_t)A.row0 + t0; const int nval = (A.T - t0) < 64 ? (A.T - t0) : 64;
        if constexpr (GLA) { LA_LOAD_G(rowc, nval); }
#pragma unroll
        for (int i = 0; i < NQ; ++i) { *(LAS u32x4*)(lds + L::QT + (tq + RPI * i) * L::QS + cq * 16) = pq[i];
            if constexpr (GLA) *(LAS u32x4*)(lds + L::KT + (tq + RPI * i) * L::QS + cq * 16) = pk[i]; }
#pragma unroll
        for (int i = 0; i < 2; ++i) *(LAS u32x4*)(lds + L::VT + (tv + 32 * i) * L::VS + cv * 16) = pv[i];
        float g[TPT];
        { float run = 0.f;
#pragma unroll
            for (int i = 0; i < TPT; ++i) { g[i] = pg[i]; run += g[i]; }
            *(LAS float*)(lds + L::PTOT + (part * DK + d) * 4) = run; }
        __syncthreads();
        float pre = 0.f, tot = 0.f, rr = 0.f;
#pragma unroll
        for (int p = 0; p < NPART; ++p) { const float v = *(const LAS float*)(lds + L::PTOT + (p * DK + d) * 4); pre += (p < part) ? v : 0.f; tot += v; rr += (p < NPART / 2) ? v : 0.f; }
        {
            float bb = pre; const float etr = __expf(tot - rr);
#pragma unroll
            for (int i8 = 0; i8 < TPT / 8; ++i8) { float kh[8];
#pragma unroll
                for (int ii = 0; ii < 8; ++ii) { const int i = 8 * i8 + ii; const int t = part * TPT + i; bb += g[i];
                    LAS bf16* qp = (LAS bf16*)(lds + L::QT + t * L::QS + d * 2); LAS bf16* kp = (LAS bf16*)(lds + L::KT + t * L::QS + d * 2);
                    const float qr = bf2f(*qp); float kr;
                    if constexpr (GLA) kr = bf2f(*kp); else kr = 1.0f - __expf(g[i]);
                    const float e1 = __expf(bb - rr), e2 = __expf(rr - bb);
                    *qp = f2bf(qr * e1); const float kt = kr * e2; *kp = f2bf(kt); kh[ii] = kt * etr; }
                u32x4 o; o.x = pk2(kh[0], kh[1]); o.y = pk2(kh[2], kh[3]); o.z = pk2(kh[4], kh[5]); o.w = pk2(kh[6], kh[7]);
                *(LAS u32x4*)(lds + L::KH + d * L::KHS + (part * TPT + 8 * i8) * 2) = o;
                asm volatile("" ::: "memory"); }
            if (part == 0) { *(LAS float*)(lds + L::ER + d * 4) = __expf(rr); *(LAS float*)(lds + L::EBL + d * 4) = __expf(tot); }
        }
        __syncthreads();
        if (c + 1 < nchunk) LA_PREFETCH(c + 1);
        bf16x8 Vf[2];
#pragma unroll
        for (int ks = 0; ks < 2; ++ks) {
            const bf16x4 lo = __builtin_amdgcn_ds_read_tr16_b64_v4i16((LAS bf16x4*)(lds + L::VT + (32 * ks + 8 * fq + (fr >> 2)) * L::VS + (16 * w + 4 * (fr & 3)) * 2));
            const bf16x4 hi = __builtin_amdgcn_ds_read_tr16_b64_v4i16((LAS bf16x4*)(lds + L::VT + (32 * ks + 8 * fq + 4 + (fr >> 2)) * L::VS + (16 * w + 4 * (fr & 3)) * 2));
            Vf[ks] = (bf16x8){lo[0], lo[1], lo[2], lo[3], hi[0], hi[1], hi[2], hi[3]}; }
        { const int ti = w >> 1; const int pk_base = b_k + ((w & 1) * 2) * 16 * L::QS, pq_base = b_q + ti * 16 * L::QS;
#pragma unroll
            for (int sj = 0; sj < 2; ++sj) { const int si = (w & 1) * 2 + sj; f32x4 acc = (f32x4){0.f, 0.f, 0.f, 0.f};
                if (si <= ti) {
#pragma unroll
                    for (int ks = 0; ks < NKS; ++ks) { const bf16x8 a = *(const LAS bf16x8*)(lds + pk_base + sj * 16 * L::QS + ks * 64);
                        const bf16x8 bq = *(const LAS bf16x8*)(lds + pq_base + ks * 64); acc = MFMA16(a, bq, acc); } }
                const int t = 16 * ti + fr, s0 = 16 * si + 4 * fq;
#pragma unroll
                for (int j = 0; j < 4; ++j) if (s0 + j > t) acc[j] = 0.f;
                u32x2 pw; pw.x = pk2(acc[0], acc[1]); pw.y = pk2(acc[2], acc[3]);
                *(LAS u32x2*)(lds + L::PP + t * L::KHS + s0 * 2) = pw; } }
        f32x4 O[4];
#pragma unroll
        for (int ti = 0; ti < 4; ++ti) O[ti] = (f32x4){0.f, 0.f, 0.f, 0.f};
#pragma unroll
        for (int p = 0; p < NKS; ++p) { const f32x4 ea = *(const LAS f32x4*)(lds + b_e + L::ER + 128 * p), eb = *(const LAS f32x4*)(lds + b_e + L::ER + 128 * p + 64);
            u32x4 o; o.x = pk2(S[2 * p][0] * ea[0], S[2 * p][1] * ea[1]); o.y = pk2(S[2 * p][2] * ea[2], S[2 * p][3] * ea[3]);
            o.z = pk2(S[2 * p + 1][0] * eb[0], S[2 * p + 1][1] * eb[1]); o.w = pk2(S[2 * p + 1][2] * eb[2], S[2 * p + 1][3] * eb[3]); const bf16x8 Sf = __builtin_bit_cast(bf16x8, o);
#pragma unroll
            for (int ti = 0; ti < 4; ++ti) { const u32x2 q0 = *(const LAS u32x2*)(lds + b_q4 + ti * 16 * L::QS + 64 * p), q1 = *(const LAS u32x2*)(lds + b_q4 + ti * 16 * L::QS + 64 * p + 32);
                u32x4 qq; qq.x = q0.x; qq.y = q0.y; qq.z = q1.x; qq.w = q1.y; O[ti] = MFMA16(Sf, __builtin_bit_cast(bf16x8, qq), O[ti]); }
            }
        __syncthreads();
        u32x2 gt[4];
#pragma unroll
        for (int ti = 0; ti < 4; ++ti) { f32x4 acc = O[ti];
#pragma unroll
            for (int ks = 0; ks < 2; ++ks) { const bf16x8 bp = *(const LAS bf16x8*)(lds + b_p + ti * 16 * L::KHS + ks * 64); acc = MFMA16(Vf[ks], bp, acc); }
            O[ti] = acc;
            const int t = 16 * ti + fr;
            gt[ti] = (u32x2){0u, 0u}; if (t < nval) gt[ti] = *(const u32x2*)(A.gate + (rowc + t) * BW + 16 * w + 4 * fq);
            float s = (acc[0] * acc[0] + acc[1] * acc[1]) + (acc[2] * acc[2] + acc[3] * acc[3]); s += __shfl_xor(s, 16); s += __shfl_xor(s, 32);
            if (fq == 0) *(LAS float*)(lds + L::SSQ + (t * 8 + w) * 4) = s; }
        if (c + 1 < nchunk) LA_PREFETCH_G(c + 1);
#pragma unroll
        for (int k = 0; k < NDKT; ++k) { const f32x4 e = *(const LAS f32x4*)(lds + b_e + L::EBL + 64 * k); f32x4 acc = S[k] * e;
#pragma unroll
            for (int ks = 0; ks < 2; ++ks) { const bf16x8 a = *(const LAS bf16x8*)(lds + b_kh + k * 16 * L::KHS + ks * 64); acc = MFMA16(a, Vf[ks], acc); }
            S[k] = acc; }
        __syncthreads();
#pragma unroll
        for (int ti = 0; ti < 4; ++ti) { const int t = 16 * ti + fr;
            const f32x4 sa = *(const LAS f32x4*)(lds + L::SSQ + t * 32), sb = *(const LAS f32x4*)(lds + L::SSQ + t * 32 + 16);
            const float r = 1.0f / sqrtf((((sa.x + sa.y) + (sa.z + sa.w)) + ((sb.x + sb.y) + (sb.z + sb.w))) * (1.0f / 128.0f) + EPS);
            const f32x4 o = O[ti]; u32x2 y; y.x = pk2(o[0] * r * nw4[0] * bflo(gt[ti].x), o[1] * r * nw4[1] * bfhi(gt[ti].x)); y.y = pk2(o[2] * r * nw4[2] * bflo(gt[ti].y), o[3] * r * nw4[3] * bfhi(gt[ti].y));
            if (t < nval) *(u32x2*)(A.Y + (rowc + t) * KBR + 16 * w + 4 * fq) = y; }
    }
#undef LA_PREFETCH
#undef LA_PREFETCH_G
#undef LA_LOAD_G
#pragma unroll
    for (int k = 0; k < NDKT; ++k)
#pragma unroll
        for (int j = 0; j < 4; ++j) A.S1[(size_t)(16 * k + 4 * fq + j) * A.lds + 16 * w + fr] = S[k][j];
}

struct GPrep { const bf16* CQ; const bf16* CK; const float* CLR; const float* w2; const float* b2; bf16* QT; bf16* KT; bf16* KH; float* ER; float* EB; };
DI void gla_prep(LAS unsigned char* lds, const int tid_in, const GPrep& P, const int ci, const int hh) {
    int tid = tid_in; asm volatile("" : "+v"(tid));
    const int d = tid & 255, part = __builtin_amdgcn_readfirstlane(tid >> 8);
    const int row0 = ci < 128 ? ci * 64 : MP + (ci - 128) * 32, nval = ci < 128 ? 64 : 32;
    const int ch = hh * 256 + d;
    LAS float* ptot = (LAS float*)lds; LAS float* clrs = (LAS float*)(lds + 4096);
    if (tid < 256) { const int t = tid >> 2, q4 = tid & 3; f32x4 v = (f32x4){0.f, 0.f, 0.f, 0.f}; if (t < nval) v = *(const f32x4*)(P.CLR + ((size_t)row0 + t) * 16 + q4 * 4);
        *(LAS f32x4*)(clrs + t * 16 + q4 * 4) = v; }
    float w2r[16];
#pragma unroll
    for (int r = 0; r < 16; ++r) w2r[r] = P.w2[r * 1024 + ch];
    const float b2v = P.b2[ch];
    unsigned qk[32];
    { const bf16* qi = P.CQ + (size_t)row0 * 1024 + ch; const bf16* ki = P.CK + (size_t)row0 * 1024 + ch;
#pragma unroll
      for (int i = 0; i < 32; ++i) { const int t = part * 32 + i; unsigned qv = 0u, kv = 0u; if (t < nval) { qv = qi[(size_t)t * 1024]; kv = ki[(size_t)t * 1024]; } qk[i] = qv | (kv << 16); } }
    __syncthreads();
    float g[32]; float run = 0.f;
#pragma unroll
    for (int i = 0; i < 32; ++i) { const int t = part * 32 + i; const LAS f32x4* cp = (const LAS f32x4*)(clrs + t * 16);
        float x = b2v;
#pragma unroll
        for (int q = 0; q < 4; ++q) { const f32x4 cv = cp[q]; x += cv.x * w2r[4 * q] + cv.y * w2r[4 * q + 1] + cv.z * w2r[4 * q + 2] + cv.w * w2r[4 * q + 3]; }
        const float ls = -(fmaxf(-x, 0.f) + __logf(1.0f + __expf(-fabsf(x))));
        g[i] = (t < nval) ? ls * 0.0625f : 0.f; run += g[i]; }
    ptot[part * 256 + d] = run;
    __syncthreads();
    const float p0 = ptot[d], p1 = ptot[256 + d];
    const float rr = p0, tot = p0 + p1, etr = __expf(tot - rr);
    float bb = part ? p0 : 0.f;
    bf16* qo = P.QT + (size_t)row0 * 1024 + ch; bf16* ko = P.KT + (size_t)row0 * 1024 + ch;
    u32x4* kho = (u32x4*)(P.KH + ((size_t)ci * 1024 + ch) * 64 + part * 32);
#pragma unroll
    for (int i8 = 0; i8 < 4; ++i8) { float kh[8];
#pragma unroll
        for (int ii = 0; ii < 8; ++ii) { const int i = 8 * i8 + ii; const int t = part * 32 + i; bb += g[i];
            const float qr = bflo(qk[i]), kr = bfhi(qk[i]);
            const float e1 = __expf(bb - rr), e2 = __expf(rr - bb); const float kt = kr * e2;
            if (t < nval) { qo[(size_t)t * 1024] = f2bf(qr * e1); ko[(size_t)t * 1024] = f2bf(kt); }
            kh[ii] = kt * etr; }
        u32x4 o; o.x = pk2(kh[0], kh[1]); o.y = pk2(kh[2], kh[3]); o.z = pk2(kh[4], kh[5]); o.w = pk2(kh[6], kh[7]); kho[i8] = o; }
    if (part == 0) { P.ER[(size_t)ci * 1024 + ch] = __expf(rr); P.EB[(size_t)ci * 1024 + ch] = __expf(tot); }
    __syncthreads();
}
struct GArgs { const bf16* QT; const bf16* KT; const bf16* KH; const float* ER; const float* EB; const bf16* V; int ci0, row0, T; const float* S0; float* S1; int lds; bf16* OA; float* SSQ; };
DI void gla_job(LAS unsigned char* lds, const int tid_in, const GArgs& A) {
    int tid = tid_in; asm volatile("" : "+v"(tid));
    typedef SL<256> L;
    constexpr int NDKT = 16, NKS = 8;
    const int lane = tid & 63, w = __builtin_amdgcn_readfirstlane(tid >> 6), fr = lane & 15, fq = lane >> 4;
    f32x4 S[NDKT];
#pragma unroll
    for (int k = 0; k < NDKT; ++k) {
        if (A.S0) {
#pragma unroll
            for (int j = 0; j < 4; ++j) S[k][j] = A.S0[(size_t)(16 * k + 4 * fq + j) * A.lds + 16 * w + fr];
        } else S[k] = (f32x4){0.f, 0.f, 0.f, 0.f};
    }
    const int nchunk = (A.T + 63) >> 6;
    u32x4 pq[4], pk[4], ph[4], pv[2]; f32x4 pe = (f32x4){0.f, 0.f, 0.f, 0.f};
    int b_q = L::QT + fr * L::QS + 16 * fq, b_q4 = L::QT + fr * L::QS + 8 * fq, b_k = L::KT + fr * L::QS + 16 * fq, b_kh = L::KH + fr * L::KHS + 16 * fq, b_p = L::PP + fr * L::KHS + 16 * fq, b_e = 16 * fq;
    asm volatile("" : "+v"(b_q), "+v"(b_q4), "+v"(b_k), "+v"(b_kh), "+v"(b_p), "+v"(b_e));
#define G_IDX() int t_ = tid; asm volatile("" : "+v"(t_)); const int tq = t_ >> 5, cq = t_ & 31, tv = t_ >> 4, cv = t_ & 15, th = t_ >> 3, chh = t_ & 7; \
        const unsigned qoff = (unsigned)(tq * 1024 + cq * 8), voff = (unsigned)(tv * BW + cv * 8), hoff = (unsigned)(th * 64 + chh * 8); (void)tq; (void)cq; (void)tv; (void)cv; (void)th; (void)chh; (void)qoff; (void)voff; (void)hoff
#define G_LOAD_QK(cc) do { G_IDX(); int c_ = (cc); asm volatile("" : "+s"(c_)); const size_t rowc_ = (size_t)A.row0 + c_ * 64; const int nval_ = (A.T - c_ * 64) < 64 ? (A.T - c_ * 64) : 64; \
        _Pragma("unroll") for (int i_ = 0; i_ < 4; ++i_) { const bf16* qb_ = A.QT + (rowc_ + 16 * i_) * 1024; const bf16* kb_ = A.KT + (rowc_ + 16 * i_) * 1024; \
            pq[i_] = (u32x4){0u, 0u, 0u, 0u}; pk[i_] = (u32x4){0u, 0u, 0u, 0u}; if (tq + 16 * i_ < nval_) { pq[i_] = *(const u32x4*)(qb_ + qoff); pk[i_] = *(const u32x4*)(kb_ + qoff); } } } while (0)
#define G_LOAD_HV(cc) do { G_IDX(); int c_ = (cc); asm volatile("" : "+s"(c_)); const size_t rowc_ = (size_t)A.row0 + c_ * 64; const int nval_ = (A.T - c_ * 64) < 64 ? (A.T - c_ * 64) : 64; \
        _Pragma("unroll") for (int i_ = 0; i_ < 4; ++i_) { const bf16* hb_ = A.KH + ((size_t)(A.ci0 + c_) * 1024 + 64 * i_) * 64; ph[i_] = *(const u32x4*)(hb_ + hoff); } \
        _Pragma("unroll") for (int i_ = 0; i_ < 2; ++i_) { const bf16* vb_ = A.V + (rowc_ + 32 * i_) * BW; pv[i_] = (u32x4){0u, 0u, 0u, 0u}; if (tv + 32 * i_ < nval_) pv[i_] = *(const u32x4*)(vb_ + voff); } \
        if (tid < 128) { const float* eb_ = (tid < 64 ? A.ER : A.EB) + (size_t)(A.ci0 + c_) * 1024; pe = *(const f32x4*)(eb_ + 4 * (tid & 63)); } } while (0)
#define G_LAND_QK() do { G_IDX(); _Pragma("unroll") for (int i_ = 0; i_ < 4; ++i_) { *(LAS u32x4*)(lds + L::QT + (tq + 16 * i_) * L::QS + cq * 16) = pq[i_]; *(LAS u32x4*)(lds + L::KT + (tq + 16 * i_) * L::QS + cq * 16) = pk[i_]; } } while (0)
#define G_LAND_HV() do { G_IDX(); _Pragma("unroll") for (int i_ = 0; i_ < 4; ++i_) *(LAS u32x4*)(lds + L::KH + (th + 64 * i_) * L::KHS + chh * 16) = ph[i_]; \
        _Pragma("unroll") for (int i_ = 0; i_ < 2; ++i_) *(LAS u32x4*)(lds + L::VT + (tv + 32 * i_) * L::VS + cv * 16) = pv[i_]; \
        if (tid < 128) *(LAS f32x4*)(lds + L::ER + 16 * tid) = pe; } while (0)
    G_LOAD_QK(0); G_LOAD_HV(0); G_LAND_QK();
    for (int c = 0; c < nchunk; ++c) {
        const int t0 = c * 64; const size_t rowc = (size_t)A.row0 + t0; const int nval = (A.T - t0) < 64 ? (A.T - t0) : 64;
        G_LAND_HV();
        __syncthreads();
        if (c + 1 < nchunk) G_LOAD_QK(c + 1);
        bf16x8 Vf[2];
#pragma unroll
        for (int ks = 0; ks < 2; ++ks) {
            const bf16x4 lo = __builtin_amdgcn_ds_read_tr16_b64_v4i16((LAS bf16x4*)(lds + L::VT + (32 * ks + 8 * fq + (fr >> 2)) * L::VS + (16 * w + 4 * (fr & 3)) * 2));
            const bf16x4 hi = __builtin_amdgcn_ds_read_tr16_b64_v4i16((LAS bf16x4*)(lds + L::VT + (32 * ks + 8 * fq + 4 + (fr >> 2)) * L::VS + (16 * w + 4 * (fr & 3)) * 2));
            Vf[ks] = (bf16x8){lo[0], lo[1], lo[2], lo[3], hi[0], hi[1], hi[2], hi[3]}; }
        { const int ti = w >> 1; const int pk_base = b_k + ((w & 1) * 2) * 16 * L::QS, pq_base = b_q + ti * 16 * L::QS;
#pragma unroll
            for (int sj = 0; sj < 2; ++sj) { const int si = (w & 1) * 2 + sj; f32x4 acc = (f32x4){0.f, 0.f, 0.f, 0.f};
                if (si <= ti) {
#pragma unroll
                    for (int ks = 0; ks < NKS; ++ks) { const bf16x8 a = *(const LAS bf16x8*)(lds + pk_base + sj * 16 * L::QS + ks * 64);
                        const bf16x8 bq = *(const LAS bf16x8*)(lds + pq_base + ks * 64); acc = MFMA16(a, bq, acc); } }
                const int t = 16 * ti + fr, s0 = 16 * si + 4 * fq;
#pragma unroll
                for (int j = 0; j < 4; ++j) if (s0 + j > t) acc[j] = 0.f;
                u32x2 pw; pw.x = pk2(acc[0], acc[1]); pw.y = pk2(acc[2], acc[3]);
                *(LAS u32x2*)(lds + L::PP + t * L::KHS + s0 * 2) = pw; } }
        f32x4 O[4];
#pragma unroll
        for (int ti = 0; ti < 4; ++ti) O[ti] = (f32x4){0.f, 0.f, 0.f, 0.f};
#pragma unroll
        for (int p = 0; p < NKS; ++p) { const f32x4 ea = *(const LAS f32x4*)(lds + b_e + L::ER + 128 * p), eb = *(const LAS f32x4*)(lds + b_e + L::ER + 128 * p + 64);
            u32x4 o; o.x = pk2(S[2 * p][0] * ea[0], S[2 * p][1] * ea[1]); o.y = pk2(S[2 * p][2] * ea[2], S[2 * p][3] * ea[3]);
            o.z = pk2(S[2 * p + 1][0] * eb[0], S[2 * p + 1][1] * eb[1]); o.w = pk2(S[2 * p + 1][2] * eb[2], S[2 * p + 1][3] * eb[3]); const bf16x8 Sf = __builtin_bit_cast(bf16x8, o);
#pragma unroll
            for (int ti = 0; ti < 4; ++ti) { const u32x2 q0 = *(const LAS u32x2*)(lds + b_q4 + ti * 16 * L::QS + 64 * p), q1 = *(const LAS u32x2*)(lds + b_q4 + ti * 16 * L::QS + 64 * p + 32);
                u32x4 qq; qq.x = q0.x; qq.y = q0.y; qq.z = q1.x; qq.w = q1.y; O[ti] = MFMA16(Sf, __builtin_bit_cast(bf16x8, qq), O[ti]); }
            }
        __syncthreads();
        if (c + 1 < nchunk) { G_LAND_QK(); G_LOAD_HV(c + 1); }
#pragma unroll
        for (int ti = 0; ti < 4; ++ti) { f32x4 acc = O[ti];
#pragma unroll
            for (int ks = 0; ks < 2; ++ks) { const bf16x8 bp = *(const LAS bf16x8*)(lds + b_p + ti * 16 * L::KHS + ks * 64); acc = MFMA16(Vf[ks], bp, acc); }
            const int t = 16 * ti + fr;
            if (t < nval) { u32x2 ob; ob.x = pk2(acc[0], acc[1]); ob.y = pk2(acc[2], acc[3]); *(u32x2*)(A.OA + (rowc + t) * (2 * BW) + 16 * w + 4 * fq) = ob; }
            float s = (acc[0] * acc[0] + acc[1] * acc[1]) + (acc[2] * acc[2] + acc[3] * acc[3]); s += __shfl_xor(s, 16); s += __shfl_xor(s, 32);
            if (fq == 0) *(LAS float*)(lds + L::SSQ + (t * 8 + w) * 4) = s; }
#pragma unroll
        for (int k = 0; k < NDKT; ++k) { const f32x4 e = *(const LAS f32x4*)(lds + b_e + L::EBL + 64 * k); f32x4 acc = S[k] * e;
#pragma unroll
            for (int ks = 0; ks < 2; ++ks) { const bf16x8 a = *(const LAS bf16x8*)(lds + b_kh + k * 16 * L::KHS + ks * 64); acc = MFMA16(a, Vf[ks], acc); }
            S[k] = acc; }
        __syncthreads();
        if (tid < 64 && tid < nval) { const f32x4 sa = *(const LAS f32x4*)(lds + L::SSQ + tid * 32), sb = *(const LAS f32x4*)(lds + L::SSQ + tid * 32 + 16);
            A.SSQ[(rowc + tid) * 32] = ((sa.x + sa.y) + (sa.z + sa.w)) + ((sb.x + sb.y) + (sb.z + sb.w)); }
    }
#undef G_IDX
#undef G_LOAD_QK
#undef G_LOAD_HV
#undef G_LAND_QK
#undef G_LAND_HV
#pragma unroll
    for (int k = 0; k < NDKT; ++k)
#pragma unroll
        for (int j = 0; j < 4; ++j) A.S1[(size_t)(16 * k + 4 * fq + j) * A.lds + 16 * w + fr] = S[k][j];
}

struct LruArgs { const float* LX; int row0, T; const float* cst; const float* h0; const float* cw; const float* cb; const float* wa; const float* ba;
                 const float* wx; const float* bx; const float* lam; const bf16* lgate; bf16* Y; float* newh; float* newconv; };
constexpr int LR_XB = 0, LR_XF = 17408, LR_AA = LR_XF + 32768, LR_UU = LR_AA + 32768, LR_END = LR_UU + 32768;
static_assert(LR_END <= MISC_OFF, "lru LDS map");
DI void lru_job(LAS unsigned char* lds, const int tid_in, const LruArgs& A) {
    int tid = tid_in; asm volatile("" : "+v"(tid));
    const int lane = tid & 63, w = __builtin_amdgcn_readfirstlane(tid >> 6), fr = lane & 15, fq = lane >> 4;
    const int c = tid & 127, part = __builtin_amdgcn_readfirstlane(tid >> 7), cc = 16 * w + fr;
    bf16x8 Wf[2][4];
#pragma unroll
    for (int ks = 0; ks < 4; ++ks) { float a[8], x[8];
#pragma unroll
        for (int j = 0; j < 8; ++j) { const int i = 32 * ks + 8 * fq + j; a[j] = A.wa[i * 128 + cc]; x[j] = A.wx[i * 128 + cc]; }
        u32x4 oa, ox; oa.x = pk2(a[0], a[1]); oa.y = pk2(a[2], a[3]); oa.z = pk2(a[4], a[5]); oa.w = pk2(a[6], a[7]);
        ox.x = pk2(x[0], x[1]); ox.y = pk2(x[2], x[3]); ox.z = pk2(x[4], x[5]); ox.w = pk2(x[6], x[7]);
        Wf[0][ks] = __builtin_bit_cast(bf16x8, oa); Wf[1][ks] = __builtin_bit_cast(bf16x8, ox); }
    const float bav = A.ba[cc], bxv = A.bx[cc]; const float lamv = A.lam[cc];
    const float sp8 = -8.0f * (fmaxf(-lamv, 0.f) + log1pf(expf(-fabsf(lamv))));
    const float cw0 = A.cw[c], cw1 = A.cw[BW + c], cw2 = A.cw[2 * BW + c], cw3 = A.cw[3 * BW + c], cbv = A.cb[c];
    float hc = (tid < 128 && A.h0) ? A.h0[c] : 0.f;
    const int nchunk = (A.T + 63) >> 6;
    float xv[19]; unsigned lgn[16];
#define LRU_PREFETCH(chn) do { int t0_ = (chn) * 64; asm volatile("" : "+s"(t0_)); const int nval_ = (A.T - t0_) < 64 ? (A.T - t0_) : 64; \
        _Pragma("unroll") for (int i_ = 0; i_ < 19; ++i_) { const int ta_ = t0_ + 16 * part - 3 + i_; float v_ = 0.f; \
            if (ta_ < 0) { if (A.cst) v_ = A.cst[(3 + ta_) * BW + c]; } else if (ta_ < A.T) { const float* xb_ = A.LX + (size_t)(A.row0 + ta_) * BW; v_ = xb_[c]; } \
            xv[i_] = v_; } \
        _Pragma("unroll") for (int i_ = 0; i_ < 16; ++i_) { const int t_ = 16 * part + i_; const bf16* gb_ = A.lgate + ((size_t)A.row0 + t0_ + t_) * BW; lgn[i_] = (t_ < nval_) ? (unsigned)gb_[c] : 0u; } } while (0)
    LRU_PREFETCH(0);
    for (int ch = 0; ch < nchunk; ++ch) {
        const int t0 = ch * 64; const size_t rowc = (size_t)A.row0 + t0; const int nval = (A.T - t0) < 64 ? (A.T - t0) : 64;
        unsigned lg[16];
#pragma unroll
        for (int i = 0; i < 16; ++i) lg[i] = lgn[i];
#pragma unroll
        for (int i = 0; i < 16; ++i) { const int t = 16 * part + i; const float xc = cbv + xv[i] * cw0 + xv[i + 1] * cw1 + xv[i + 2] * cw2 + xv[i + 3] * cw3;
            *(LAS float*)(lds + LR_XF + (t * 128 + c) * 4) = xc; *(LAS bf16*)(lds + LR_XB + t * 272 + c * 2) = f2bf(xc); }
        __syncthreads();
        if (ch + 1 < nchunk) LRU_PREFETCH(ch + 1);
#pragma unroll
        for (int ti = 0; ti < 4; ++ti) { f32x4 ar = (f32x4){0.f, 0.f, 0.f, 0.f}, ai = (f32x4){0.f, 0.f, 0.f, 0.f};
#pragma unroll
            for (int ks = 0; ks < 4; ++ks) { const bf16x8 a = *(const LAS bf16x8*)(lds + LR_XB + (16 * ti + fr) * 272 + (32 * ks + 8 * fq) * 2); ar = MFMA16(a, Wf[0][ks], ar); ai = MFMA16(a, Wf[1][ks], ai); }
#pragma unroll
            for (int j = 0; j < 4; ++j) { const int t = 16 * ti + 4 * fq + j;
                const float r = sigmoidf_(ar[j] + bav), ig = sigmoidf_(ai[j] + bxv); const float la = r * sp8;
                float a_ = __expf(la); const float t2 = 2.0f * la;
                const float om = (t2 > -0.03f) ? -t2 * (1.0f + t2 * (0.5f + t2 * (0.16666667f + t2 * 0.041666668f))) : 1.0f - a_ * a_;
                float u = __builtin_amdgcn_sqrtf(fmaxf(om, 0.f)) * ig * *(const LAS float*)(lds + LR_XF + (t * 128 + cc) * 4);
                if (t >= nval) { a_ = 1.0f; u = 0.f; }
                *(LAS float*)(lds + LR_AA + (t * 128 + cc) * 4) = a_; *(LAS float*)(lds + LR_UU + (t * 128 + cc) * 4) = u; } }
        __syncthreads();
        if (tid < 128) {
#pragma unroll 16
            for (int t = 0; t < 64; ++t) { const float a_ = *(const LAS float*)(lds + LR_AA + (t * 128 + c) * 4); LAS float* up = (LAS float*)(lds + LR_UU + (t * 128 + c) * 4);
                hc = a_ * hc + *up; *up = hc; }
        }
        __syncthreads();
#pragma unroll
        for (int i = 0; i < 16; ++i) { const int t = 16 * part + i; const float ht = *(const LAS float*)(lds + LR_UU + (t * 128 + c) * 4);
            if (t < nval) { bf16* yb = A.Y + (rowc + t) * KBR; yb[c] = f2bf(ht * bf2f(lg[i])); } }
    }
#undef LRU_PREFETCH
    if (tid < 128) { A.newh[c] = hc;
#pragma unroll
        for (int j = 0; j < 3; ++j) A.newconv[j * BW + c] = A.LX[(size_t)(A.row0 + A.T - 3 + j) * BW + c]; }
    __syncthreads();
}

struct Args { const float* in[23]; float* out; unsigned char* ws; int ph_lo, ph_hi, use_bar, pad; };
enum { I_XP = 0, I_XS, I_SHG, I_SLH, I_SLC, I_SGL, I_NPRE, I_NPOST, I_WIN, I_LBL, I_HGN, I_CW, I_CB, I_WA, I_BA, I_WX, I_BX, I_LAM, I_W2, I_B2, I_GLN, I_WBR, I_WOU };
constexpr int NPHASE = 15;


#define WSZ() unsigned char* wsz = ws; asm volatile("" : "+s"(wsz))
#define wHQ ((bf16*)(wsz + WS_HQ))
#define wHG ((float*)(wsz + WS_HG))
#define wHV ((bf16*)(wsz + WS_HV))
#define wHGATE ((bf16*)(wsz + WS_HGATE))
#define wLX ((float*)(wsz + WS_LX))
#define wLGATE ((bf16*)(wsz + WS_LGATE))
#define wCQ ((bf16*)(wsz + WS_CQ))
#define wCK ((bf16*)(wsz + WS_CK))
#define wCV ((bf16*)(wsz + WS_CV))
#define wCGATE ((bf16*)(wsz + WS_CGATE))
#define wMG ((unsigned char*)(wsz + WS_MG))
#define wCLR ((float*)(wsz + WS_CLR))
#define wY ((bf16*)(wsz + WS_Y))
#define wOC ((bf16*)(wsz + WS_OC))
#define wSSQ ((float*)(wsz + WS_SSQ))
#define wGL ((float*)(wsz + WS_MERGED))
#define wMB ((bf16*)(wsz + WS_MB))
#define wOUT ((bf16*)(wsz + WS_OUT))
__global__ void __launch_bounds__(NTHR, 2) mega(Args args) {
    extern __shared__ __attribute__((aligned(16))) unsigned char lds_raw[];
    LAS unsigned char* lds = (LAS unsigned char*)lds_raw;
    const int wave = __builtin_amdgcn_readfirstlane((int)threadIdx.x >> 6);
#define tid ((int)threadIdx.x)
#define lane ((int)(threadIdx.x & 63u))
    const int G = gridDim.x, bx = blockIdx.x;
    const int gw = bx * NWAVES + wave, NGW = G * NWAVES;
#define chain (gridDim.x == 256u)
#define MM (chain ? MP : MT)
    unsigned char* ws = args.ws;
    volatile LAS unsigned* MISC = (volatile LAS unsigned*)(lds + MISC_OFF);
    if (tid < 64) MISC[tid] = 0u;
    __syncthreads();
    XcdBarrier bar; bar.bar = (unsigned*)(ws + WS_CTL) + CW_BAR; bar.x = 0; bar.st = nullptr;
    if (args.use_bar) bar = xcd_barrier_post((unsigned*)(ws + WS_CTL) + CW_BAR, MISC);
    const int lo = args.ph_lo, hi = args.ph_hi;
#define IN(k) (lo <= (k) && (k) < hi)
#define SEAM(k) do { if (IN(k) && IN((k) + 1)) xcd_barrier(bar); } while (0)
    const float* xp = args.in[I_XP]; const float* xs = args.in[I_XS];
    bf16* Z = (bf16*)(ws + WS_Z);
    bf16* X1 = (bf16*)(ws + WS_X1);

    for (int rep_ = 0; rep_ < REP_P0; ++rep_) if (IN(0) && (PHM & 64)) {
        { int lz = lane, gz = gw; asm volatile("" : "+v"(lz), "+s"(gz));
          convert_items(lds, args.in[I_WIN], args.in[I_WBR], args.in[I_WOU], ws, 0, 0, CV_IN, gz, NGW, lz); }
        norm_rows(xp, xs, args.in[I_NPRE], Z, ws + WS_Z8, gw, NGW, lane);
        __syncthreads();
    }
    SEAM(0);
    for (int l = 0; l < 2; ++l) {
        const int pb = 1 + 7 * l;
        for (int rp_ = 0; rp_ < REP_IN; ++rp_) if (IN(pb) && (PHM & 1)) { WSZ();
            const NoDrain<EpiInProj> E{{wHQ, wHV, wHGATE, wLGATE, wCQ, wCK, wCV, wCGATE, wMG, wHG, wLX, wCLR, args.in[I_LBL], l, 0.015625f}};
            { pg8::Gemm g{Z, (const bf16*)(ws + WS_WIN + l * SZ_WIN), MT, NIN, DM, DM, DM}; int bz = bx; asm volatile("" : "+s"(bz)); InOrderA SA; SA.S.init(MT, 73 * 256, G, bz);
              af4 acc[2][2][4][2]; zero_acc(acc); pg8::gemm_phase<NoDrain<EpiInProj>, InOrderA, GEMM_ALIGN, GEMM_SP2, false>(lds, g, SA, E, acc); }
            { pg8::Gemm g{(const bf16*)(ws + WS_Z8), (const bf16*)(ws + WS_W8 + l * SZ_W8) - (size_t)72 * 256 * 2048, MT, 12288, 2048, 2048, 2048}; InOrder8 S8; int bz = bx; asm volatile("" : "+s"(bz)); S8.S.init(MT, 48 * 256, G, G == 256 ? ((bz + 48) & 255) : bz);
              af4 acc[2][2][4][2]; zero_acc(acc); pg8::gemm_phase<NoDrain<EpiInProj>, InOrder8, GEMM_ALIGN, GEMM_SP2, true>(lds, g, S8, E, acc); }
            if (G == 256) { if (bx >= 105 && bx < 208) { int lz = lane; asm volatile("" : "+v"(lz)); convert_items(lds, args.in[I_WIN], args.in[I_WBR], args.in[I_WOU], ws, l, CV_IN, CV_L, (bx - 105) * NWAVES + wave, 103 * NWAVES, lz); } }
            else { int lz = lane; asm volatile("" : "+v"(lz)); convert_items(lds, args.in[I_WIN], args.in[I_WBR], args.in[I_WOU], ws, l, CV_IN, CV_L, bx * NWAVES + wave, G * NWAVES, lz); }
        }
        SEAM(pb);
        if (!chain) {
            if (IN(pb + 1)) { WSZ();
                const GPrep P{wCQ, wCK, wCLR, args.in[I_W2] + (size_t)l * 16 * 1024, args.in[I_B2] + l * 1024, (bf16*)(wsz + WS_GQT), (bf16*)(wsz + WS_GKT), (bf16*)(wsz + WS_GKH), (float*)(wsz + WS_GER), (float*)(wsz + WS_GEB)};
                for (int it = bx; it < NCHK * 4; it += G) gla_prep(lds, tid, P, it >> 2, it & 3);
            }
            SEAM(pb + 1);
        }
        for (int rep_ = 0; rep_ < REP_SCAN; ++rep_) if (IN(pb + 2) && (PHM & 2)) { WSZ();
            constexpr int NLONG = 192;
            const bool split = G > NLONG;
            const int mytype = split ? (bx < NLONG ? bx / 64 : -1) : -2;
            const int sw = bx - NLONG, nsw = G - NLONG;
            if (chain && mytype != 2) {
                const GPrep P{wCQ, wCK, wCLR, args.in[I_W2] + (size_t)l * 16 * 1024, args.in[I_B2] + l * 1024, (bf16*)(wsz + WS_GQT), (bf16*)(wsz + WS_GKT), (bf16*)(wsz + WS_GKH), (float*)(wsz + WS_GER), (float*)(wsz + WS_GEB)};
                for (int it = (bx < 128 ? bx : bx - 64); it < NCHK * 4; it += 192) gla_prep(lds, tid, P, it >> 2, it & 3);
                if (mytype == 1) team_arrive((unsigned*)(ws + WS_CTL) + CW_TEAM + 2048 + l * 64 + rep_ * 16);
                else team_barrier((unsigned*)(ws + WS_CTL) + CW_TEAM + 2048 + l * 64 + rep_ * 16, 192u);
            }
#define JOB_RANGE(TYPE, j0, j1, js) int j0, j1, js; \
            if (mytype == -2) { j0 = bx; j1 = 192; js = G; } else if (mytype == (TYPE)) { j0 = bx - 64 * (TYPE); j1 = j0 + 1; js = 1; } else if (mytype == -1) { j0 = 64 + sw; j1 = 192; js = nsw; } else { j0 = 0; j1 = 0; js = 1; }
#define JOB_DECODE(idx) const int seq = (idx) < 64 ? (idx) / 16 : 4 + ((idx) - 64) / 16; const int sub = (idx) % 16; const bool smp = seq >= 4; const int sb = smp ? seq - 4 : seq; \
            const int row0 = smp ? MP + sb * 32 : sb * 2048, T = smp ? 32 : 2048;
            for (int rj_ = 0; rj_ < REP_J0; ++rj_) if (JOBM & 1) { JOB_RANGE(0, j0, j1, js)
                for (int idx = j0; idx < j1; idx += js) { JOB_DECODE(idx)
                    const int hd = sub >> 2, sl = sub & 3;
                    GArgs A; A.QT = (const bf16*)(wsz + WS_GQT) + hd * 256; A.KT = (const bf16*)(wsz + WS_GKT) + hd * 256; A.KH = (const bf16*)(wsz + WS_GKH) + (size_t)hd * 256 * 64;
                    A.ER = (const float*)(wsz + WS_GER) + hd * 256; A.EB = (const float*)(wsz + WS_GEB) + hd * 256; A.ci0 = smp ? 128 + sb : sb * 32;
                    A.V = wCV + hd * 512 + sl * 128; A.row0 = row0; A.T = T;
                    const size_t so = ((size_t)hd * 256) * 512 + sl * 128;
                    A.S0 = smp ? args.in[I_SGL] + ((size_t)l * 8 + sb) * 4 * 256 * 512 + so : nullptr;
                    A.S1 = args.out + (smp ? O_GLS + ((size_t)l * 8 + sb) * 4 * 256 * 512 : O_GLP + ((size_t)l * 4 + sb) * 4 * 256 * 512) + so; A.lds = 512;
                    A.OA = wOC + BW + hd * 512 + sl * 128; A.SSQ = wSSQ + 16 + hd * 4 + sl;
                    gla_job(lds, tid, A);
                    __syncthreads(); } }
            for (int rj_ = 0; rj_ < REP_J1; ++rj_) if (JOBM & 2) { JOB_RANGE(1, j0, j1, js)
                for (int idx = j0; idx < j1; idx += js) { JOB_DECODE(idx)
                    const int h = sub;
                    LaArgs A; A.Q = wHQ + h * 128; A.ldq = BW; A.G = wHG + h * 128; A.ldg = BW; A.K = nullptr;
                    A.V = wHV + h * 128; A.row0 = row0; A.T = T;
                    A.S0 = smp ? args.in[I_SHG] + (((size_t)l * 8 + sb) * 16 + h) * 16384 : nullptr;
                    A.S1 = args.out + (smp ? O_HGS + (((size_t)l * 8 + sb) * 16 + h) * 16384 : O_HGP + (((size_t)l * 4 + sb) * 16 + h) * 16384); A.lds = 128;
                    A.nw = args.in[I_HGN] + l * BW + h * 128; A.gate = wHGATE + h * 128; A.Y = wY + h * 128;
                    la_job<128, false>(lds, tid, A);
                    __syncthreads(); } }
            for (int rj_ = 0; rj_ < REP_J2; ++rj_) if (JOBM & 4) { JOB_RANGE(2, j0, j1, js)
                for (int idx = j0; idx < j1; idx += js) { JOB_DECODE(idx)
                    const int hb = sub;
                    LruArgs A; A.LX = wLX + hb * 128; A.row0 = row0; A.T = T;
                    A.cst = smp ? args.in[I_SLC] + ((size_t)l * 8 + sb) * 3 * BW + hb * 128 : nullptr;
                    A.h0 = smp ? args.in[I_SLH] + ((size_t)l * 8 + sb) * BW + hb * 128 : nullptr;
                    A.cw = args.in[I_CW] + (size_t)l * 4 * BW + hb * 128; A.cb = args.in[I_CB] + l * BW + hb * 128;
                    A.wa = args.in[I_WA] + ((size_t)l * 16 + hb) * 16384; A.ba = args.in[I_BA] + l * BW + hb * 128;
                    A.wx = args.in[I_WX] + ((size_t)l * 16 + hb) * 16384; A.bx = args.in[I_BX] + l * BW + hb * 128;
                    A.lam = args.in[I_LAM] + l * BW + hb * 128; A.lgate = wLGATE + hb * 128; A.Y = wY + BW + hb * 128;
                    A.newh = args.out + (smp ? O_LHS + ((size_t)l * 8 + sb) * BW : O_LHP + ((size_t)l * 4 + sb) * BW) + hb * 128;
                    A.newconv = args.out + (smp ? O_LCS + ((size_t)l * 8 + sb) * 3 * BW : O_LCP + ((size_t)l * 4 + sb) * 3 * BW) + hb * 128;
                    lru_job(lds, tid, A);
                    __syncthreads(); } }
            if (chain && bx >= 192) {
                const int sw = bx - 192;
                unsigned* tb = (unsigned*)(ws + WS_CTL) + CW_TEAM + (l * 4) * 64 + rep_ * 16;
                team_barrier(tb, 64u);
                mix_fix_rows(wOC, wSSQ, args.in[I_HGN] + l * BW, wHGATE, args.in[I_GLN] + l * BW, wCGATE, wY, MP, MT, sw * NWAVES + wave, 64 * NWAVES, lane);
                team_barrier(tb + 64, 64u);
                if (sw < 48) {
                    const int pn = sw / 3, seg = sw - 3 * pn;
                    const FixedUnit FU{pg8::Unit{MP / 256, pn}};
                    af4 acc[2][2][4][2]; zero_acc(acc); const bf16* WB = (const bf16*)(ws + WS_WBR + l * SZ_WBR);
                    pg8::Gemm g{wY + seg * BW, WB + seg * BW, MT, DM, BW, KBR, KBR}; EpiGateSlab E{wMG, (float*)(wsz + WS_PB), seg};
                    pg8::gemm_phase<EpiGateSlab, FixedUnit, false, GEMM_SP2>(lds, g, FU, E, acc);
                }
                team_barrier(tb + 128, 64u);
                sum_slabs_rows((const float*)(wsz + WS_PB), wMB, sw * NWAVES + wave, 64 * NWAVES, lane);
                team_barrier(tb + 192, 64u);
                {
                    const int pn = sw >> 2, kq = sw & 3;
                    const FixedUnit FU{pg8::Unit{MP / 256, pn}};
                    af4 acc[2][2][4][2]; zero_acc(acc);
                    pg8::Gemm g{wMB + kq * 1024, (const bf16*)(ws + WS_WOU + l * SZ_WOU) + kq * 1024, MT, DM, 1024, DM, DM};
                    EpiF32 E{(float*)(wsz + WS_PO) + (size_t)kq * 256 * DM - (size_t)MP * DM, DM};
                    pg8::gemm_phase<EpiF32, FixedUnit, false, GEMM_SP2>(lds, g, FU, E, acc);
                }
                if (l == 0) {
                    int lz = lane; asm volatile("" : "+v"(lz));
                    convert_items(lds, args.in[I_WIN], args.in[I_WBR], args.in[I_WOU], ws, 1, 0, CVX, sw * NWAVES + wave, 64 * NWAVES, lz);
                }
            }
        }
        SEAM(pb + 2);
        for (int rp_ = 0; rp_ < REP_FIN; ++rp_) if (IN(pb + 3) && (PHM & 4)) { WSZ(); mix_fix_rows(wOC, wSSQ, args.in[I_HGN] + l * BW, wHGATE, args.in[I_GLN] + l * BW, wCGATE, wY, 0, MM, gw, NGW, lane); }
        SEAM(pb + 3);
        for (int rp_ = 0; rp_ < REP_BR; ++rp_) if (IN(pb + 4) && (PHM & 8)) { WSZ();
            const bf16* WB = (const bf16*)(ws + WS_WBR + l * SZ_WBR);
            BranchOrder BO; BO.S.init(MM, DM, G, bx);
            { af4 acc[2][2][4][2]; zero_acc(acc); pg8::Gemm g{wY, WB, MT, DM, BW, KBR, KBR}; const NoDrain<EpiBranchSeg> E{{wMG, wMB, 0}};
              pg8::gemm_phase<NoDrain<EpiBranchSeg>, BranchOrder, GEMM_ALIGN, GEMM_SP2>(lds, g, BO, E, acc); }
            if (l == 0) tail_convert(lds, args.in[I_WIN], args.in[I_WBR], args.in[I_WOU], ws, 1, chain ? CVX : 0, CV_IN, (MM / 256) * (DM / 256), G, bx, wave, lane);
        }
        SEAM(pb + 4);
        for (int rp_ = 0; rp_ < REP_OUT; ++rp_) if (IN(pb + 5) && (PHM & 16)) { WSZ();
            pg8::Gemm g{wMB, (const bf16*)(ws + WS_WOU + l * SZ_WOU), MT, DM, DM, DM, DM}; pg8::StaticOrder S; S.init(MM, DM, G, bx);
            EpiBf E{wOUT, DM}; if (GEMM_STREAM & 2) gemm_stream<EpiBf>(lds, g, S, E); else gemm_units<EpiBf>(lds, g, S, E);
        }
        SEAM(pb + 5);
        for (int rp_ = 0; rp_ < REP_FIN; ++rp_) if (IN(pb + 6) && (PHM & 32)) { WSZ();
            if (l == 0) final_rows<false, true>(xp, xs, wOUT, chain ? (const float*)(wsz + WS_PO) : nullptr, args.in[I_NPOST], X1, args.in[I_NPRE] + DM, Z, ws + WS_Z8, gw, NGW, lane);
            else        final_rows<true, false>(X1, X1 + (size_t)MP * DM, wOUT, chain ? (const float*)(wsz + WS_PO) : nullptr, args.in[I_NPOST] + DM, args.out, nullptr, nullptr, nullptr, gw, NGW, lane);
        }
        if (l == 0) SEAM(pb + 6);
    }
}

#undef tid
#undef lane
#undef chain
#undef MM
#ifndef PHM
#define PHM 127
#endif
#ifndef N_LAUNCH_MODE
#define N_LAUNCH_MODE 0
#endif
extern "C" void kernel_launch(void* const* d_in, const int* in_sizes, int n_in, void* d_out, int out_size, void* d_ws, size_t ws_size, hipStream_t stream) {
    static int grid = 0;
    if (grid == 0) {
        if (n_in != 23 || (size_t)out_size != O_END || ws_size < WS_END) { fprintf(stderr, "kernel_launch: unexpected shapes (n_in %d out %d ws %zu need %zu)\n", n_in, out_size, ws_size, (size_t)WS_END); grid = -1; return; }
        int dev = 0, cus = 0, per_cu = 0;
        if (hipGetDevice(&dev) != hipSuccess || hipDeviceGetAttribute(&cus, hipDeviceAttributeMultiprocessorCount, dev) != hipSuccess) { grid = -1; return; }
        if (hipFuncSetAttribute((const void*)mega, hipFuncAttributeMaxDynamicSharedMemorySize, LDS_BYTES) != hipSuccess) { fprintf(stderr, "kernel_launch: hipFuncSetAttribute failed\n"); grid = -1; return; }
        if (hipOccupancyMaxActiveBlocksPerMultiprocessor(&per_cu, (const void*)mega, NTHR, LDS_BYTES) != hipSuccess || per_cu < 1) { fprintf(stderr, "kernel_launch: occupancy query says %d\n", per_cu); grid = -1; return; }
        grid = cus;
    }
    if (grid < 0) return;
    hipMemsetAsync((char*)d_ws + WS_CTL, 0, CTL_ZERO_BYTES, stream);
    Args a{};
    for (int i = 0; i < 23; ++i) a.in[i] = (const float*)d_in[i];
    a.out = (float*)d_out; a.ws = (unsigned char*)d_ws; a.pad = 0;
#if N_LAUNCH_MODE == 1
    a.ph_lo = 0; a.ph_hi = NPHASE; a.use_bar = 1;
    hipLaunchKernelGGL(mega, dim3(grid), dim3(NTHR), LDS_BYTES, stream, a);
#else
    for (int p = 0; p < NPHASE; ++p) { a.ph_lo = p; a.ph_hi = p + 1; a.use_bar = 0; hipLaunchKernelGGL(mega, dim3(grid), dim3(NTHR), LDS_BYTES, stream, a); }
#endif
}
```

```cpp
#include <hip/hip_runtime.h>
#include <cstdio>
#include <cstdint>
#define N_LAUNCH_MODE 1
#ifndef PG8_WGM
#define PG8_WGM 8
#endif
namespace pg8 {
#define PG8_LAS __attribute__((address_space(3)))
typedef unsigned short bf16_t;
typedef short bf16x8 __attribute__((ext_vector_type(8)));
typedef float f32x4 __attribute__((ext_vector_type(4)));
typedef unsigned u32x4 __attribute__((ext_vector_type(4)));
typedef int i32x4 __attribute__((ext_vector_type(4)));
typedef int i32x8 __attribute__((ext_vector_type(8)));
constexpr int BM = 256, BK = 64, HALF = 128, HTB = HALF * BK * 2  , STAGE_BYTES = 8 * HTB, NXCD = 8, WGM = PG8_WGM;

__host__ __device__ __forceinline__ int lds_byte(int r, int c) { const int st = (r >> 4) * 2 + (c >> 5), rr = r & 15, cc = c & 31, ob = rr * 64 + cc * 2; return st * 1024 + (ob ^ (((ob >> 9) & 1) << 5)); }
__host__ __device__ __forceinline__ void stage_rc(int b, int& R, int& C) { const int st = b / 1024, sb = b % 1024, swz = sb ^ (((sb >> 9) & 1) << 5); R = (st >> 1) * 16 + swz / 64; C = (st & 1) * 32 + (swz % 64) / 2; }
__host__ __device__ __forceinline__ int perm32(int rho) { const int n = rho >> 4, i = rho & 15; return 8 * (i >> 2) + 4 * n + (i & 3); }

struct Unit { int pm, pn, ko; };
struct Gemm { const bf16_t* A; const bf16_t* Bt; int M, N, K, lda, ldb; };

struct StaticOrder {
    int nM, nN, nwg, G, c;
    __host__ __device__ __forceinline__ void init(int M, int N, int G_, int c_) { nM = M / BM; nN = N / BM; nwg = nM * nN; G = G_; c = c_; }
    __host__ __device__ __forceinline__ bool next(int i, Unit& u) const {
        const long L = (long)i * G + c; if (L >= nwg) return false;
        int wgid = (int)L; { const int q = nwg / NXCD, r = nwg % NXCD, xcd = wgid % NXCD, off = wgid / NXCD; wgid = (xcd < r ? xcd * (q + 1) : r * (q + 1) + (xcd - r) * q) + off; }
        const int nig = WGM * nN, gid = wgid / nig, fm = gid * WGM, w_ = wgid - gid * nig, rem = (nM % WGM) ? (nM % WGM) : 1;
        if ((nM - fm) < WGM) { u.pm = fm + (w_ % rem); u.pn = w_ / rem; } else { u.pm = fm + (w_ % WGM); u.pn = w_ / WGM; }
        u.ko = 0; return true;
    }
    __device__ __forceinline__ void a_ready(const Unit&) const {}
    __device__ __forceinline__ void done(const Unit&) const {}
    __device__ __forceinline__ bool zero_after(const Unit&) const { return true; }
};

template <class Epi, class Sched, bool ALIGN_EPI = false, bool SP2 = false, bool F8 = false>
__device__ __forceinline__ void gemm_phase(PG8_LAS unsigned char* lds, const Gemm g, const Sched& S, const Epi& E, f32x4 (&acc)[2][2][4][2]) {
    int tid_ = threadIdx.x; asm volatile("" : "+v"(tid_));
    const int tid = tid_, wid = __builtin_amdgcn_readfirstlane(tid >> 6), lane = tid & 63, wr = wid >> 2, wc = wid & 3, fr = lane & 15, fq = lane >> 4;
    const int K = g.K, nt = K / BK;
    unsigned voffA[2], voffB[2];
#pragma unroll
    for (int i = 0; i < 2; ++i) { int R, C; stage_rc(tid * 16 + i * 8192, R, C); const int Rb = Epi::PERM ? ((R & ~31) + perm32(R & 31)) : R;
        voffA[i] = (unsigned)(R * g.lda + C) * 2u; voffB[i] = (unsigned)(Rb * g.ldb + C) * 2u; }
    const size_t kstep = (size_t)(BK * 2);
    const size_t hstepA = (size_t)HALF * g.lda * 2, hstepB = (size_t)HALF * g.ldb * 2;
    const size_t tstepA = 2 * hstepA, tstepB = 2 * hstepB;
    const unsigned ldsw = (unsigned)wid * 1024u;
    const int aoff = lds_byte(wr * 64 + fr, fq * 8), boff = lds_byte(wc * 32 + fr, fq * 8);
#define PG8_SA(b, h) (((b) * 2 + (h)) * HTB)
#define PG8_SB(b, h) ((4 + (b) * 2 + (h)) * HTB)
#define PG8_STAGE(bufoff, gbase, voff) do { _Pragma("unroll") for (int _i = 0; _i < 2; ++_i) \
        __builtin_amdgcn_global_load_lds((const unsigned*)((const char*)(gbase) + (voff)[_i]), (PG8_LAS unsigned*)(lds + (bufoff) + ldsw + _i * 8192), 16, 0, 0); } while (0)
#define PG8_LDA(dst, b, h) do { if constexpr (F8) { _Pragma("unroll") for (int m = 0; m < 4; ++m) dst##8[m] = __builtin_shufflevector(*(const PG8_LAS i32x4*)(lds + PG8_SA(b, h) + aoff + m * 2048), *(const PG8_LAS i32x4*)(lds + PG8_SA(b, h) + aoff + m * 2048 + 1024), 0, 1, 2, 3, 4, 5, 6, 7); } \
        else { _Pragma("unroll") for (int m = 0; m < 4; ++m) _Pragma("unroll") for (int k = 0; k < 2; ++k) dst[m][k] = *(const PG8_LAS bf16x8*)(lds + PG8_SA(b, h) + aoff + m * 2048 + k * 1024); } } while (0)
#define PG8_LDB(dst, b, h) do { if constexpr (F8) { _Pragma("unroll") for (int n = 0; n < 2; ++n) dst##8[n] = __builtin_shufflevector(*(const PG8_LAS i32x4*)(lds + PG8_SB(b, h) + boff + n * 2048), *(const PG8_LAS i32x4*)(lds + PG8_SB(b, h) + boff + n * 2048 + 1024), 0, 1, 2, 3, 4, 5, 6, 7); } \
        else { _Pragma("unroll") for (int n = 0; n < 2; ++n) _Pragma("unroll") for (int k = 0; k < 2; ++k) dst[n][k] = *(const PG8_LAS bf16x8*)(lds + PG8_SB(b, h) + boff + n * 2048 + k * 1024); } } while (0)
#define PG8_CAT8(x0, x1) __builtin_shufflevector(__builtin_bit_cast(i32x4, (x0)), __builtin_bit_cast(i32x4, (x1)), 0, 1, 2, 3, 4, 5, 6, 7)
#define PG8_MMA(ai, bj, At, Bt) do { __builtin_amdgcn_s_setprio(1); \
        if constexpr (F8) { _Pragma("unroll") for (int m = 0; m < 4; ++m) _Pragma("unroll") for (int n = 0; n < 2; ++n) \
            asm volatile("v_mfma_f32_16x16x128_f8f6f4 %0, %1, %2, %0" : "+v"(acc[ai][bj][m][n]) : "v"(Bt##8[n]), "v"(At##8[m])); }   \
        else { _Pragma("unroll") for (int m = 0; m < 4; ++m) _Pragma("unroll") for (int n = 0; n < 2; ++n) _Pragma("unroll") for (int k = 0; k < 2; ++k) \
            acc[ai][bj][m][n] = __builtin_amdgcn_mfma_f32_16x16x32_bf16(Bt[n][k], At[m][k], acc[ai][bj][m][n], 0, 0, 0); } \
        __builtin_amdgcn_s_setprio(0); } while (0)
#define PG8_WAIT_V(n) asm volatile("s_waitcnt vmcnt(" #n ")" ::: "memory")
#define PG8_WAIT_L(n) asm volatile("s_waitcnt lgkmcnt(" #n ")" ::: "memory")
#define PG8_BAR __builtin_amdgcn_s_barrier()
#define PG8_SCHED __builtin_amdgcn_sched_barrier(0)
    Unit cur, nxt; int ui = 0;
    if (!S.next(0, cur)) return;
    bf16x8 At[4][2], B0[2][2], B1[2][2];
    i32x8 At8[4], B08[2], B18[2];
    const char* cA = (const char*)g.A + (size_t)cur.pm * tstepA + (size_t)cur.ko * 2; const char* cB = (const char*)g.Bt + (size_t)cur.pn * tstepB + (size_t)cur.ko * 2;
    S.a_ready(cur);
    if constexpr (SP2) {
        PG8_STAGE(PG8_SB(0, 0), cB, voffB); PG8_STAGE(PG8_SB(0, 1), cB + hstepB, voffB); PG8_STAGE(PG8_SA(0, 0), cA, voffA); PG8_STAGE(PG8_SA(0, 1), cA + hstepA, voffA);
        if (wr == 1) PG8_BAR;
        PG8_WAIT_V(2); PG8_BAR;
        PG8_STAGE(PG8_SB(1, 0), cB + kstep, voffB); PG8_STAGE(PG8_SA(1, 0), cA + kstep, voffA); PG8_STAGE(PG8_SB(1, 1), cB + hstepB + kstep, voffB);
        PG8_WAIT_V(6); PG8_BAR;
    } else {
        PG8_STAGE(PG8_SB(0, 0), cB, voffB); PG8_STAGE(PG8_SA(0, 0), cA, voffA); PG8_STAGE(PG8_SB(0, 1), cB + hstepB, voffB); PG8_STAGE(PG8_SA(0, 1), cA + hstepA, voffA);
        if (wr == 1) PG8_BAR;
        PG8_WAIT_V(4); PG8_BAR;
        PG8_STAGE(PG8_SB(1, 0), cB + kstep, voffB); PG8_STAGE(PG8_SA(1, 0), cA + kstep, voffA); PG8_STAGE(PG8_SB(1, 1), cB + hstepB + kstep, voffB);
        PG8_WAIT_V(6); PG8_BAR;
    }
    for (;;) {
        const bool has_next = S.next(ui + 1, nxt);
        const char* nA = has_next ? (const char*)g.A + (size_t)nxt.pm * tstepA + (size_t)nxt.ko * 2 : cA; const char* nB = has_next ? (const char*)g.Bt + (size_t)nxt.pn * tstepB + (size_t)nxt.ko * 2 : cB;
        for (int t = 0; t < nt; t += 2) {
            const bool last = (t == nt - 2);
            const char* a1 = cA + (size_t)(t + 1) * kstep;
            const char* a2 = last ? nA : cA + (size_t)(t + 2) * kstep; const char* b2 = last ? nB : cB + (size_t)(t + 2) * kstep;
            const char* a3 = a2 + kstep; const char* b3 = b2 + kstep;
            if (last && has_next) S.a_ready(nxt);
            if constexpr (SP2) {
            PG8_LDB(B0, 0, 0); PG8_LDB(B1, 0, 1); PG8_SCHED; PG8_LDA(At, 0, 0); PG8_STAGE(PG8_SA(1, 1), a1 + hstepA, voffA);
            PG8_WAIT_V(8); PG8_WAIT_L(0); PG8_BAR; PG8_MMA(0, 0, At, B0); PG8_MMA(0, 1, At, B1); PG8_BAR; PG8_SCHED;
            PG8_LDA(At, 0, 1); PG8_STAGE(PG8_SB(0, 0), b2, voffB); PG8_STAGE(PG8_SB(0, 1), b2 + hstepB, voffB); PG8_STAGE(PG8_SA(0, 0), a2, voffA);
            PG8_WAIT_V(8); PG8_WAIT_L(0); PG8_BAR; PG8_MMA(1, 0, At, B0); PG8_MMA(1, 1, At, B1); PG8_BAR; PG8_SCHED;
            PG8_LDB(B0, 1, 0); PG8_LDB(B1, 1, 1); PG8_SCHED; PG8_LDA(At, 1, 0); PG8_STAGE(PG8_SA(0, 1), a2 + hstepA, voffA);
            PG8_WAIT_V(8); PG8_WAIT_L(0); PG8_BAR; PG8_MMA(0, 0, At, B0); PG8_MMA(0, 1, At, B1); PG8_BAR; PG8_SCHED;
            PG8_LDA(At, 1, 1); PG8_STAGE(PG8_SB(1, 0), b3, voffB); PG8_STAGE(PG8_SB(1, 1), b3 + hstepB, voffB); PG8_STAGE(PG8_SA(1, 0), a3, voffA);
            PG8_WAIT_V(8); PG8_WAIT_L(0); PG8_BAR; PG8_MMA(1, 0, At, B0); PG8_MMA(1, 1, At, B1); PG8_BAR; PG8_SCHED;
            } else {
            PG8_LDB(B0, 0, 0); PG8_SCHED; PG8_LDA(At, 0, 0); PG8_STAGE(PG8_SA(1, 1), a1 + hstepA, voffA);
            PG8_WAIT_L(8); PG8_BAR; PG8_WAIT_L(0); PG8_MMA(0, 0, At, B0); PG8_BAR; PG8_SCHED;
            PG8_LDB(B1, 0, 1); PG8_STAGE(PG8_SB(0, 0), b2, voffB);
            PG8_BAR; PG8_WAIT_L(0); PG8_MMA(0, 1, At, B1); PG8_BAR;
            PG8_LDA(At, 0, 1); PG8_STAGE(PG8_SA(0, 0), a2, voffA);
            PG8_BAR; PG8_WAIT_L(0); PG8_MMA(1, 0, At, B0); PG8_BAR; PG8_SCHED;
            PG8_STAGE(PG8_SB(0, 1), b2 + hstepB, voffB);
            PG8_WAIT_V(6); PG8_BAR; PG8_MMA(1, 1, At, B1); PG8_BAR;
            PG8_LDB(B0, 1, 0); PG8_SCHED; PG8_LDA(At, 1, 0); PG8_STAGE(PG8_SA(0, 1), a2 + hstepA, voffA);
            PG8_WAIT_L(8); PG8_BAR; PG8_WAIT_L(0); PG8_MMA(0, 0, At, B0); PG8_BAR; PG8_SCHED;
            PG8_LDB(B1, 1, 1); PG8_STAGE(PG8_SB(1, 0), b3, voffB);
            PG8_BAR; PG8_WAIT_L(0); PG8_MMA(0, 1, At, B1); PG8_BAR;
            PG8_LDA(At, 1, 1); PG8_STAGE(PG8_SA(1, 0), a3, voffA);
            PG8_BAR; PG8_WAIT_L(0); PG8_MMA(1, 0, At, B0); PG8_BAR; PG8_SCHED;
            PG8_STAGE(PG8_SB(1, 1), b3 + hstepB, voffB);
            PG8_WAIT_V(6); PG8_BAR; PG8_MMA(1, 1, At, B1); PG8_BAR;
            }
        }
        if constexpr (ALIGN_EPI) { if (wr == 0) PG8_BAR; }
        if constexpr (F8) {
            asm volatile("s_nop 15\n\ts_nop 15\n\ts_nop 7" : "+v"(acc[0][0][0][0]), "+v"(acc[0][0][0][1]), "+v"(acc[0][0][1][0]), "+v"(acc[0][0][1][1]), "+v"(acc[0][0][2][0]), "+v"(acc[0][0][2][1]), "+v"(acc[0][0][3][0]), "+v"(acc[0][0][3][1]), "+v"(acc[0][1][0][0]), "+v"(acc[0][1][0][1]), "+v"(acc[0][1][1][0]), "+v"(acc[0][1][1][1]), "+v"(acc[0][1][2][0]), "+v"(acc[0][1][2][1]), "+v"(acc[0][1][3][0]), "+v"(acc[0][1][3][1]));
            asm volatile("" : "+v"(acc[1][0][0][0]), "+v"(acc[1][0][0][1]), "+v"(acc[1][0][1][0]), "+v"(acc[1][0][1][1]), "+v"(acc[1][0][2][0]), "+v"(acc[1][0][2][1]), "+v"(acc[1][0][3][0]), "+v"(acc[1][0][3][1]), "+v"(acc[1][1][0][0]), "+v"(acc[1][1][0][1]), "+v"(acc[1][1][1][0]), "+v"(acc[1][1][1][1]), "+v"(acc[1][1][2][0]), "+v"(acc[1][1][2][1]), "+v"(acc[1][1][3][0]), "+v"(acc[1][1][3][1])); }
        if constexpr (!Epi::AFTER_DRAIN) { E(acc, cur, wr, wc, fr, fq); S.done(cur); }
        if (!has_next) break;
        if (S.zero_after(cur)) {
#pragma unroll
        for (int a = 0; a < 2; ++a)
#pragma unroll
            for (int b = 0; b < 2; ++b)
#pragma unroll
                for (int m = 0; m < 4; ++m)
#pragma unroll
                    for (int n = 0; n < 2; ++n) acc[a][b][m][n] = (f32x4){0.f, 0.f, 0.f, 0.f};
        }
        cur = nxt; cA = nA; cB = nB; ++ui;
        if constexpr (ALIGN_EPI) { if (wr == 1) PG8_BAR; }
    }
    PG8_WAIT_V(0);
    if constexpr (!ALIGN_EPI) { if (wr == 0) PG8_BAR; }
    PG8_BAR;
    if constexpr (Epi::AFTER_DRAIN) { E.fused(acc, cur, wr, wc, fr, fq, lds, wid, lane); S.done(cur); }
#undef PG8_SA
#undef PG8_SB
#undef PG8_STAGE
#undef PG8_LDA
#undef PG8_LDB
#undef PG8_MMA
#undef PG8_CAT8
#undef PG8_WAIT_V
#undef PG8_WAIT_L
#undef PG8_BAR
#undef PG8_SCHED
}
}
#ifndef REP_IN
#define REP_IN 1
#endif
#ifndef REP_BR
#define REP_BR 1
#endif
#ifndef REP_OUT
#define REP_OUT 1
#endif
#ifndef REP_FIN
#define REP_FIN 1
#endif
#ifndef GEMM_STREAM
#define GEMM_STREAM 3
#endif
#ifndef REP_J0
#define REP_J0 1
#endif
#ifndef REP_J1
#define REP_J1 1
#endif
#ifndef REP_J2
#define REP_J2 1
#endif
#ifndef REP_SCAN
#define REP_SCAN 1
#endif
#ifndef REP_P0
#define REP_P0 1
#endif
#ifndef SEG0
#define SEG0 0
#endif
#ifndef GATELESS
#define GATELESS 1
#endif
#ifndef GEMM_ONEUNIT
#define GEMM_ONEUNIT 1
#endif
#ifndef DIAGSEL
#define DIAGSEL 4095
#endif
#ifndef NO_T4
#define NO_T4 0
#endif
#ifndef NO_T5
#define NO_T5 0
#endif
#ifndef NO_T6
#define NO_T6 0
#endif
#ifndef DIAG_SIMPLE
#define DIAG_SIMPLE 0
#endif
#ifndef GEMM_ALIGN
#define GEMM_ALIGN true
#endif
#ifndef GEMM_SP2
#define GEMM_SP2 true
#endif
#ifndef PHM
#define PHM 127
#endif
#ifndef JOBM
#define JOBM 7
#endif

#define GAS __attribute__((address_space(1)))
#define LAS __attribute__((address_space(3)))
typedef unsigned short bf16;
typedef short bf16x8 __attribute__((ext_vector_type(8)));
typedef short bf16x4 __attribute__((ext_vector_type(4)));
typedef float f32x4 __attribute__((ext_vector_type(4)));
typedef unsigned u32x4 __attribute__((ext_vector_type(4)));
typedef unsigned u32x2 __attribute__((ext_vector_type(2)));
#define DI __device__ __forceinline__
#define LDS_WAIT() asm volatile("s_waitcnt lgkmcnt(0)" ::: "memory")
typedef float f32x2_t __attribute__((ext_vector_type(2)));
typedef __bf16 bf16x2_t __attribute__((ext_vector_type(2)));
DI unsigned pk2(float lo, float hi) { const f32x2_t v = {lo, hi}; const bf16x2_t b = __builtin_convertvector(v, bf16x2_t); return __builtin_bit_cast(unsigned, b); }
DI unsigned pk4f8(float a, float b, float c, float d) { int w = 0; w = __builtin_amdgcn_cvt_pk_fp8_f32(a, b, w, false); w = __builtin_amdgcn_cvt_pk_fp8_f32(c, d, w, true); return (unsigned)w; }
DI unsigned pk4u8(float a, float b, float c, float d) { unsigned w = 0u; w = __builtin_amdgcn_cvt_pk_u8_f32(a, 0, w); w = __builtin_amdgcn_cvt_pk_u8_f32(b, 1, w); w = __builtin_amdgcn_cvt_pk_u8_f32(c, 2, w); w = __builtin_amdgcn_cvt_pk_u8_f32(d, 3, w); return w; }
DI float ub0(unsigned w) { return (float)(w & 0xffu); }
DI float ub1(unsigned w) { return (float)((w >> 8) & 0xffu); }
DI float ub2(unsigned w) { return (float)((w >> 16) & 0xffu); }
DI float ub3(unsigned w) { return (float)(w >> 24); }
DI bf16 f2bf(float f) { return (bf16)(pk2(f, 0.f) & 0xffffu); }
DI float bf2f(unsigned b) { return __uint_as_float(b << 16); }
DI float bflo(unsigned w) { return __uint_as_float(w << 16); }
DI float bfhi(unsigned w) { return __uint_as_float(w & 0xffff0000u); }
DI float sigmoidf_(float x) { return __builtin_amdgcn_rcpf(1.0f + __expf(-x)); }
DI float siluf_(float x) { return x * sigmoidf_(x); }
DI float wave_sum(float v) {
#pragma unroll
    for (int o = 1; o < 64; o <<= 1) v += __shfl_xor(v, o);
    return v;
}
#define MFMA16(a, b, c) __builtin_amdgcn_mfma_f32_16x16x32_bf16((a), (b), (c), 0, 0, 0)

constexpr int DM = 4096, MP = 8192, MS_ = 256, MT = 8448;
constexpr int BW = 2048;
constexpr int NIN = 30976;
constexpr int KBR = 6144;
constexpr float EPS = 1e-6f;
constexpr int NWAVES = 8, NTHR = 512;
constexpr int LDS_BYTES = 147456;
constexpr int MISC_OFF = LDS_BYTES - 256;

constexpr size_t O_YP = 0, O_YS = 33554432, O_HGP = 34603008, O_HGS = 36700160, O_LHP = 40894464, O_LHS = 40910848,
                 O_LCP = 40943616, O_LCS = 40992768, O_GLP = 41091072, O_GLS = 45285376, O_END = 53673984;

constexpr size_t MiB = 1u << 20;
constexpr size_t alup(size_t x) { return (x + MiB - 1) / MiB * MiB; }
constexpr size_t WS_CTL = 0, CTL_ZERO_BYTES = MiB;
constexpr size_t SZ_WIN = alup((size_t)NIN * DM * 2), SZ_WBR = alup((size_t)DM * KBR * 2), SZ_WOU = alup((size_t)DM * DM * 2);
constexpr size_t WS_WIN = MiB, WS_WBR = WS_WIN + 2 * SZ_WIN, WS_WOU = WS_WBR + 2 * SZ_WBR;
constexpr size_t WS_Z = WS_WOU + 2 * SZ_WOU;
constexpr size_t WS_HQ = WS_Z + alup((size_t)MT * DM * 2);
constexpr size_t WS_HG = WS_HQ + alup((size_t)MT * BW * 2);
constexpr size_t WS_HV = WS_HG + alup((size_t)MT * BW * 4);
constexpr size_t WS_HGATE = WS_HV + alup((size_t)MT * BW * 2);
constexpr size_t WS_LX = WS_HGATE + alup((size_t)MT * BW * 2);
constexpr size_t WS_LGATE = WS_LX + alup((size_t)MT * BW * 4);
constexpr size_t WS_CQ = WS_LGATE + alup((size_t)MT * BW * 2);
constexpr size_t WS_CK = WS_CQ + alup((size_t)MT * 1024 * 2);
constexpr size_t WS_CV = WS_CK + alup((size_t)MT * 1024 * 2);
constexpr size_t WS_CGATE = WS_CV + alup((size_t)MT * BW * 2);
constexpr size_t WS_MG = WS_CGATE + alup((size_t)MT * BW * 2);
constexpr size_t WS_CLR = WS_MG + alup((size_t)MT * 12288 * 2);
constexpr size_t WS_Y = WS_CLR + alup((size_t)MT * 16 * 4);
constexpr size_t WS_OC = WS_Y + alup((size_t)MT * KBR * 2);
constexpr size_t WS_SSQ = WS_OC + alup((size_t)MT * 2 * BW * 4);
constexpr size_t WS_MERGED = WS_SSQ + alup((size_t)MT * 32 * 4);
constexpr size_t WS_MB = WS_MERGED + alup((size_t)MT * DM * 4);
constexpr size_t WS_OUT = WS_MB + alup((size_t)MT * DM * 2);
constexpr size_t WS_X1 = WS_OUT + alup((size_t)MT * DM * 4);
constexpr size_t WS_PB = WS_X1 + alup((size_t)MT * DM * 4);
constexpr size_t WS_PO = WS_PB + alup((size_t)3 * 256 * DM * 4);
constexpr int NCHK = 136;
constexpr size_t WS_GQT = WS_PO + alup((size_t)4 * 256 * DM * 4);
constexpr size_t WS_GKT = WS_GQT + alup((size_t)MT * 1024 * 2);
constexpr size_t WS_GKH = WS_GKT + alup((size_t)MT * 1024 * 2);
constexpr size_t WS_GER = WS_GKH + alup((size_t)NCHK * 1024 * 64 * 2);
constexpr size_t WS_GEB = WS_GER + alup((size_t)NCHK * 1024 * 4);
constexpr size_t WS_Z8 = WS_GEB + alup((size_t)NCHK * 1024 * 4);
constexpr size_t SZ_W8 = alup((size_t)12288 * DM);
constexpr size_t WS_W8 = WS_Z8 + alup((size_t)MT * DM);
constexpr size_t WS_END = WS_W8 + 2 * SZ_W8;
constexpr int CW_BAR = 4096;
constexpr int CW_TEAM = 16384;

#define XB_TMO      128
#define XB_XCNT(j)  (256  + 64 * (j))
#define XB_XSUB(j)  (1280 + 64 * (j))
#define XB_XGEN(j)  (2304 + 64 * (j))
#define XB_TOP      3328
#define XB_TOPGEN   3392
#define XCD_BAR_WORDS 3456
#define XB_SPIN_CAP (1u << 18)
__device__ __forceinline__ unsigned xb_ld(unsigned* p)              { return __hip_atomic_load(p, __ATOMIC_RELAXED, __HIP_MEMORY_SCOPE_AGENT); }
__device__ __forceinline__ unsigned xb_add(unsigned* p, unsigned v) { return __hip_atomic_fetch_add(p, v, __ATOMIC_RELAXED, __HIP_MEMORY_SCOPE_AGENT); }
__device__ __forceinline__ unsigned xb_xcc_id() { return (unsigned)__builtin_amdgcn_s_getreg((3 << 11) | 20) & 0xFu; }
#define XB_SPIN(cond, bar) do { unsigned _sp = 0; while (cond) { __builtin_amdgcn_s_sleep(1); \
    if ((++_sp & 255u) == 0u) { if (xb_ld(&(bar)[XB_TMO])) break; if (_sp > XB_SPIN_CAP) { atomicAdd(&(bar)[XB_TMO], 1u); break; } } } } while (0)
struct XcdBarrier { unsigned* bar; unsigned x; volatile LAS unsigned* st; };
__device__ __forceinline__ XcdBarrier xcd_barrier_post(unsigned* bar, volatile LAS unsigned* st) {
    XcdBarrier b; b.bar = bar; b.x = xb_xcc_id(); b.st = st;
    if (threadIdx.x == 0) (void)xb_add(&bar[XB_XCNT(b.x)], 1u);
    return b;
}
__device__ __forceinline__ void xcd_barrier_complete(unsigned* bar, unsigned x, unsigned& nloc, unsigned& nx) {
    const unsigned G = gridDim.x * gridDim.y * gridDim.z;
    unsigned sum, cnt, mine, sp = 0u;
    for (;;) {
        sum = 0u; cnt = 0u; mine = 0u;
#pragma unroll
        for (unsigned j = 0; j < 16; ++j) { const unsigned c = xb_ld(&bar[XB_XCNT(j)]); sum += c; cnt += (c > 0u) ? 1u : 0u; mine = (j == x) ? c : mine; }
        if (sum == G) break;
        __builtin_amdgcn_s_sleep(1);
        if ((++sp & 255u) == 0u) { if (xb_ld(&bar[XB_TMO])) break; if (sp > XB_SPIN_CAP) { atomicAdd(&bar[XB_TMO], 1u); break; } }
    }
    nloc = mine > 0u ? mine : 1u; nx = cnt > 0u ? cnt : 1u;
}
__device__ __forceinline__ void xcd_barrier(const XcdBarrier& b) {
    asm volatile("s_waitcnt vmcnt(0)" ::: "memory");
    __syncthreads();
    if (threadIdx.x == 0) {
        unsigned* bar = b.bar;
        __builtin_amdgcn_s_waitcnt(0);
        unsigned nloc = b.st[0], nx = b.st[1];
        if (nloc == 0u) { xcd_barrier_complete(bar, b.x, nloc, nx); b.st[0] = nloc; b.st[1] = nx; }
        const unsigned old = xb_add(&bar[XB_XSUB(b.x)], 1u);
        const unsigned gen = old / nloc;
        if (old + 1u == (gen + 1u) * nloc) {
            __builtin_amdgcn_fence(__ATOMIC_RELEASE, "agent");
            asm volatile("s_waitcnt vmcnt(0)" ::: "memory");
            const unsigned og = xb_add(&bar[XB_TOP], 1u);
            const unsigned tg = og / nx;
            if (og + 1u == (tg + 1u) * nx) xb_add(&bar[XB_TOPGEN], 1u);
            else XB_SPIN(xb_ld(&bar[XB_TOPGEN]) == tg, bar);
            __builtin_amdgcn_fence(__ATOMIC_ACQUIRE, "agent");
            xb_add(&bar[XB_XGEN(b.x)], 1u);
            asm volatile("s_waitcnt vmcnt(0)" ::: "memory");
        } else {
            XB_SPIN(xb_ld(&bar[XB_XGEN(b.x)]) == gen, bar);
            __builtin_amdgcn_fence(__ATOMIC_ACQUIRE, "agent");
            asm volatile("s_waitcnt vmcnt(0)" ::: "memory");
        }
    }
    __syncthreads();
}

typedef pg8::f32x4 af4;
struct EpiInProj {
    static constexpr bool PERM = true, AFTER_DRAIN = true;
    DI void fused(af4 (&acc)[2][2][4][2], const pg8::Unit& u, int wr, int wc, int fr, int fq, LAS unsigned char*, int, int) const { (*this)(acc, u, wr, wc, fr, fq); }
    bf16 *HQ, *HV, *HGATE, *LGATE, *CQ, *CK, *CV, *CGATE; unsigned char* MG; float *HG, *LX, *CLR; const float* lbl; int layer; float mgs;
    template <int T> DI void body(const af4 (&acc)[2][2][4][2], void* base, const int ld, const int row0, const int col0) const {
        af4 lbv[2][2];
        if (T == 5) {
#pragma unroll
            for (int bj = 0; bj < 2; ++bj)
#pragma unroll
                for (int hh = 0; hh < 2; ++hh) { const af4 a0 = *(const af4*)(lbl + col0 + bj * 128 + 4 * hh), a1 = *(const af4*)(lbl + BW + col0 + bj * 128 + 4 * hh);
#pragma unroll
                    for (int j = 0; j < 4; ++j) { const float mx = fmaxf(a0[j], a1[j]); const float e0 = __expf(a0[j] - mx), e1 = __expf(a1[j] - mx); lbv[bj][hh][j] = layer ? e1 / (e0 + e1) : 0.f; } }
        }
        if (T == 2) {
            int c0 = col0; asm volatile("" : "+v"(c0)); const int odd = (c0 >> 3) & 1;
#pragma unroll
            for (int ai = 0; ai < 2; ++ai)
#pragma unroll
                for (int mp = 0; mp < 2; ++mp)
#pragma unroll
                    for (int bj = 0; bj < 2; ++bj) {
                        unsigned px[2], py[2];
#pragma unroll
                        for (int h = 0; h < 2; ++h) { af4 v0 = acc[ai][bj][2 * mp + h][0], v1 = acc[ai][bj][2 * mp + h][1];
#pragma unroll
                            for (int j = 0; j < 4; ++j) { v0[j] = fmaxf(sigmoidf_(v0[j] * mgs) * 255.0f + 0.5f, 1.0f); v1[j] = fmaxf(sigmoidf_(v1[j] * mgs) * 255.0f + 0.5f, 1.0f); }
                            px[h] = pk4u8(v0[0], v0[1], v0[2], v0[3]); py[h] = pk4u8(v1[0], v1[1], v1[2], v1[3]); __builtin_amdgcn_sched_barrier(0); }
                        const auto rx = __builtin_amdgcn_permlane16_swap(px[0], px[1], false, false); const auto ry = __builtin_amdgcn_permlane16_swap(py[0], py[1], false, false);
                        u32x4 o; o.x = rx[0]; o.y = ry[0]; o.z = rx[1]; o.w = ry[1];
                        *(u32x4*)((unsigned char*)base + (size_t)(row0 + ai * 128 + (2 * mp + odd) * 16) * ld + (c0 - 8 * odd) + bj * 128) = o;
                    }
            return;
        }
#pragma unroll
        for (int ai = 0; ai < 2; ++ai)
#pragma unroll
            for (int m = 0; m < 4; ++m) {
                const size_t rowoff = (size_t)(row0 + ai * 128 + m * 16) * ld;
#pragma unroll
                for (int bj = 0; bj < 2; ++bj) {
                    af4 v0 = acc[ai][bj][m][0], v1 = acc[ai][bj][m][1];
                    const int col = col0 + bj * 128;
                    if (T <= 3) {
#pragma unroll
                        for (int j = 0; j < 4; ++j) {
                            if (T == 1) { v0[j] = siluf_(v0[j]); v1[j] = siluf_(v1[j]); }
                            if (T == 2) { v0[j] = sigmoidf_(v0[j] * mgs); v1[j] = sigmoidf_(v1[j] * mgs); }
                            if (T == 3) { v0[j] *= 0.0625f; v1[j] *= 0.0625f; }
                        }
                        if (T == 2) {
#pragma unroll
                            for (int j = 0; j < 4; ++j) { v0[j] = fmaxf(v0[j] * 255.0f + 0.5f, 1.0f); v1[j] = fmaxf(v1[j] * 255.0f + 0.5f, 1.0f); }
                            u32x2 o; o.x = pk4u8(v0[0], v0[1], v0[2], v0[3]); o.y = pk4u8(v1[0], v1[1], v1[2], v1[3]);
                            *(u32x2*)((unsigned char*)base + rowoff + col) = o;
                        } else {
                        u32x4 o; o.x = pk2(v0[0], v0[1]); o.y = pk2(v0[2], v0[3]); o.z = pk2(v1[0], v1[1]); o.w = pk2(v1[2], v1[3]);
                        *(u32x4*)((bf16*)base + rowoff + col) = o; }
                    } else if (T == 4) {
                        float* p = (float*)base + rowoff + col; *(af4*)p = v0; *(af4*)(p + 4) = v1;
                    } else if (T == 5) {
#pragma unroll
                        for (int j = 0; j < 4; ++j) {
                            const float l0 = lbv[bj][0][j], l1 = lbv[bj][1][j];
                            v0[j] = __logf(fmaxf(l0 + (1.0f - l0) * sigmoidf_(v0[j]), 1e-6f));
                            v1[j] = __logf(fmaxf(l1 + (1.0f - l1) * sigmoidf_(v1[j]), 1e-6f));
                        }
                        float* p = (float*)base + rowoff + col; *(af4*)p = v0; *(af4*)(p + 4) = v1;
                    } else {
                        if (col < 16) { float* p = (float*)base + rowoff + col; *(af4*)p = v0; *(af4*)(p + 4) = v1; }
                    }
                }
            }
    }
    DI void operator()(const af4 (&acc)[2][2][4][2], const pg8::Unit& u, int wr, int wc, int fr, int fq) const {
        const int row0 = u.pm * 256 + wr * 64 + fr, cl = wc * 32 + 8 * fq, pn = u.pn;
        if (pn < 8)        body<1>(acc, HQ, BW, row0, pn * 256 + cl);
        else if (pn < 16)  body<(NO_T5 ? (NO_T4 ? 0 : 4) : 5)>(acc, HG, BW, row0, (pn - 8) * 256 + cl);
        else if (pn < 24)  body<0>(acc, HV, BW, row0, (pn - 16) * 256 + cl);
        else if (pn < 32)  body<1>(acc, HGATE, BW, row0, (pn - 24) * 256 + cl);
        else if (pn < 40)  body<(NO_T4 ? 0 : 4)>(acc, LX, BW, row0, (pn - 32) * 256 + cl);
        else if (pn < 48)  body<1>(acc, LGATE, BW, row0, (pn - 40) * 256 + cl);
        else if (pn < 52)  body<3>(acc, CQ, 1024, row0, (pn - 48) * 256 + cl);
        else if (pn < 56)  body<0>(acc, CK, 1024, row0, (pn - 52) * 256 + cl);
        else if (pn < 64)  body<0>(acc, CV, BW, row0, (pn - 56) * 256 + cl);
        else if (pn < 72)  body<1>(acc, CGATE, BW, row0, (pn - 64) * 256 + cl);
        else if (pn < 120) body<2>(acc, MG, 12288, row0, (pn - 72) * 256 + cl);
        else               { if (!NO_T6) body<6>(acc, CLR, 16, row0, cl); }
    }
};
struct EpiBranchSeg {
    static constexpr bool PERM = true, AFTER_DRAIN = true;
    const unsigned char* MG; bf16* MB; int seg;
    DI void operator()(af4 (&acc)[2][2][4][2], const pg8::Unit& u, int wr, int wc, int fr, int fq) const { const EpiBranchSeg E2{MG, MB, u.ko / BW}; E2.fused(acc, u, wr, wc, fr, fq, nullptr, 0, 0); }
    DI void fused(af4 (&acc)[2][2][4][2], const pg8::Unit& u, int wr, int wc, int fr, int fq, LAS unsigned char*, int, int) const {
        int fqz = fq; asm volatile("" : "+v"(fqz));
        const int odd = fqz & 1;
        const size_t row0 = (size_t)(u.pm * 256 + wr * 64 + fr); const int col0 = u.pn * 256 + wc * 32 + 8 * fqz;
        const unsigned char* gp = MG + (row0 + 16 * odd) * 12288 + (size_t)seg * DM + (col0 - 8 * odd);
#define EB_PTR(p_) (gp + (size_t)((((p_) >> 2) & 1) * 128 + (((p_) >> 1) & 1) * 32) * 12288 + ((p_) & 1) * 128)
#define EB_SPLIT(L_, G0_, G1_) do { const auto rx_ = __builtin_amdgcn_permlane16_swap((L_).x, (L_).z, false, false); const auto ry_ = __builtin_amdgcn_permlane16_swap((L_).y, (L_).w, false, false); \
            G0_.x = rx_[0]; G0_.y = ry_[0]; G1_.x = rx_[1]; G1_.y = ry_[1]; } while (0)
        if (seg < 2) {
            u32x4 a0 = *(const u32x4*)EB_PTR(0), b0 = *(const u32x4*)(EB_PTR(0) + DM), a1 = *(const u32x4*)EB_PTR(1), b1 = *(const u32x4*)(EB_PTR(1) + DM);
#pragma unroll
            for (int p = 0; p < 8; ++p) {
                u32x4 a2 = a1, b2 = b1;
                if (p + 2 < 8) { a2 = *(const u32x4*)EB_PTR(p + 2); b2 = *(const u32x4*)(EB_PTR(p + 2) + DM); }
                u32x2 ga[2], gb[2]; EB_SPLIT(a0, ga[0], ga[1]); EB_SPLIT(b0, gb[0], gb[1]);
#pragma unroll
                for (int h = 0; h < 2; ++h) {
                    af4& v0 = acc[(p >> 2) & 1][p & 1][((p >> 1) & 1) * 2 + h][0]; af4& v1 = acc[(p >> 2) & 1][p & 1][((p >> 1) & 1) * 2 + h][1];
                    v0[0] *= ub0(ga[h].x) * __builtin_amdgcn_rcpf(ub0(gb[h].x)); v0[1] *= ub1(ga[h].x) * __builtin_amdgcn_rcpf(ub1(gb[h].x));
                    v0[2] *= ub2(ga[h].x) * __builtin_amdgcn_rcpf(ub2(gb[h].x)); v0[3] *= ub3(ga[h].x) * __builtin_amdgcn_rcpf(ub3(gb[h].x));
                    v1[0] *= ub0(ga[h].y) * __builtin_amdgcn_rcpf(ub0(gb[h].y)); v1[1] *= ub1(ga[h].y) * __builtin_amdgcn_rcpf(ub1(gb[h].y));
                    v1[2] *= ub2(ga[h].y) * __builtin_amdgcn_rcpf(ub2(gb[h].y)); v1[3] *= ub3(ga[h].y) * __builtin_amdgcn_rcpf(ub3(gb[h].y));
                    asm volatile("" : "+v"(v0), "+v"(v1) :: "memory");
                }
                asm volatile("" : "+v"(a1), "+v"(b1), "+v"(a2), "+v"(b2) :: "memory");
                a0 = a1; b0 = b1; a1 = a2; b1 = b2;
            }
        } else {
            constexpr float Q = 1.0f / 255.0f;
            u32x4 a0 = *(const u32x4*)EB_PTR(0), a1 = *(const u32x4*)EB_PTR(1);
#pragma unroll
            for (int p = 0; p < 8; ++p) {
                u32x4 a2 = a1;
                if (p + 2 < 8) a2 = *(const u32x4*)EB_PTR(p + 2);
                u32x2 gw[2]; EB_SPLIT(a0, gw[0], gw[1]);
#pragma unroll
                for (int h = 0; h < 2; ++h) {
                    const int m = ((p >> 1) & 1) * 2 + h; const size_t ro = (size_t)(((p >> 2) & 1) * 128 + m * 16);
                    af4 v0 = acc[(p >> 2) & 1][p & 1][m][0], v1 = acc[(p >> 2) & 1][p & 1][m][1];
                    v0[0] *= ub0(gw[h].x) * Q; v0[1] *= ub1(gw[h].x) * Q; v0[2] *= ub2(gw[h].x) * Q; v0[3] *= ub3(gw[h].x) * Q;
                    v1[0] *= ub0(gw[h].y) * Q; v1[1] *= ub1(gw[h].y) * Q; v1[2] *= ub2(gw[h].y) * Q; v1[3] *= ub3(gw[h].y) * Q;
                    u32x4 o; o.x = pk2(v0[0], v0[1]); o.y = pk2(v0[2], v0[3]); o.z = pk2(v1[0], v1[1]); o.w = pk2(v1[2], v1[3]);
                    *(u32x4*)(MB + (row0 + ro) * DM + col0 + (p & 1) * 128) = o;
                }
                asm volatile("" : "+v"(a1), "+v"(a2) :: "memory");
                a0 = a1; a1 = a2;
            }
        }
#undef EB_SPLIT
#undef EB_PTR
    }
};
struct EpiGateSlab {
    static constexpr bool PERM = true, AFTER_DRAIN = true;
    const unsigned char* MG; float* PB; int seg;
    DI void fused(af4 (&acc)[2][2][4][2], const pg8::Unit& u, int wr, int wc, int fr, int fq, LAS unsigned char*, int, int) const {
        const size_t row0 = (size_t)(u.pm * 256 + wr * 64 + fr); const int col0 = u.pn * 256 + wc * 32 + 8 * fq;
        const unsigned char* gp = MG + row0 * 12288 + (size_t)seg * DM + col0;
        float* pb = PB + ((size_t)seg * 256 + (size_t)(wr * 64 + fr)) * DM + col0;
#pragma unroll
        for (int ai = 0; ai < 2; ++ai)
#pragma unroll
            for (int m = 0; m < 4; ++m) {
#pragma unroll
                for (int bj = 0; bj < 2; ++bj) {
                    const size_t ro = (size_t)(ai * 128 + m * 16);
                    const u32x2 gw = *(const u32x2*)(gp + ro * 12288 + bj * 128); constexpr float Q = 1.0f / 255.0f;
                    af4 v0 = acc[ai][bj][m][0], v1 = acc[ai][bj][m][1];
                    v0[0] *= ub0(gw.x) * Q; v0[1] *= ub1(gw.x) * Q; v0[2] *= ub2(gw.x) * Q; v0[3] *= ub3(gw.x) * Q;
                    v1[0] *= ub0(gw.y) * Q; v1[1] *= ub1(gw.y) * Q; v1[2] *= ub2(gw.y) * Q; v1[3] *= ub3(gw.y) * Q;
                    float* q = pb + ro * DM + bj * 128; *(af4*)q = v0; *(af4*)(q + 4) = v1;
                    asm volatile("" ::: "memory");
                }
            }
    }
};
struct EpiSimple {
    static constexpr bool PERM = true, AFTER_DRAIN = true;
    DI void fused(af4 (&acc)[2][2][4][2], const pg8::Unit& u, int wr, int wc, int fr, int fq, LAS unsigned char*, int, int) const { (*this)(acc, u, wr, wc, fr, fq); }
    bf16* O; int ldc;
    DI void operator()(const af4 (&acc)[2][2][4][2], const pg8::Unit& u, int wr, int wc, int fr, int fq) const {
        const int row0 = u.pm * 256 + wr * 64 + fr, col0 = u.pn * 256 + wc * 32 + 8 * fq;
#pragma unroll
        for (int ai = 0; ai < 2; ++ai)
#pragma unroll
            for (int m = 0; m < 4; ++m) {
                bf16* rp = O + (size_t)(row0 + ai * 128 + m * 16) * ldc + col0;
#pragma unroll
                for (int bj = 0; bj < 2; ++bj) { af4 v0 = acc[ai][bj][m][0], v1 = acc[ai][bj][m][1];
#pragma unroll
                    for (int j = 0; j < 4; ++j) { v0[j] = siluf_(v0[j]); v1[j] = siluf_(v1[j]); }
                    u32x4 o; o.x = pk2(v0[0], v0[1]); o.y = pk2(v0[2], v0[3]); o.z = pk2(v1[0], v1[1]); o.w = pk2(v1[2], v1[3]); *(u32x4*)(rp + bj * 128) = o; }
            }
    }
};
struct EpiBf {
    static constexpr bool PERM = true, AFTER_DRAIN = true;
    DI void fused(af4 (&acc)[2][2][4][2], const pg8::Unit& u, int wr, int wc, int fr, int fq, LAS unsigned char*, int, int) const { (*this)(acc, u, wr, wc, fr, fq); }
    bf16* O; int ldc;
    DI void operator()(const af4 (&acc)[2][2][4][2], const pg8::Unit& u, int wr, int wc, int fr, int fq) const {
        const int row0 = u.pm * 256 + wr * 64 + fr, col0 = u.pn * 256 + wc * 32 + 8 * fq;
#pragma unroll
        for (int ai = 0; ai < 2; ++ai)
#pragma unroll
            for (int m = 0; m < 4; ++m) {
                bf16* rp = O + (size_t)(row0 + ai * 128 + m * 16) * ldc + col0;
#pragma unroll
                for (int bj = 0; bj < 2; ++bj) { const af4 v0 = acc[ai][bj][m][0], v1 = acc[ai][bj][m][1];
                    u32x4 o; o.x = pk2(v0[0], v0[1]); o.y = pk2(v0[2], v0[3]); o.z = pk2(v1[0], v1[1]); o.w = pk2(v1[2], v1[3]); *(u32x4*)(rp + bj * 128) = o; }
            }
    }
};
struct EpiF32 {
    static constexpr bool PERM = true, AFTER_DRAIN = true;
    DI void fused(af4 (&acc)[2][2][4][2], const pg8::Unit& u, int wr, int wc, int fr, int fq, LAS unsigned char*, int, int) const { (*this)(acc, u, wr, wc, fr, fq); }
    float* C; int ldc;
    DI void operator()(const af4 (&acc)[2][2][4][2], const pg8::Unit& u, int wr, int wc, int fr, int fq) const {
        const int row0 = u.pm * 256 + wr * 64 + fr, col0 = u.pn * 256 + wc * 32 + 8 * fq;
#pragma unroll
        for (int ai = 0; ai < 2; ++ai)
#pragma unroll
            for (int m = 0; m < 4; ++m) {
                float* rp = C + (size_t)(row0 + ai * 128 + m * 16) * ldc + col0;
#pragma unroll
                for (int bj = 0; bj < 2; ++bj) { *(af4*)(rp + bj * 128) = acc[ai][bj][m][0]; *(af4*)(rp + bj * 128 + 4) = acc[ai][bj][m][1]; }
            }
    }
};

struct OneUnit {
    pg8::StaticOrder S; int i;
    DI bool next(int k, pg8::Unit& u) const { return k == 0 ? S.next(i, u) : false; }
    DI void a_ready(const pg8::Unit&) const {}
    DI void done(const pg8::Unit&) const {}
    DI bool zero_after(const pg8::Unit&) const { return true; }
};
struct InOrderA {
    pg8::StaticOrder S;
    DI bool next(int i, pg8::Unit& u) const { if (!S.next(i, u)) return false; if (u.pn == 72) u.pn = 120; return true; }
    DI void a_ready(const pg8::Unit&) const {}
    DI void done(const pg8::Unit&) const {}
    DI bool zero_after(const pg8::Unit&) const { return true; }
};
struct InOrder8 {
    pg8::StaticOrder S;
    DI bool next(int i, pg8::Unit& u) const { if (!S.next(i, u)) return false; u.pn += 72; return true; }
    DI void a_ready(const pg8::Unit&) const {}
    DI void done(const pg8::Unit&) const {}
    DI bool zero_after(const pg8::Unit&) const { return true; }
};
struct BranchOrder {
    pg8::StaticOrder S;
    DI bool next(int i, pg8::Unit& u) const { const int t = i / 3; if (!S.next(t, u)) return false; u.ko = (i - 3 * t) * BW; return true; }
    DI void a_ready(const pg8::Unit&) const {}
    DI void done(const pg8::Unit&) const {}
    DI bool zero_after(const pg8::Unit& u) const { return u.ko == 2 * BW; }
};
struct FixedUnit {
    pg8::Unit u0;
    DI bool next(int k, pg8::Unit& u) const { u = u0; return k == 0; }
    DI void a_ready(const pg8::Unit&) const {}
    DI void done(const pg8::Unit&) const {}
    DI bool zero_after(const pg8::Unit&) const { return true; }
};
DI void team_barrier(unsigned* cnt, unsigned n) {
    asm volatile("s_waitcnt vmcnt(0)" ::: "memory");
    __syncthreads();
    if (threadIdx.x == 0) {
        __builtin_amdgcn_fence(__ATOMIC_RELEASE, "agent");
        asm volatile("s_waitcnt vmcnt(0)" ::: "memory");
        (void)xb_add(cnt, 1u);
        unsigned sp = 0u;
        while (xb_ld(cnt) < n) { __builtin_amdgcn_s_sleep(2); if (++sp > (1u << 20)) break; }
        __builtin_amdgcn_fence(__ATOMIC_ACQUIRE, "agent");
        asm volatile("s_waitcnt vmcnt(0)" ::: "memory");
    }
    __syncthreads();
}
DI void team_arrive(unsigned* cnt) {
    asm volatile("s_waitcnt vmcnt(0)" ::: "memory");
    __syncthreads();
    if (threadIdx.x == 0) { __builtin_amdgcn_fence(__ATOMIC_RELEASE, "agent"); asm volatile("s_waitcnt vmcnt(0)" ::: "memory"); (void)xb_add(cnt, 1u); }
}
DI void zero_acc(af4 (&acc)[2][2][4][2]) {
#pragma unroll
    for (int a = 0; a < 2; ++a)
#pragma unroll
        for (int b = 0; b < 2; ++b)
#pragma unroll
            for (int mm = 0; mm < 4; ++mm)
#pragma unroll
                for (int n = 0; n < 2; ++n) acc[a][b][mm][n] = (af4){0.f, 0.f, 0.f, 0.f};
}
template <class E> struct NoDrain : E { static constexpr bool AFTER_DRAIN = false; };
template <class Epi> DI void gemm_stream(LAS unsigned char* lds, const pg8::Gemm& g, const pg8::StaticOrder& S, const Epi& E) {
    af4 acc[2][2][4][2]; zero_acc(acc); const NoDrain<Epi> E2{E};
    pg8::gemm_phase<NoDrain<Epi>, pg8::StaticOrder, GEMM_ALIGN, GEMM_SP2>(lds, g, S, E2, acc);
}
template <class Epi> DI void gemm_units(LAS unsigned char* lds, const pg8::Gemm& g, const pg8::StaticOrder& S, const Epi& E) {
    pg8::Unit u;
    for (int i = 0; S.next(i, u); ++i) { af4 acc[2][2][4][2]; zero_acc(acc); OneUnit O{S, i}; pg8::gemm_phase<Epi, OneUnit, false, GEMM_SP2>(lds, g, O, E, acc); }
}
DI int win_src_col(int n) { return n < 16384 ? n : (n < 30720 ? n + 16 : (n < 30736 ? n - 30720 + 16384 : -1)); }
template <bool WIN> DI void tr_item(LAS unsigned char* lds, const float* W, int ldsrc, bf16* WT, size_t ldd, int k0, int n0, int dcol0, int lane) {
    const int n = n0 + 2 * lane;
    const int sc = WIN ? win_src_col(n) : n;
    const unsigned so = (unsigned)(sc >= 0 ? sc : 0);
    f32x2_t v[64];
#pragma unroll
    for (int i = 0; i < 64; ++i) { const float* rowp = W + (size_t)(k0 + i) * ldsrc; v[i] = *(const f32x2_t*)(rowp + so); }
    if (sc < 0) {
#pragma unroll
        for (int i = 0; i < 64; ++i) v[i] = (f32x2_t){0.f, 0.f};
    }
    LAS unsigned char* slab = lds + __builtin_amdgcn_readfirstlane((int)(threadIdx.x >> 6)) * 16384;
    LAS u32x4* w0 = (LAS u32x4*)(slab + lane * 256);
#pragma unroll
    for (int j = 0; j < 8; ++j) { u32x4 o; o.x = pk2(v[8 * j].x, v[8 * j + 1].x); o.y = pk2(v[8 * j + 2].x, v[8 * j + 3].x); o.z = pk2(v[8 * j + 4].x, v[8 * j + 5].x); o.w = pk2(v[8 * j + 6].x, v[8 * j + 7].x); w0[j] = o; }
#pragma unroll
    for (int j = 0; j < 8; ++j) { u32x4 o; o.x = pk2(v[8 * j].y, v[8 * j + 1].y); o.y = pk2(v[8 * j + 2].y, v[8 * j + 3].y); o.z = pk2(v[8 * j + 4].y, v[8 * j + 5].y); o.w = pk2(v[8 * j + 6].y, v[8 * j + 7].y); w0[8 + j] = o; }
    bf16* dst = WT + (size_t)(n0 + (lane >> 3)) * ldd + dcol0 + k0 + (lane & 7) * 8;
#pragma unroll
    for (int s_ = 0; s_ < 16; ++s_) { const u32x4 o = *(const LAS u32x4*)(slab + s_ * 1024 + lane * 16); *(u32x4*)(dst + (size_t)(8 * s_) * ldd) = o; }
}
DI void tr_item8(LAS unsigned char* lds, const float* W, int ldsrc, unsigned char* W8, int k0, int nl0, int lane) {
    const unsigned so = (unsigned)(18448 + nl0 + lane);
    float v[128];
#pragma unroll
    for (int i = 0; i < 128; ++i) { const float* rowp = W + (size_t)(k0 + i) * ldsrc; v[i] = rowp[so]; }
    LAS unsigned char* slab = lds + __builtin_amdgcn_readfirstlane((int)(threadIdx.x >> 6)) * 16384;
    LAS u32x4* w0 = (LAS u32x4*)(slab + lane * 128);
#pragma unroll
    for (int j = 0; j < 8; ++j) { u32x4 o; o.x = pk4f8(v[16 * j] * 64.f, v[16 * j + 1] * 64.f, v[16 * j + 2] * 64.f, v[16 * j + 3] * 64.f); o.y = pk4f8(v[16 * j + 4] * 64.f, v[16 * j + 5] * 64.f, v[16 * j + 6] * 64.f, v[16 * j + 7] * 64.f);
        o.z = pk4f8(v[16 * j + 8] * 64.f, v[16 * j + 9] * 64.f, v[16 * j + 10] * 64.f, v[16 * j + 11] * 64.f); o.w = pk4f8(v[16 * j + 12] * 64.f, v[16 * j + 13] * 64.f, v[16 * j + 14] * 64.f, v[16 * j + 15] * 64.f); w0[j] = o; }
    unsigned char* dst = W8 + (size_t)(nl0 + (lane >> 3)) * DM + k0 + (lane & 7) * 16;
#pragma unroll
    for (int s_ = 0; s_ < 8; ++s_) { const u32x4 o = *(const LAS u32x4*)(slab + s_ * 1024 + lane * 16); *(u32x4*)(dst + (size_t)(8 * s_) * DM) = o; }
}
constexpr int CV_INB = 64 * 146, CV_IN8 = 32 * 192, CV_IN = CV_INB + CV_IN8, CV_BR = 3 * 32 * 32, CV_OU = 64 * 32, CV_L = CV_IN + CV_BR + CV_OU;
#ifndef CVX_ITEMS
#define CVX_ITEMS 5000
#endif
constexpr int CVX = CVX_ITEMS;
DI void convert_items(LAS unsigned char* lds, const float* w_in, const float* w_branch, const float* w_out, unsigned char* ws, int l, int it0, int it1, int gw, int NGW, int lane) {
    for (int it = it0 + gw; it < it1; it += NGW) {
        int r = it;
        if (r < CV_INB) { const int kb = r / 146, nb = r % 146; const int n0 = nb < 144 ? nb * 128 : 30720 + (nb - 144) * 128;
            tr_item<true>(lds, w_in + (size_t)l * DM * 30736, 30736, (bf16*)(ws + WS_WIN + l * SZ_WIN), DM, kb * 64, n0, 0, lane); continue; }
        r -= CV_INB;
        if (r < CV_IN8) { const int kb = r / 192, nb = r % 192;
            tr_item8(lds, w_in + (size_t)l * DM * 30736, 30736, ws + WS_W8 + l * SZ_W8, kb * 128, nb * 64, lane); continue; }
        r -= CV_IN8;
        if (r < CV_BR) { const int n = r / (32 * 32), rr = r % (32 * 32), kb = rr / 32, nb = rr % 32;
            tr_item<false>(lds, w_branch + ((size_t)l * 3 + n) * BW * DM, DM, (bf16*)(ws + WS_WBR + l * SZ_WBR), KBR, kb * 64, nb * 128, n * BW, lane); continue; }
        r -= CV_BR;
        { const int kb = r / 32, nb = r % 32;
            tr_item<false>(lds, w_out + (size_t)l * DM * DM, DM, (bf16*)(ws + WS_WOU + l * SZ_WOU), DM, kb * 64, nb * 128, 0, lane); }
    }
}
DI void tail_convert(LAS unsigned char* lds, const float* w_in, const float* w_branch, const float* w_out, unsigned char* ws, int l, int it0, int it1, int nunits, int G, int bx, int wave, int lane_in) {
    int lane = lane_in; asm volatile("" : "+v"(lane));
    const int rounds = (nunits + G - 1) / G, busy = nunits - (rounds - 1) * G, idle = G - busy;
    if (idle > 0) { if (bx >= busy) convert_items(lds, w_in, w_branch, w_out, ws, l, it0, it1, (bx - busy) * NWAVES + wave, idle * NWAVES, lane); }
    else convert_items(lds, w_in, w_branch, w_out, ws, l, it0, it1, bx * NWAVES + wave, G * NWAVES, lane);
}
DI void norm_rows(const float* xp, const float* xs, const float* nw, bf16* Z, unsigned char* Z8, int gw, int NGW, int lane) {
    asm volatile("" : "+v"(lane), "+s"(gw));
    for (int m = gw; m < MT; m += NGW) {
        const f32x4* xr = (const f32x4*)(m < MP ? xp + (size_t)m * DM : xs + (size_t)(m - MP) * DM) + lane;
        f32x4 v[16]; float s = 0.f;
#pragma unroll
        for (int j = 0; j < 16; ++j) { v[j] = xr[64 * j]; s += (v[j].x * v[j].x + v[j].y * v[j].y) + (v[j].z * v[j].z + v[j].w * v[j].w); }
        const float rstd = 1.0f / sqrtf(wave_sum(s) * (1.0f / DM) + EPS);
        u32x2* o8 = (u32x2*)(Z + (size_t)m * DM) + lane; unsigned* q8 = (unsigned*)(Z8 + (size_t)m * DM) + lane;
#pragma unroll
        for (int j = 0; j < 16; ++j) { const f32x4 w4 = ((const f32x4*)nw)[lane + 64 * j]; const float z0 = v[j].x * rstd * w4.x, z1 = v[j].y * rstd * w4.y, z2 = v[j].z * rstd * w4.z, z3 = v[j].w * rstd * w4.w;
            u32x2 o; o.x = pk2(z0, z1); o.y = pk2(z2, z3); o8[64 * j] = o; q8[64 * j] = pk4f8(z0, z1, z2, z3); }
    }
}
DI void sum_slabs_rows(const float* PB, bf16* MB, int gw, int NGW, int lane) {
    asm volatile("" : "+v"(lane), "+s"(gw));
    for (int r = gw; r < 256; r += NGW) {
        const f32x4* a = (const f32x4*)(PB + (size_t)r * DM) + lane; const f32x4* b = a + (size_t)256 * DM / 4; const f32x4* c = b + (size_t)256 * DM / 4;
        u32x2* o8 = (u32x2*)(MB + (size_t)(MP + r) * DM) + lane;
#pragma unroll
        for (int j = 0; j < 16; ++j) { const f32x4 v = (a[64 * j] + b[64 * j]) + c[64 * j]; u32x2 o; o.x = pk2(v.x, v.y); o.y = pk2(v.z, v.w); o8[64 * j] = o; }
    }
}
template <bool XB, bool YB> DI void final_rows(const void* xp_, const void* xs_, const bf16* OUT, const float* PO, const float* npost, void* ydst_, const float* npre_next, bf16* Z, unsigned char* Z8, int gw, int NGW, int lane) {
    asm volatile("" : "+v"(lane), "+s"(gw));
    for (int m = gw; m < MT; m += NGW) {
        const f32x4* xr = (const f32x4*)(m < MP ? (const float*)xp_ + (size_t)m * DM : (const float*)xs_ + (size_t)(m - MP) * DM) + lane;
        const u32x2* xrb = (const u32x2*)(m < MP ? (const bf16*)xp_ + (size_t)m * DM : (const bf16*)xs_ + (size_t)(m - MP) * DM) + lane;
        f32x4 v[16]; float s = 0.f;
        if (PO && m >= MP) { const f32x4* p0 = (const f32x4*)(PO + (size_t)(m - MP) * DM) + lane; const f32x4* p1 = p0 + (size_t)256 * DM / 4; const f32x4* p2 = p1 + (size_t)256 * DM / 4; const f32x4* p3 = p2 + (size_t)256 * DM / 4;
#pragma unroll
            for (int j = 0; j < 16; ++j) v[j] = (p0[64 * j] + p1[64 * j]) + (p2[64 * j] + p3[64 * j]); }
        else { const u32x2* orow = (const u32x2*)(OUT + (size_t)m * DM) + lane;
#pragma unroll
            for (int j = 0; j < 16; ++j) { const u32x2 ov = orow[64 * j]; v[j] = (f32x4){bflo(ov.x), bfhi(ov.x), bflo(ov.y), bfhi(ov.y)}; } }
#pragma unroll
        for (int j = 0; j < 16; ++j) s += (v[j].x * v[j].x + v[j].y * v[j].y) + (v[j].z * v[j].z + v[j].w * v[j].w);
        const float rstd = 1.0f / sqrtf(wave_sum(s) * (1.0f / DM) + EPS);
        f32x4* yo = (f32x4*)((float*)ydst_ + (size_t)m * DM) + lane; u32x2* yob = (u32x2*)((bf16*)ydst_ + (size_t)m * DM) + lane; float s2 = 0.f;
#pragma unroll
        for (int j = 0; j < 16; ++j) { const f32x4 w4 = ((const f32x4*)npost)[lane + 64 * j]; f32x4 x4;
            if constexpr (XB) { const u32x2 xb = xrb[64 * j]; x4 = (f32x4){bflo(xb.x), bfhi(xb.x), bflo(xb.y), bfhi(xb.y)}; } else x4 = xr[64 * j];
            v[j] = x4 + v[j] * rstd * w4;
            if constexpr (YB) { u32x2 yb; yb.x = pk2(v[j].x, v[j].y); yb.y = pk2(v[j].z, v[j].w); yob[64 * j] = yb; } else yo[64 * j] = v[j];
            s2 += (v[j].x * v[j].x + v[j].y * v[j].y) + (v[j].z * v[j].z + v[j].w * v[j].w); }
        if (Z) {
            const float r2 = 1.0f / sqrtf(wave_sum(s2) * (1.0f / DM) + EPS);
            u32x2* o8 = (u32x2*)(Z + (size_t)m * DM) + lane; unsigned* q8 = (unsigned*)(Z8 + (size_t)m * DM) + lane;
#pragma unroll
            for (int j = 0; j < 16; ++j) { const f32x4 w4 = ((const f32x4*)npre_next)[lane + 64 * j]; const float z0 = v[j].x * r2 * w4.x, z1 = v[j].y * r2 * w4.y, z2 = v[j].z * r2 * w4.z, z3 = v[j].w * r2 * w4.w;
                u32x2 o; o.x = pk2(z0, z1); o.y = pk2(z2, z3); o8[64 * j] = o; q8[64 * j] = pk4f8(z0, z1, z2, z3); }
        }
    }
}
DI void mix_fix_rows(const bf16* OA, const float* SSQ, const float* hnw, const bf16* HGATE, const float* gnw, const bf16* CGATE, bf16* Y, int m0, int m1, int gw, int NGW, int lane) {
    asm volatile("" : "+v"(lane), "+s"(gw));
    for (int m = m0 + gw; m < m1; m += NGW) {
        const f32x4* sq = (const f32x4*)(SSQ + (size_t)m * 32);
        float rs[4];
#pragma unroll
        for (int h = 0; h < 4; ++h) { const f32x4 s = sq[4 + h]; rs[h] = 1.0f / sqrtf(((s.x + s.y) + (s.z + s.w)) * (1.0f / 512.0f) + EPS); }
#pragma unroll
        for (int j = 0; j < 8; ++j) { const int col = 4 * (lane + 64 * j);
            const u32x2 ob = *(const u32x2*)(OA + (size_t)m * (2 * BW) + BW + col); const f32x4 o = (f32x4){bflo(ob.x), bfhi(ob.x), bflo(ob.y), bfhi(ob.y)}, w4 = *(const f32x4*)(gnw + col); const u32x2 g = *(const u32x2*)(CGATE + (size_t)m * BW + col);
            const float r = rs[j >> 1]; u32x2 y; y.x = pk2(o.x * r * w4.x * bflo(g.x), o.y * r * w4.y * bfhi(g.x)); y.y = pk2(o.z * r * w4.z * bflo(g.y), o.w * r * w4.w * bfhi(g.y));
            *(u32x2*)(Y + (size_t)m * KBR + 2 * BW + col) = y; }
    }
}
DI void gl_rows(const float* CLR, const float* w2, const float* b2, float* GL, int bx, int G, int tid_in) {
    int tid = tid_in; asm volatile("" : "+v"(tid));
    float wa[16], wb[16];
#pragma unroll
    for (int r = 0; r < 16; ++r) { wa[r] = w2[r * 1024 + tid]; wb[r] = w2[r * 1024 + 512 + tid]; }
    const float ba = b2[tid], bb = b2[512 + tid];
    for (int m = bx; m < MT; m += G) {
        const f32x4* cp = (const f32x4*)(CLR + (size_t)m * 16); float xa = ba, xb = bb;
#pragma unroll
        for (int q = 0; q < 4; ++q) { const f32x4 cv = cp[q];
            xa += cv.x * wa[4 * q] + cv.y * wa[4 * q + 1] + cv.z * wa[4 * q + 2] + cv.w * wa[4 * q + 3];
            xb += cv.x * wb[4 * q] + cv.y * wb[4 * q + 1] + cv.z * wb[4 * q + 2] + cv.w * wb[4 * q + 3]; }
        GL[(size_t)m * 1024 + tid] = -(fmaxf(-xa, 0.f) + __logf(1.0f + __expf(-fabsf(xa)))) * 0.0625f;
        GL[(size_t)m * 1024 + 512 + tid] = -(fmaxf(-xb, 0.f) + __logf(1.0f + __expf(-fabsf(xb)))) * 0.0625f;
    }
}

template <int DK> struct SL {
    static constexpr int QS = (DK + 8) * 2;
    static constexpr int KHS = 72 * 2;
    static constexpr int VS = 136 * 2;
    static constexpr int QT = 0, KT = QT + 64 * QS, KH = KT + 64 * QS, VT = KH + DK * KHS, PP = VT + 64 * VS;
    static constexpr int PTOT = PP + 64 * KHS, ER = PTOT + 2048, EBL = ER + DK * 4, SSQ = EBL + DK * 4, END = SSQ + 2048;
};
static_assert(SL<256>::END <= MISC_OFF, "scan LDS map");
struct LaArgs {
    const bf16* Q; int ldq;
    const float* G; int ldg;
    const bf16* K;
    const bf16* V;
    int row0, T;
    const float* S0; float* S1; int lds;
    const float* nw; const bf16* gate; bf16* Y;
};
template <int DK, bool GLA>
DI void la_job(LAS unsigned char* lds, const int tid_in, const LaArgs& A) {
    int tid = tid_in; asm volatile("" : "+v"(tid));
    typedef SL<DK> L;
    constexpr int NPART = 512 / DK, TPT = 64 / NPART, NDKT = DK / 16, NKS = DK / 32, NQ = DK / 64;
    const int lane = tid & 63, w = __builtin_amdgcn_readfirstlane(tid >> 6), fr = lane & 15, fq = lane >> 4;
    const int d = tid % DK, part = __builtin_amdgcn_readfirstlane(tid / DK);
    f32x4 S[NDKT];
#pragma unroll
    for (int k = 0; k < NDKT; ++k) {
        if (A.S0) {
#pragma unroll
            for (int j = 0; j < 4; ++j) S[k][j] = A.S0[(size_t)(16 * k + 4 * fq + j) * A.lds + 16 * w + fr];
        } else S[k] = (f32x4){0.f, 0.f, 0.f, 0.f};
    }
    const int nchunk = (A.T + 63) >> 6;
    const f32x4 nw4 = *(const f32x4*)(A.nw + 16 * w + 4 * fq);
    u32x4 pq[NQ], pk[NQ], pv[2]; float pg[TPT];
    constexpr int RPI = 512 / (DK / 8);
    const int tq = tid / (DK / 8), cq = tid % (DK / 8), tv = tid >> 4, cv = tid & 15;
    int b_q = L::QT + fr * L::QS + 16 * fq, b_q4 = L::QT + fr * L::QS + 8 * fq, b_k = L::KT + fr * L::QS + 16 * fq, b_kh = L::KH + fr * L::KHS + 16 * fq, b_p = L::PP + fr * L::KHS + 16 * fq, b_e = 16 * fq;
    asm volatile("" : "+v"(b_q), "+v"(b_q4), "+v"(b_k), "+v"(b_kh), "+v"(b_p), "+v"(b_e));
    const unsigned qoff = (unsigned)(tq * A.ldq + cq * 8), koff = (unsigned)(tq * 1024 + cq * 8), voff = (unsigned)(tv * BW + cv * 8);
#define LA_PREFETCH(cc) do { int t0_ = (cc) * 64; asm volatile("" : "+s"(t0_)); const size_t rowc_ = (size_t)A.row0 + t0_; const int nval_ = (A.T - t0_) < 64 ? (A.T - t0_) : 64; \
        _Pragma("unroll") for (int i_ = 0; i_ < NQ; ++i_) { const bf16* qb_ = A.Q + (rowc_ + RPI * i_) * A.ldq; \
            pq[i_] = (u32x4){0u, 0u, 0u, 0u}; if (tq + RPI * i_ < nval_) pq[i_] = *(const u32x4*)(qb_ + qoff); \
            } \
        _Pragma("unroll") for (int i_ = 0; i_ < 2; ++i_) { const bf16* vb_ = A.V + (rowc_ + 32 * i_) * BW; \
            pv[i_] = (u32x4){0u, 0u, 0u, 0u}; if (tv + 32 * i_ < nval_) pv[i_] = *(const u32x4*)(vb_ + voff); } \
        } while (0)
#define LA_LOAD_G(rowc_, nval_) do { _Pragma("unroll") for (int i_ = 0; i_ < TPT; ++i_) { const int t_ = part * TPT + i_; const float* gb_ = A.G + ((rowc_) + t_) * A.ldg; pg[i_] = (t_ < (nval_)) ? gb_[d] : 0.f; } } while (0)
#define LA_PREFETCH_G(cc) do { int t0_ = (cc) * 64; asm volatile("" : "+s"(t0_)); const size_t rowc_ = (size_t)A.row0 + t0_; const int nval_ = (A.T - t0_) < 64 ? (A.T - t0_) : 64; \
        if constexpr (GLA) { _Pragma("unroll") for (int i_ = 0; i_ < NQ; ++i_) { const bf16* kb_ = A.K + (rowc_ + RPI * i_) * 1024; pk[i_] = (u32x4){0u, 0u, 0u, 0u}; if (tq + RPI * i_ < nval_) pk[i_] = *(const u32x4*)(kb_ + koff); } } \
        if constexpr (!GLA) { LA_LOAD_G(rowc_, nval_); } } while (0)
    LA_PREFETCH(0); LA_PREFETCH_G(0);
    for (int c = 0; c < nchunk; ++c) {
        const int t0 = c * 64; const size_t rowc = (size_t)A.row0 + t0; const int nval = (A.T - t0) < 64 ? (A.T - t0) : 64;
        if constexpr (GLA) { LA_LOAD_G(rowc, nval); }
#pragma unroll
        for (int i = 0; i < NQ; ++i) { *(LAS u32x4*)(lds + L::QT + (tq + RPI * i) * L::QS + cq * 16) = pq[i];
            if constexpr (GLA) *(LAS u32x4*)(lds + L::KT + (tq + RPI * i) * L::QS + cq * 16) = pk[i]; }
#pragma unroll
        for (int i = 0; i < 2; ++i) *(LAS u32x4*)(lds + L::VT + (tv + 32 * i) * L::VS + cv * 16) = pv[i];
        float g[TPT];
        { float run = 0.f;
#pragma unroll
            for (int i = 0; i < TPT; ++i) { g[i] = pg[i]; run += g[i]; }
            *(LAS float*)(lds + L::PTOT + (part * DK + d) * 4) = run; }
        __syncthreads();
        float pre = 0.f, tot = 0.f, rr = 0.f;
#pragma unroll
        for (int p = 0; p < NPART; ++p) { const float v = *(const LAS float*)(lds + L::PTOT + (p * DK + d) * 4); pre += (p < part) ? v : 0.f; tot += v; rr += (p < NPART / 2) ? v : 0.f; }
        {
            float bb = pre; const float etr = __expf(tot - rr);
#pragma unroll
            for (int i8 = 0; i8 < TPT / 8; ++i8) { float kh[8];
#pragma unroll
                for (int ii = 0; ii < 8; ++ii) { const int i = 8 * i8 + ii; const int t = part * TPT + i; bb += g[i];
                    LAS bf16* qp = (LAS bf16*)(lds + L::QT + t * L::QS + d * 2); LAS bf16* kp = (LAS bf16*)(lds + L::KT + t * L::QS + d * 2);
                    const float qr = bf2f(*qp); float kr;
                    if constexpr (GLA) kr = bf2f(*kp); else kr = 1.0f - __expf(g[i]);
                    const float e1 = __expf(bb - rr), e2 = __expf(rr - bb);
                    *qp = f2bf(qr * e1); const float kt = kr * e2; *kp = f2bf(kt); kh[ii] = kt * etr; }
                u32x4 o; o.x = pk2(kh[0], kh[1]); o.y = pk2(kh[2], kh[3]); o.z = pk2(kh[4], kh[5]); o.w = pk2(kh[6], kh[7]);
                *(LAS u32x4*)(lds + L::KH + d * L::KHS + (part * TPT + 8 * i8) * 2) = o;
                asm volatile("" ::: "memory"); }
            if (part == 0) { *(LAS float*)(lds + L::ER + d * 4) = __expf(rr); *(LAS float*)(lds + L::EBL + d * 4) = __expf(tot); }
        }
        __syncthreads();
        if (c + 1 < nchunk) LA_PREFETCH(c + 1);
        bf16x8 Vf[2];
#pragma unroll
        for (int ks = 0; ks < 2; ++ks) {
            const bf16x4 lo = __builtin_amdgcn_ds_read_tr16_b64_v4i16((LAS bf16x4*)(lds + L::VT + (32 * ks + 8 * fq + (fr >> 2)) * L::VS + (16 * w + 4 * (fr & 3)) * 2));
            const bf16x4 hi = __builtin_amdgcn_ds_read_tr16_b64_v4i16((LAS bf16x4*)(lds + L::VT + (32 * ks + 8 * fq + 4 + (fr >> 2)) * L::VS + (16 * w + 4 * (fr & 3)) * 2));
            Vf[ks] = (bf16x8){lo[0], lo[1], lo[2], lo[3], hi[0], hi[1], hi[2], hi[3]}; }
        { const int ti = w >> 1; const int pk_base = b_k + ((w & 1) * 2) * 16 * L::QS, pq_base = b_q + ti * 16 * L::QS;
#pragma unroll
            for (int sj = 0; sj < 2; ++sj) { const int si = (w & 1) * 2 + sj; f32x4 acc = (f32x4){0.f, 0.f, 0.f, 0.f};
                if (si <= ti) {
#pragma unroll
                    for (int ks = 0; ks < NKS; ++ks) { const bf16x8 a = *(const LAS bf16x8*)(lds + pk_base + sj * 16 * L::QS + ks * 64);
                        const bf16x8 bq = *(const LAS bf16x8*)(lds + pq_base + ks * 64); acc = MFMA16(a, bq, acc); } }
                const int t = 16 * ti + fr, s0 = 16 * si + 4 * fq;
#pragma unroll
                for (int j = 0; j < 4; ++j) if (s0 + j > t) acc[j] = 0.f;
                u32x2 pw; pw.x = pk2(acc[0], acc[1]); pw.y = pk2(acc[2], acc[3]);
                *(LAS u32x2*)(lds + L::PP + t * L::KHS + s0 * 2) = pw; } }
        f32x4 O[4];
#pragma unroll
        for (int ti = 0; ti < 4; ++ti) O[ti] = (f32x4){0.f, 0.f, 0.f, 0.f};
#pragma unroll
        for (int p = 0; p < NKS; ++p) { const f32x4 ea = *(const LAS f32x4*)(lds + b_e + L::ER + 128 * p), eb = *(const LAS f32x4*)(lds + b_e + L::ER + 128 * p + 64);
            u32x4 o; o.x = pk2(S[2 * p][0] * ea[0], S[2 * p][1] * ea[1]); o.y = pk2(S[2 * p][2] * ea[2], S[2 * p][3] * ea[3]);
            o.z = pk2(S[2 * p + 1][0] * eb[0], S[2 * p + 1][1] * eb[1]); o.w = pk2(S[2 * p + 1][2] * eb[2], S[2 * p + 1][3] * eb[3]); const bf16x8 Sf = __builtin_bit_cast(bf16x8, o);
#pragma unroll
            for (int ti = 0; ti < 4; ++ti) { const u32x2 q0 = *(const LAS u32x2*)(lds + b_q4 + ti * 16 * L::QS + 64 * p), q1 = *(const LAS u32x2*)(lds + b_q4 + ti * 16 * L::QS + 64 * p + 32);
                u32x4 qq; qq.x = q0.x; qq.y = q0.y; qq.z = q1.x; qq.w = q1.y; O[ti] = MFMA16(Sf, __builtin_bit_cast(bf16x8, qq), O[ti]); }
            }
        __syncthreads();
        u32x2 gt[4];
#pragma unroll
        for (int ti = 0; ti < 4; ++ti) { f32x4 acc = O[ti];
#pragma unroll
            for (int ks = 0; ks < 2; ++ks) { const bf16x8 bp = *(const LAS bf16x8*)(lds + b_p + ti * 16 * L::KHS + ks * 64); acc = MFMA16(Vf[ks], bp, acc); }
            O[ti] = acc;
            const int t = 16 * ti + fr;
            gt[ti] = (u32x2){0u, 0u}; if (t < nval) gt[ti] = *(const u32x2*)(A.gate + (rowc + t) * BW + 16 * w + 4 * fq);
            float s = (acc[0] * acc[0] + acc[1] * acc[1]) + (acc[2] * acc[2] + acc[3] * acc[3]); s += __shfl_xor(s, 16); s += __shfl_xor(s, 32);
            if (fq == 0) *(LAS float*)(lds + L::SSQ + (t * 8 + w) * 4) = s; }
        if (c + 1 < nchunk) LA_PREFETCH_G(c + 1);
#pragma unroll
        for (int k = 0; k < NDKT; ++k) { const f32x4 e = *(const LAS f32x4*)(lds + b_e + L::EBL + 64 * k); f32x4 acc = S[k] * e;
#pragma unroll
            for (int ks = 0; ks < 2; ++ks) { const bf16x8 a = *(const LAS bf16x8*)(lds + b_kh + k * 16 * L::KHS + ks * 64); acc = MFMA16(a, Vf[ks], acc); }
            S[k] = acc; }
        __syncthreads();
#pragma unroll
        for (int ti = 0; ti < 4; ++ti) { const int t = 16 * ti + fr;
            const f32x4 sa = *(const LAS f32x4*)(lds + L::SSQ + t * 32), sb = *(const LAS f32x4*)(lds + L::SSQ + t * 32 + 16);
            const float r = 1.0f / sqrtf((((sa.x + sa.y) + (sa.z + sa.w)) + ((sb.x + sb.y) + (sb.z + sb.w))) * (1.0f / 128.0f) + EPS);
            const f32x4 o = O[ti]; u32x2 y; y.x = pk2(o[0] * r * nw4[0] * bflo(gt[ti].x), o[1] * r * nw4[1] * bfhi(gt[ti].x)); y.y = pk2(o[2] * r * nw4[2] * bflo(gt[ti].y), o[3] * r * nw4[3] * bfhi(gt[ti].y));
            if (t < nval) *(u32x2*)(A.Y + (rowc + t) * KBR + 16 * w + 4 * fq) = y; }
    }
#undef LA_PREFETCH
#undef LA_PREFETCH_G
#undef LA_LOAD_G
#pragma unroll
    for (int k = 0; k < NDKT; ++k)
#pragma unroll
        for (int j = 0; j < 4; ++j) A.S1[(size_t)(16 * k + 4 * fq + j) * A.lds + 16 * w + fr] = S[k][j];
}

struct GPrep { const bf16* CQ; const bf16* CK; const float* CLR; const float* w2; const float* b2; bf16* QT; bf16* KT; bf16* KH; float* ER; float* EB; };
DI void gla_prep(LAS unsigned char* lds, const int tid_in, const GPrep& P, const int ci, const int hh) {
    int tid = tid_in; asm volatile("" : "+v"(tid));
    const int d = tid & 255, part = __builtin_amdgcn_readfirstlane(tid >> 8);
    const int row0 = ci < 128 ? ci * 64 : MP + (ci - 128) * 32, nval = ci < 128 ? 64 : 32;
    const int ch = hh * 256 + d;
    LAS float* ptot = (LAS float*)lds; LAS float* clrs = (LAS float*)(lds + 4096);
    if (tid < 256) { const int t = tid >> 2, q4 = tid & 3; f32x4 v = (f32x4){0.f, 0.f, 0.f, 0.f}; if (t < nval) v = *(const f32x4*)(P.CLR + ((size_t)row0 + t) * 16 + q4 * 4);
        *(LAS f32x4*)(clrs + t * 16 + q4 * 4) = v; }
    float w2r[16];
#pragma unroll
    for (int r = 0; r < 16; ++r) w2r[r] = P.w2[r * 1024 + ch];
    const float b2v = P.b2[ch];
    unsigned qk[32];
    { const bf16* qi = P.CQ + (size_t)row0 * 1024 + ch; const bf16* ki = P.CK + (size_t)row0 * 1024 + ch;
#pragma unroll
      for (int i = 0; i < 32; ++i) { const int t = part * 32 + i; const int tc = t < nval ? t : 0; const unsigned qv = qi[(size_t)tc * 1024], kv = ki[(size_t)tc * 1024]; qk[i] = (t < nval) ? (qv | (kv << 16)) : 0u; } }
    __syncthreads();
    float g[32]; float run = 0.f;
#pragma unroll
    for (int i = 0; i < 32; ++i) { const int t = part * 32 + i; const LAS f32x4* cp = (const LAS f32x4*)(clrs + t * 16);
        float x = b2v;
#pragma unroll
        for (int q = 0; q < 4; ++q) { const f32x4 cv = cp[q]; x += cv.x * w2r[4 * q] + cv.y * w2r[4 * q + 1] + cv.z * w2r[4 * q + 2] + cv.w * w2r[4 * q + 3]; }
        const float ls = -(fmaxf(-x, 0.f) + __logf(1.0f + __expf(-fabsf(x))));
        g[i] = (t < nval) ? ls * 0.0625f : 0.f; run += g[i]; }
    ptot[part * 256 + d] = run;
    __syncthreads();
    const float p0 = ptot[d], p1 = ptot[256 + d];
    const float rr = p0, tot = p0 + p1, etr = __expf(tot - rr);
    float bb = part ? p0 : 0.f;
    bf16* qo = P.QT + (size_t)row0 * 1024 + ch; bf16* ko = P.KT + (size_t)row0 * 1024 + ch;
    u32x4* kho = (u32x4*)(P.KH + ((size_t)ci * 1024 + ch) * 64 + part * 32);
#pragma unroll
    for (int i8 = 0; i8 < 4; ++i8) { float kh[8];
#pragma unroll
        for (int ii = 0; ii < 8; ++ii) { const int i = 8 * i8 + ii; const int t = part * 32 + i; bb += g[i];
            const float qr = bflo(qk[i]), kr = bfhi(qk[i]);
            const float e1 = __expf(bb - rr), e2 = __expf(rr - bb); const float kt = kr * e2;
            if (t < nval) { qo[(size_t)t * 1024] = f2bf(qr * e1); ko[(size_t)t * 1024] = f2bf(kt); }
            kh[ii] = kt * etr; }
        u32x4 o; o.x = pk2(kh[0], kh[1]); o.y = pk2(kh[2], kh[3]); o.z = pk2(kh[4], kh[5]); o.w = pk2(kh[6], kh[7]); kho[i8] = o; }
    if (part == 0) { P.ER[(size_t)ci * 1024 + ch] = __expf(rr); P.EB[(size_t)ci * 1024 + ch] = __expf(tot); }
    __syncthreads();
}
struct GArgs { const bf16* QT; const bf16* KT; const bf16* KH; const float* ER; const float* EB; const bf16* V; int ci0, row0, T; const float* S0; float* S1; int lds; bf16* OA; float* SSQ; };
DI void gla_job(LAS unsigned char* lds, const int tid_in, const GArgs& A) {
    int tid = tid_in; asm volatile("" : "+v"(tid));
    typedef SL<256> L;
    constexpr int NDKT = 16, NKS = 8;
    const int lane = tid & 63, w = __builtin_amdgcn_readfirstlane(tid >> 6), fr = lane & 15, fq = lane >> 4;
    f32x4 S[NDKT];
#pragma unroll
    for (int k = 0; k < NDKT; ++k) {
        if (A.S0) {
#pragma unroll
            for (int j = 0; j < 4; ++j) S[k][j] = A.S0[(size_t)(16 * k + 4 * fq + j) * A.lds + 16 * w + fr];
        } else S[k] = (f32x4){0.f, 0.f, 0.f, 0.f};
    }
    const int nchunk = (A.T + 63) >> 6;
    u32x4 pq[4], pk[4], ph[4], pv[2]; f32x4 pe = (f32x4){0.f, 0.f, 0.f, 0.f};
    int b_q = L::QT + fr * L::QS + 16 * fq, b_q4 = L::QT + fr * L::QS + 8 * fq, b_k = L::KT + fr * L::QS + 16 * fq, b_kh = L::KH + fr * L::KHS + 16 * fq, b_p = L::PP + fr * L::KHS + 16 * fq, b_e = 16 * fq;
    asm volatile("" : "+v"(b_q), "+v"(b_q4), "+v"(b_k), "+v"(b_kh), "+v"(b_p), "+v"(b_e));
#define G_IDX() int t_ = tid; asm volatile("" : "+v"(t_)); const int tq = t_ >> 5, cq = t_ & 31, tv = t_ >> 4, cv = t_ & 15, th = t_ >> 3, chh = t_ & 7; \
        const unsigned qoff = (unsigned)(tq * 1024 + cq * 8), voff = (unsigned)(tv * BW + cv * 8), hoff = (unsigned)(th * 64 + chh * 8); (void)tq; (void)cq; (void)tv; (void)cv; (void)th; (void)chh; (void)qoff; (void)voff; (void)hoff
#define G_LOAD_QK(cc) do { G_IDX(); int c_ = (cc); asm volatile("" : "+s"(c_)); const size_t rowc_ = (size_t)A.row0 + c_ * 64; const int nval_ = (A.T - c_ * 64) < 64 ? (A.T - c_ * 64) : 64; \
        _Pragma("unroll") for (int i_ = 0; i_ < 4; ++i_) { const bf16* qb_ = A.QT + (rowc_ + 16 * i_) * 1024; const bf16* kb_ = A.KT + (rowc_ + 16 * i_) * 1024; \
            pq[i_] = (u32x4){0u, 0u, 0u, 0u}; pk[i_] = (u32x4){0u, 0u, 0u, 0u}; if (tq + 16 * i_ < nval_) { pq[i_] = *(const u32x4*)(qb_ + qoff); pk[i_] = *(const u32x4*)(kb_ + qoff); } } } while (0)
#define G_LOAD_HV(cc) do { G_IDX(); int c_ = (cc); asm volatile("" : "+s"(c_)); const size_t rowc_ = (size_t)A.row0 + c_ * 64; const int nval_ = (A.T - c_ * 64) < 64 ? (A.T - c_ * 64) : 64; \
        _Pragma("unroll") for (int i_ = 0; i_ < 4; ++i_) { const bf16* hb_ = A.KH + ((size_t)(A.ci0 + c_) * 1024 + 64 * i_) * 64; ph[i_] = *(const u32x4*)(hb_ + hoff); } \
        _Pragma("unroll") for (int i_ = 0; i_ < 2; ++i_) { const bf16* vb_ = A.V + (rowc_ + 32 * i_) * BW; pv[i_] = (u32x4){0u, 0u, 0u, 0u}; if (tv + 32 * i_ < nval_) pv[i_] = *(const u32x4*)(vb_ + voff); } \
        if (tid < 128) { const float* eb_ = (tid < 64 ? A.ER : A.EB) + (size_t)(A.ci0 + c_) * 1024; pe = *(const f32x4*)(eb_ + 4 * (tid & 63)); } } while (0)
#define G_LAND_QK() do { G_IDX(); _Pragma("unroll") for (int i_ = 0; i_ < 4; ++i_) { *(LAS u32x4*)(lds + L::QT + (tq + 16 * i_) * L::QS + cq * 16) = pq[i_]; *(LAS u32x4*)(lds + L::KT + (tq + 16 * i_) * L::QS + cq * 16) = pk[i_]; } } while (0)
#define G_LAND_HV() do { G_IDX(); _Pragma("unroll") for (int i_ = 0; i_ < 4; ++i_) *(LAS u32x4*)(lds + L::KH + (th + 64 * i_) * L::KHS + chh * 16) = ph[i_]; \
        _Pragma("unroll") for (int i_ = 0; i_ < 2; ++i_) *(LAS u32x4*)(lds + L::VT + (tv + 32 * i_) * L::VS + cv * 16) = pv[i_]; \
        if (tid < 128) *(LAS f32x4*)(lds + L::ER + 16 * tid) = pe; } while (0)
    G_LOAD_QK(0); G_LOAD_HV(0); G_LAND_QK();
    for (int c = 0; c < nchunk; ++c) {
        const int t0 = c * 64; const size_t rowc = (size_t)A.row0 + t0; const int nval = (A.T - t0) < 64 ? (A.T - t0) : 64;
        G_LAND_HV();
        __syncthreads();
        if (c + 1 < nchunk) G_LOAD_QK(c + 1);
        bf16x8 Vf[2];
#pragma unroll
        for (int ks = 0; ks < 2; ++ks) {
            const bf16x4 lo = __builtin_amdgcn_ds_read_tr16_b64_v4i16((LAS bf16x4*)(lds + L::VT + (32 * ks + 8 * fq + (fr >> 2)) * L::VS + (16 * w + 4 * (fr & 3)) * 2));
            const bf16x4 hi = __builtin_amdgcn_ds_read_tr16_b64_v4i16((LAS bf16x4*)(lds + L::VT + (32 * ks + 8 * fq + 4 + (fr >> 2)) * L::VS + (16 * w + 4 * (fr & 3)) * 2));
            Vf[ks] = (bf16x8){lo[0], lo[1], lo[2], lo[3], hi[0], hi[1], hi[2], hi[3]}; }
        { const int ti = w >> 1; const int pk_base = b_k + ((w & 1) * 2) * 16 * L::QS, pq_base = b_q + ti * 16 * L::QS;
#pragma unroll
            for (int sj = 0; sj < 2; ++sj) { const int si = (w & 1) * 2 + sj; f32x4 acc = (f32x4){0.f, 0.f, 0.f, 0.f};
                if (si <= ti) {
#pragma unroll
                    for (int ks = 0; ks < NKS; ++ks) { const bf16x8 a = *(const LAS bf16x8*)(lds + pk_base + sj * 16 * L::QS + ks * 64);
                        const bf16x8 bq = *(const LAS bf16x8*)(lds + pq_base + ks * 64); acc = MFMA16(a, bq, acc); } }
                const int t = 16 * ti + fr, s0 = 16 * si + 4 * fq;
#pragma unroll
                for (int j = 0; j < 4; ++j) if (s0 + j > t) acc[j] = 0.f;
                u32x2 pw; pw.x = pk2(acc[0], acc[1]); pw.y = pk2(acc[2], acc[3]);
                *(LAS u32x2*)(lds + L::PP + t * L::KHS + s0 * 2) = pw; } }
        f32x4 O[4];
#pragma unroll
        for (int ti = 0; ti < 4; ++ti) O[ti] = (f32x4){0.f, 0.f, 0.f, 0.f};
#pragma unroll
        for (int p = 0; p < NKS; ++p) { const f32x4 ea = *(const LAS f32x4*)(lds + b_e + L::ER + 128 * p), eb = *(const LAS f32x4*)(lds + b_e + L::ER + 128 * p + 64);
            u32x4 o; o.x = pk2(S[2 * p][0] * ea[0], S[2 * p][1] * ea[1]); o.y = pk2(S[2 * p][2] * ea[2], S[2 * p][3] * ea[3]);
            o.z = pk2(S[2 * p + 1][0] * eb[0], S[2 * p + 1][1] * eb[1]); o.w = pk2(S[2 * p + 1][2] * eb[2], S[2 * p + 1][3] * eb[3]); const bf16x8 Sf = __builtin_bit_cast(bf16x8, o);
#pragma unroll
            for (int ti = 0; ti < 4; ++ti) { const u32x2 q0 = *(const LAS u32x2*)(lds + b_q4 + ti * 16 * L::QS + 64 * p), q1 = *(const LAS u32x2*)(lds + b_q4 + ti * 16 * L::QS + 64 * p + 32);
                u32x4 qq; qq.x = q0.x; qq.y = q0.y; qq.z = q1.x; qq.w = q1.y; O[ti] = MFMA16(Sf, __builtin_bit_cast(bf16x8, qq), O[ti]); }
            }
        __syncthreads();
        if (c + 1 < nchunk) { G_LAND_QK(); G_LOAD_HV(c + 1); }
#pragma unroll
        for (int ti = 0; ti < 4; ++ti) { f32x4 acc = O[ti];
#pragma unroll
            for (int ks = 0; ks < 2; ++ks) { const bf16x8 bp = *(const LAS bf16x8*)(lds + b_p + ti * 16 * L::KHS + ks * 64); acc = MFMA16(Vf[ks], bp, acc); }
            const int t = 16 * ti + fr;
            if (t < nval) { u32x2 ob; ob.x = pk2(acc[0], acc[1]); ob.y = pk2(acc[2], acc[3]); *(u32x2*)(A.OA + (rowc + t) * (2 * BW) + 16 * w + 4 * fq) = ob; }
            float s = (acc[0] * acc[0] + acc[1] * acc[1]) + (acc[2] * acc[2] + acc[3] * acc[3]); s += __shfl_xor(s, 16); s += __shfl_xor(s, 32);
            if (fq == 0) *(LAS float*)(lds + L::SSQ + (t * 8 + w) * 4) = s; }
#pragma unroll
        for (int k = 0; k < NDKT; ++k) { const f32x4 e = *(const LAS f32x4*)(lds + b_e + L::EBL + 64 * k); f32x4 acc = S[k] * e;
#pragma unroll
            for (int ks = 0; ks < 2; ++ks) { const bf16x8 a = *(const LAS bf16x8*)(lds + b_kh + k * 16 * L::KHS + ks * 64); acc = MFMA16(a, Vf[ks], acc); }
            S[k] = acc; }
        __syncthreads();
        if (tid < 64 && tid < nval) { const f32x4 sa = *(const LAS f32x4*)(lds + L::SSQ + tid * 32), sb = *(const LAS f32x4*)(lds + L::SSQ + tid * 32 + 16);
            A.SSQ[(rowc + tid) * 32] = ((sa.x + sa.y) + (sa.z + sa.w)) + ((sb.x + sb.y) + (sb.z + sb.w)); }
    }
#undef G_IDX
#undef G_LOAD_QK
#undef G_LOAD_HV
#undef G_LAND_QK
#undef G_LAND_HV
#pragma unroll
    for (int k = 0; k < NDKT; ++k)
#pragma unroll
        for (int j = 0; j < 4; ++j) A.S1[(size_t)(16 * k + 4 * fq + j) * A.lds + 16 * w + fr] = S[k][j];
}

struct LruArgs { const float* LX; int row0, T; const float* cst; const float* h0; const float* cw; const float* cb; const float* wa; const float* ba;
                 const float* wx; const float* bx; const float* lam; const bf16* lgate; bf16* Y; float* newh; float* newconv; };
constexpr int LR_XB = 0, LR_XF = 17408, LR_AA = LR_XF + 32768, LR_UU = LR_AA + 32768, LR_END = LR_UU + 32768;
static_assert(LR_END <= MISC_OFF, "lru LDS map");
DI void lru_job(LAS unsigned char* lds, const int tid_in, const LruArgs& A) {
    int tid = tid_in; asm volatile("" : "+v"(tid));
    const int lane = tid & 63, w = __builtin_amdgcn_readfirstlane(tid >> 6), fr = lane & 15, fq = lane >> 4;
    const int c = tid & 127, part = __builtin_amdgcn_readfirstlane(tid >> 7), cc = 16 * w + fr;
    bf16x8 Wf[2][4];
#pragma unroll
    for (int ks = 0; ks < 4; ++ks) { float a[8], x[8];
#pragma unroll
        for (int j = 0; j < 8; ++j) { const int i = 32 * ks + 8 * fq + j; a[j] = A.wa[i * 128 + cc]; x[j] = A.wx[i * 128 + cc]; }
        u32x4 oa, ox; oa.x = pk2(a[0], a[1]); oa.y = pk2(a[2], a[3]); oa.z = pk2(a[4], a[5]); oa.w = pk2(a[6], a[7]);
        ox.x = pk2(x[0], x[1]); ox.y = pk2(x[2], x[3]); ox.z = pk2(x[4], x[5]); ox.w = pk2(x[6], x[7]);
        Wf[0][ks] = __builtin_bit_cast(bf16x8, oa); Wf[1][ks] = __builtin_bit_cast(bf16x8, ox); }
    const float bav = A.ba[cc], bxv = A.bx[cc]; const float lamv = A.lam[cc];
    const float sp8 = -8.0f * (fmaxf(-lamv, 0.f) + log1pf(expf(-fabsf(lamv))));
    const float cw0 = A.cw[c], cw1 = A.cw[BW + c], cw2 = A.cw[2 * BW + c], cw3 = A.cw[3 * BW + c], cbv = A.cb[c];
    float hc = (tid < 128 && A.h0) ? A.h0[c] : 0.f;
    const int nchunk = (A.T + 63) >> 6;
    float xv[19]; unsigned lgn[16];
#define LRU_PREFETCH(chn) do { int t0_ = (chn) * 64; asm volatile("" : "+s"(t0_)); const int nval_ = (A.T - t0_) < 64 ? (A.T - t0_) : 64; \
        _Pragma("unroll") for (int i_ = 0; i_ < 19; ++i_) { const int ta_ = t0_ + 16 * part - 3 + i_; float v_ = 0.f; \
            if (ta_ < 0) { if (A.cst) v_ = A.cst[(3 + ta_) * BW + c]; } else if (ta_ < A.T) { const float* xb_ = A.LX + (size_t)(A.row0 + ta_) * BW; v_ = xb_[c]; } \
            xv[i_] = v_; } \
        _Pragma("unroll") for (int i_ = 0; i_ < 16; ++i_) { const int t_ = 16 * part + i_; const bf16* gb_ = A.lgate + ((size_t)A.row0 + t0_ + t_) * BW; lgn[i_] = (t_ < nval_) ? (unsigned)gb_[c] : 0u; } } while (0)
    LRU_PREFETCH(0);
    for (int ch = 0; ch < nchunk; ++ch) {
        const int t0 = ch * 64; const size_t rowc = (size_t)A.row0 + t0; const int nval = (A.T - t0) < 64 ? (A.T - t0) : 64;
        unsigned lg[16];
#pragma unroll
        for (int i = 0; i < 16; ++i) lg[i] = lgn[i];
#pragma unroll
        for (int i = 0; i < 16; ++i) { const int t = 16 * part + i; const float xc = cbv + xv[i] * cw0 + xv[i + 1] * cw1 + xv[i + 2] * cw2 + xv[i + 3] * cw3;
            *(LAS float*)(lds + LR_XF + (t * 128 + c) * 4) = xc; *(LAS bf16*)(lds + LR_XB + t * 272 + c * 2) = f2bf(xc); }
        __syncthreads();
        if (ch + 1 < nchunk) LRU_PREFETCH(ch + 1);
#pragma unroll
        for (int ti = 0; ti < 4; ++ti) { f32x4 ar = (f32x4){0.f, 0.f, 0.f, 0.f}, ai = (f32x4){0.f, 0.f, 0.f, 0.f};
#pragma unroll
            for (int ks = 0; ks < 4; ++ks) { const bf16x8 a = *(const LAS bf16x8*)(lds + LR_XB + (16 * ti + fr) * 272 + (32 * ks + 8 * fq) * 2); ar = MFMA16(a, Wf[0][ks], ar); ai = MFMA16(a, Wf[1][ks], ai); }
#pragma unroll
            for (int j = 0; j < 4; ++j) { const int t = 16 * ti + 4 * fq + j;
                const float r = sigmoidf_(ar[j] + bav), ig = sigmoidf_(ai[j] + bxv); const float la = r * sp8;
                float a_ = __expf(la); const float t2 = 2.0f * la;
                const float om = (t2 > -0.03f) ? -t2 * (1.0f + t2 * (0.5f + t2 * (0.16666667f + t2 * 0.041666668f))) : 1.0f - a_ * a_;
                float u = __builtin_amdgcn_sqrtf(fmaxf(om, 0.f)) * ig * *(const LAS float*)(lds + LR_XF + (t * 128 + cc) * 4);
                if (t >= nval) { a_ = 1.0f; u = 0.f; }
                *(LAS float*)(lds + LR_AA + (t * 128 + cc) * 4) = a_; *(LAS float*)(lds + LR_UU + (t * 128 + cc) * 4) = u; } }
        __syncthreads();
        if (tid < 128) {
#pragma unroll 16
            for (int t = 0; t < 64; ++t) { const float a_ = *(const LAS float*)(lds + LR_AA + (t * 128 + c) * 4); LAS float* up = (LAS float*)(lds + LR_UU + (t * 128 + c) * 4);
                hc = a_ * hc + *up; *up = hc; }
        }
        __syncthreads();
#pragma unroll
        for (int i = 0; i < 16; ++i) { const int t = 16 * part + i; const float ht = *(const LAS float*)(lds + LR_UU + (t * 128 + c) * 4);
            if (t < nval) { bf16* yb = A.Y + (rowc + t) * KBR; yb[c] = f2bf(ht * bf2f(lg[i])); } }
    }
#undef LRU_PREFETCH
    if (tid < 128) { A.newh[c] = hc;
#pragma unroll
        for (int j = 0; j < 3; ++j) A.newconv[j * BW + c] = A.LX[(size_t)(A.row0 + A.T - 3 + j) * BW + c]; }
    __syncthreads();
}

struct Args { const float* in[23]; float* out; unsigned char* ws; int ph_lo, ph_hi, use_bar, pad; };
enum { I_XP = 0, I_XS, I_SHG, I_SLH, I_SLC, I_SGL, I_NPRE, I_NPOST, I_WIN, I_LBL, I_HGN, I_CW, I_CB, I_WA, I_BA, I_WX, I_BX, I_LAM, I_W2, I_B2, I_GLN, I_WBR, I_WOU };
constexpr int NPHASE = 15;


#define WSZ() unsigned char* wsz = ws; asm volatile("" : "+s"(wsz))
#define wHQ ((bf16*)(wsz + WS_HQ))
#define wHG ((float*)(wsz + WS_HG))
#define wHV ((bf16*)(wsz + WS_HV))
#define wHGATE ((bf16*)(wsz + WS_HGATE))
#define wLX ((float*)(wsz + WS_LX))
#define wLGATE ((bf16*)(wsz + WS_LGATE))
#define wCQ ((bf16*)(wsz + WS_CQ))
#define wCK ((bf16*)(wsz + WS_CK))
#define wCV ((bf16*)(wsz + WS_CV))
#define wCGATE ((bf16*)(wsz + WS_CGATE))
#define wMG ((unsigned char*)(wsz + WS_MG))
#define wCLR ((float*)(wsz + WS_CLR))
#define wY ((bf16*)(wsz + WS_Y))
#define wOC ((bf16*)(wsz + WS_OC))
#define wSSQ ((float*)(wsz + WS_SSQ))
#define wGL ((float*)(wsz + WS_MERGED))
#define wMB ((bf16*)(wsz + WS_MB))
#define wOUT ((bf16*)(wsz + WS_OUT))
__global__ void __launch_bounds__(NTHR, 2) mega(Args args) {
    extern __shared__ __attribute__((aligned(16))) unsigned char lds_raw[];
    LAS unsigned char* lds = (LAS unsigned char*)lds_raw;
    const int wave = __builtin_amdgcn_readfirstlane((int)threadIdx.x >> 6);
#define tid ((int)threadIdx.x)
#define lane ((int)(threadIdx.x & 63u))
    const int G = gridDim.x, bx = blockIdx.x;
    const int gw = bx * NWAVES + wave, NGW = G * NWAVES;
#define chain (gridDim.x == 256u)
#define MM (chain ? MP : MT)
    unsigned char* ws = args.ws;
    volatile LAS unsigned* MISC = (volatile LAS unsigned*)(lds + MISC_OFF);
    if (tid < 64) MISC[tid] = 0u;
    __syncthreads();
    XcdBarrier bar; bar.bar = (unsigned*)(ws + WS_CTL) + CW_BAR; bar.x = 0; bar.st = nullptr;
    if (args.use_bar) bar = xcd_barrier_post((unsigned*)(ws + WS_CTL) + CW_BAR, MISC);
    const int lo = args.ph_lo, hi = args.ph_hi;
#define IN(k) (lo <= (k) && (k) < hi)
#define SEAM(k) do { if (IN(k) && IN((k) + 1)) xcd_barrier(bar); } while (0)
    const float* xp = args.in[I_XP]; const float* xs = args.in[I_XS];
    bf16* Z = (bf16*)(ws + WS_Z);
    bf16* X1 = (bf16*)(ws + WS_X1);

    for (int rep_ = 0; rep_ < REP_P0; ++rep_) if (IN(0) && (PHM & 64)) {
        { int lz = lane, gz = gw; asm volatile("" : "+v"(lz), "+s"(gz));
          convert_items(lds, args.in[I_WIN], args.in[I_WBR], args.in[I_WOU], ws, 0, 0, CV_IN, gz, NGW, lz); }
        norm_rows(xp, xs, args.in[I_NPRE], Z, ws + WS_Z8, gw, NGW, lane);
        __syncthreads();
    }
    SEAM(0);
    for (int l = 0; l < 2; ++l) {
        const int pb = 1 + 7 * l;
        for (int rp_ = 0; rp_ < REP_IN; ++rp_) if (IN(pb) && (PHM & 1)) { WSZ();
            const NoDrain<EpiInProj> E{{wHQ, wHV, wHGATE, wLGATE, wCQ, wCK, wCV, wCGATE, wMG, wHG, wLX, wCLR, args.in[I_LBL], l, 0.015625f}};
            { pg8::Gemm g{Z, (const bf16*)(ws + WS_WIN + l * SZ_WIN), MT, NIN, DM, DM, DM}; int bz = bx; asm volatile("" : "+s"(bz)); InOrderA SA; SA.S.init(MT, 73 * 256, G, bz);
              af4 acc[2][2][4][2]; zero_acc(acc); pg8::gemm_phase<NoDrain<EpiInProj>, InOrderA, GEMM_ALIGN, GEMM_SP2, false>(lds, g, SA, E, acc); }
            { pg8::Gemm g{(const bf16*)(ws + WS_Z8), (const bf16*)(ws + WS_W8 + l * SZ_W8) - (size_t)72 * 256 * 2048, MT, 12288, 2048, 2048, 2048}; InOrder8 S8; int bz = bx; asm volatile("" : "+s"(bz)); S8.S.init(MT, 48 * 256, G, G == 256 ? ((bz + 48) & 255) : bz);
              af4 acc[2][2][4][2]; zero_acc(acc); pg8::gemm_phase<NoDrain<EpiInProj>, InOrder8, GEMM_ALIGN, GEMM_SP2, true>(lds, g, S8, E, acc); }
            if (G == 256) { if (bx >= 105 && bx < 208) { int lz = lane; asm volatile("" : "+v"(lz)); convert_items(lds, args.in[I_WIN], args.in[I_WBR], args.in[I_WOU], ws, l, CV_IN, CV_L, (bx - 105) * NWAVES + wave, 103 * NWAVES, lz); } }
            else { int lz = lane; asm volatile("" : "+v"(lz)); convert_items(lds, args.in[I_WIN], args.in[I_WBR], args.in[I_WOU], ws, l, CV_IN, CV_L, bx * NWAVES + wave, G * NWAVES, lz); }
        }
        SEAM(pb);
        if (!chain) {
            if (IN(pb + 1)) { WSZ();
                const GPrep P{wCQ, wCK, wCLR, args.in[I_W2] + (size_t)l * 16 * 1024, args.in[I_B2] + l * 1024, (bf16*)(wsz + WS_GQT), (bf16*)(wsz + WS_GKT), (bf16*)(wsz + WS_GKH), (float*)(wsz + WS_GER), (float*)(wsz + WS_GEB)};
                for (int it = bx; it < NCHK * 4; it += G) gla_prep(lds, tid, P, it >> 2, it & 3);
            }
            SEAM(pb + 1);
        }
        for (int rep_ = 0; rep_ < REP_SCAN; ++rep_) if (IN(pb + 2) && (PHM & 2)) { WSZ();
            constexpr int NLONG = 192;
            const bool split = G > NLONG;
            const int mytype = split ? (bx < NLONG ? bx / 64 : -1) : -2;
            const int sw = bx - NLONG, nsw = G - NLONG;
            if (chain && mytype != 2) {
                const GPrep P{wCQ, wCK, wCLR, args.in[I_W2] + (size_t)l * 16 * 1024, args.in[I_B2] + l * 1024, (bf16*)(wsz + WS_GQT), (bf16*)(wsz + WS_GKT), (bf16*)(wsz + WS_GKH), (float*)(wsz + WS_GER), (float*)(wsz + WS_GEB)};
                for (int it = (bx < 128 ? bx : bx - 64); it < NCHK * 4; it += 192) gla_prep(lds, tid, P, it >> 2, it & 3);
                if (mytype == 1) team_arrive((unsigned*)(ws + WS_CTL) + CW_TEAM + 2048 + l * 64 + rep_ * 16);
                else team_barrier((unsigned*)(ws + WS_CTL) + CW_TEAM + 2048 + l * 64 + rep_ * 16, 192u);
            }
#define JOB_RANGE(TYPE, j0, j1, js) int j0, j1, js; \
            if (mytype == -2) { j0 = bx; j1 = 192; js = G; } else if (mytype == (TYPE)) { j0 = bx - 64 * (TYPE); j1 = j0 + 1; js = 1; } else if (mytype == -1) { j0 = 64 + sw; j1 = 192; js = nsw; } else { j0 = 0; j1 = 0; js = 1; }
#define JOB_DECODE(idx) const int seq = (idx) < 64 ? (idx) / 16 : 4 + ((idx) - 64) / 16; const int sub = (idx) % 16; const bool smp = seq >= 4; const int sb = smp ? seq - 4 : seq; \
            const int row0 = smp ? MP + sb * 32 : sb * 2048, T = smp ? 32 : 2048;
            for (int rj_ = 0; rj_ < REP_J0; ++rj_) if (JOBM & 1) { JOB_RANGE(0, j0, j1, js)
                for (int idx = j0; idx < j1; idx += js) { JOB_DECODE(idx)
                    const int hd = sub >> 2, sl = sub & 3;
                    GArgs A; A.QT = (const bf16*)(wsz + WS_GQT) + hd * 256; A.KT = (const bf16*)(wsz + WS_GKT) + hd * 256; A.KH = (const bf16*)(wsz + WS_GKH) + (size_t)hd * 256 * 64;
                    A.ER = (const float*)(wsz + WS_GER) + hd * 256; A.EB = (const float*)(wsz + WS_GEB) + hd * 256; A.ci0 = smp ? 128 + sb : sb * 32;
                    A.V = wCV + hd * 512 + sl * 128; A.row0 = row0; A.T = T;
                    const size_t so = ((size_t)hd * 256) * 512 + sl * 128;
                    A.S0 = smp ? args.in[I_SGL] + ((size_t)l * 8 + sb) * 4 * 256 * 512 + so : nullptr;
                    A.S1 = args.out + (smp ? O_GLS + ((size_t)l * 8 + sb) * 4 * 256 * 512 : O_GLP + ((size_t)l * 4 + sb) * 4 * 256 * 512) + so; A.lds = 512;
                    A.OA = wOC + BW + hd * 512 + sl * 128; A.SSQ = wSSQ + 16 + hd * 4 + sl;
                    gla_job(lds, tid, A);
                    __syncthreads(); } }
            for (int rj_ = 0; rj_ < REP_J1; ++rj_) if (JOBM & 2) { JOB_RANGE(1, j0, j1, js)
                for (int idx = j0; idx < j1; idx += js) { JOB_DECODE(idx)
                    const int h = sub;
                    LaArgs A; A.Q = wHQ + h * 128; A.ldq = BW; A.G = wHG + h * 128; A.ldg = BW; A.K = nullptr;
                    A.V = wHV + h * 128; A.row0 = row0; A.T = T;
                    A.S0 = smp ? args.in[I_SHG] + (((size_t)l * 8 + sb) * 16 + h) * 16384 : nullptr;
                    A.S1 = args.out + (smp ? O_HGS + (((size_t)l * 8 + sb) * 16 + h) * 16384 : O_HGP + (((size_t)l * 4 + sb) * 16 + h) * 16384); A.lds = 128;
                    A.nw = args.in[I_HGN] + l * BW + h * 128; A.gate = wHGATE + h * 128; A.Y = wY + h * 128;
                    la_job<128, false>(lds, tid, A);
                    __syncthreads(); } }
            for (int rj_ = 0; rj_ < REP_J2; ++rj_) if (JOBM & 4) { JOB_RANGE(2, j0, j1, js)
                for (int idx = j0; idx < j1; idx += js) { JOB_DECODE(idx)
                    const int hb = sub;
                    LruArgs A; A.LX = wLX + hb * 128; A.row0 = row0; A.T = T;
                    A.cst = smp ? args.in[I_SLC] + ((size_t)l * 8 + sb) * 3 * BW + hb * 128 : nullptr;
                    A.h0 = smp ? args.in[I_SLH] + ((size_t)l * 8 + sb) * BW + hb * 128 : nullptr;
                    A.cw = args.in[I_CW] + (size_t)l * 4 * BW + hb * 128; A.cb = args.in[I_CB] + l * BW + hb * 128;
                    A.wa = args.in[I_WA] + ((size_t)l * 16 + hb) * 16384; A.ba = args.in[I_BA] + l * BW + hb * 128;
                    A.wx = args.in[I_WX] + ((size_t)l * 16 + hb) * 16384; A.bx = args.in[I_BX] + l * BW + hb * 128;
                    A.lam = args.in[I_LAM] + l * BW + hb * 128; A.lgate = wLGATE + hb * 128; A.Y = wY + BW + hb * 128;
                    A.newh = args.out + (smp ? O_LHS + ((size_t)l * 8 + sb) * BW : O_LHP + ((size_t)l * 4 + sb) * BW) + hb * 128;
                    A.newconv = args.out + (smp ? O_LCS + ((size_t)l * 8 + sb) * 3 * BW : O_LCP + ((size_t)l * 4 + sb) * 3 * BW) + hb * 128;
                    lru_job(lds, tid, A);
                    __syncthreads(); } }
            if (chain && bx >= 192) {
                const int sw = bx - 192;
                unsigned* tb = (unsigned*)(ws + WS_CTL) + CW_TEAM + (l * 4) * 64 + rep_ * 16;
                team_barrier(tb, 64u);
                mix_fix_rows(wOC, wSSQ, args.in[I_HGN] + l * BW, wHGATE, args.in[I_GLN] + l * BW, wCGATE, wY, MP, MT, sw * NWAVES + wave, 64 * NWAVES, lane);
                team_barrier(tb + 64, 64u);
                if (sw < 48) {
                    const int pn = sw / 3, seg = sw - 3 * pn;
                    const FixedUnit FU{pg8::Unit{MP / 256, pn}};
                    af4 acc[2][2][4][2]; zero_acc(acc); const bf16* WB = (const bf16*)(ws + WS_WBR + l * SZ_WBR);
                    pg8::Gemm g{wY + seg * BW, WB + seg * BW, MT, DM, BW, KBR, KBR}; EpiGateSlab E{wMG, (float*)(wsz + WS_PB), seg};
                    pg8::gemm_phase<EpiGateSlab, FixedUnit, false, GEMM_SP2>(lds, g, FU, E, acc);
                }
                team_barrier(tb + 128, 64u);
                sum_slabs_rows((const float*)(wsz + WS_PB), wMB, sw * NWAVES + wave, 64 * NWAVES, lane);
                team_barrier(tb + 192, 64u);
                {
                    const int pn = sw >> 2, kq = sw & 3;
                    const FixedUnit FU{pg8::Unit{MP / 256, pn}};
                    af4 acc[2][2][4][2]; zero_acc(acc);
                    pg8::Gemm g{wMB + kq * 1024, (const bf16*)(ws + WS_WOU + l * SZ_WOU) + kq * 1024, MT, DM, 1024, DM, DM};
                    EpiF32 E{(float*)(wsz + WS_PO) + (size_t)kq * 256 * DM - (size_t)MP * DM, DM};
                    pg8::gemm_phase<EpiF32, FixedUnit, false, GEMM_SP2>(lds, g, FU, E, acc);
                }
                if (l == 0) {
                    int lz = lane; asm volatile("" : "+v"(lz));
                    convert_items(lds, args.in[I_WIN], args.in[I_WBR], args.in[I_WOU], ws, 1, 0, CVX, sw * NWAVES + wave, 64 * NWAVES, lz);
                }
            }
        }
        SEAM(pb + 2);
        for (int rp_ = 0; rp_ < REP_FIN; ++rp_) if (IN(pb + 3) && (PHM & 4)) { WSZ(); mix_fix_rows(wOC, wSSQ, args.in[I_HGN] + l * BW, wHGATE, args.in[I_GLN] + l * BW, wCGATE, wY, 0, MM, gw, NGW, lane); }
        SEAM(pb + 3);
        for (int rp_ = 0; rp_ < REP_BR; ++rp_) if (IN(pb + 4) && (PHM & 8)) { WSZ();
            const bf16* WB = (const bf16*)(ws + WS_WBR + l * SZ_WBR);
            BranchOrder BO; BO.S.init(MM, DM, G, bx);
            { af4 acc[2][2][4][2]; zero_acc(acc); pg8::Gemm g{wY, WB, MT, DM, BW, KBR, KBR}; const NoDrain<EpiBranchSeg> E{{wMG, wMB, 0}};
              pg8::gemm_phase<NoDrain<EpiBranchSeg>, BranchOrder, GEMM_ALIGN, GEMM_SP2>(lds, g, BO, E, acc); }
            if (l == 0) tail_convert(lds, args.in[I_WIN], args.in[I_WBR], args.in[I_WOU], ws, 1, chain ? CVX : 0, CV_IN, (MM / 256) * (DM / 256), G, bx, wave, lane);
        }
        SEAM(pb + 4);
        for (int rp_ = 0; rp_ < REP_OUT; ++rp_) if (IN(pb + 5) && (PHM & 16)) { WSZ();
            pg8::Gemm g{wMB, (const bf16*)(ws + WS_WOU + l * SZ_WOU), MT, DM, DM, DM, DM}; pg8::StaticOrder S; S.init(MM, DM, G, bx);
            EpiBf E{wOUT, DM}; if (GEMM_STREAM & 2) gemm_stream<EpiBf>(lds, g, S, E); else gemm_units<EpiBf>(lds, g, S, E);
        }
        SEAM(pb + 5);
        for (int rp_ = 0; rp_ < REP_FIN; ++rp_) if (IN(pb + 6) && (PHM & 32)) { WSZ();
            if (l == 0) final_rows<false, true>(xp, xs, wOUT, chain ? (const float*)(wsz + WS_PO) : nullptr, args.in[I_NPOST], X1, args.in[I_NPRE] + DM, Z, ws + WS_Z8, gw, NGW, lane);
            else        final_rows<true, false>(X1, X1 + (size_t)MP * DM, wOUT, chain ? (const float*)(wsz + WS_PO) : nullptr, args.in[I_NPOST] + DM, args.out, nullptr, nullptr, nullptr, gw, NGW, lane);
        }
        if (l == 0) SEAM(pb + 6);
    }
}

#undef tid
#undef lane
#undef chain
#undef MM
#ifndef PHM
#define PHM 127
#endif
#ifndef N_LAUNCH_MODE
#define N_LAUNCH_MODE 0
#endif
extern "C" void kernel_launch(void* const* d_in, const int* in_sizes, int n_in, void* d_out, int out_size, void* d_ws, size_t ws_size, hipStream_t stream) {
    static int grid = 0;
    if (grid == 0) {
        if (n_in != 23 || (size_t)out_size != O_END || ws_size < WS_END) { fprintf(stderr, "kernel_launch: unexpected shapes (n_in %d out %d ws %zu need %zu)\n", n_in, out_size, ws_size, (size_t)WS_END); grid = -1; return; }
        int dev = 0, cus = 0, per_cu = 0;
        if (hipGetDevice(&dev) != hipSuccess || hipDeviceGetAttribute(&cus, hipDeviceAttributeMultiprocessorCount, dev) != hipSuccess) { grid = -1; return; }
        if (hipFuncSetAttribute((const void*)mega, hipFuncAttributeMaxDynamicSharedMemorySize, LDS_BYTES) != hipSuccess) { fprintf(stderr, "kernel_launch: hipFuncSetAttribute failed\n"); grid = -1; return; }
        if (hipOccupancyMaxActiveBlocksPerMultiprocessor(&per_cu, (const void*)mega, NTHR, LDS_BYTES) != hipSuccess || per_cu < 1) { fprintf(stderr, "kernel_launch: occupancy query says %d\n", per_cu); grid = -1; return; }
        grid = cus;
    }
    if (grid < 0) return;
    hipMemsetAsync((char*)d_ws + WS_CTL, 0, CTL_ZERO_BYTES, stream);
    Args a{};
    for (int i = 0; i < 23; ++i) a.in[i] = (const float*)d_in[i];
    a.out = (float*)d_out; a.ws = (unsigned char*)d_ws; a.pad = 0;
#if N_LAUNCH_MODE == 1
    a.ph_lo = 0; a.ph_hi = NPHASE; a.use_bar = 1;
    hipLaunchKernelGGL(mega, dim3(grid), dim3(NTHR), LDS_BYTES, stream, a);
#else
    for (int p = 0; p < NPHASE; ++p) { a.ph_lo = p; a.ph_hi = p + 1; a.use_bar = 0; hipLaunchKernelGGL(mega, dim3(grid), dim3(NTHR), LDS_BYTES, stream, a); }
#endif
}
```

```cpp
#include <hip/hip_runtime.h>
#include <cstdio>
#include <cstdint>
#define N_LAUNCH_MODE 1
#ifndef PG8_WGM
#define PG8_WGM 8
#endif
namespace pg8 {
#define PG8_LAS __attribute__((address_space(3)))
typedef unsigned short bf16_t;
typedef short bf16x8 __attribute__((ext_vector_type(8)));
typedef float f32x4 __attribute__((ext_vector_type(4)));
typedef unsigned u32x4 __attribute__((ext_vector_type(4)));
typedef int i32x4 __attribute__((ext_vector_type(4)));
typedef int i32x8 __attribute__((ext_vector_type(8)));
constexpr int BM = 256, BK = 64, HALF = 128, HTB = HALF * BK * 2  , STAGE_BYTES = 8 * HTB, NXCD = 8, WGM = PG8_WGM;

__host__ __device__ __forceinline__ int lds_byte(int r, int c) { const int st = (r >> 4) * 2 + (c >> 5), rr = r & 15, cc = c & 31, ob = rr * 64 + cc * 2; return st * 1024 + (ob ^ (((ob >> 9) & 1) << 5)); }
__host__ __device__ __forceinline__ void stage_rc(int b, int& R, int& C) { const int st = b / 1024, sb = b % 1024, swz = sb ^ (((sb >> 9) & 1) << 5); R = (st >> 1) * 16 + swz / 64; C = (st & 1) * 32 + (swz % 64) / 2; }
__host__ __device__ __forceinline__ int perm32(int rho) { const int n = rho >> 4, i = rho & 15; return 8 * (i >> 2) + 4 * n + (i & 3); }

struct Unit { int pm, pn, ko; };
struct Gemm { const bf16_t* A; const bf16_t* Bt; int M, N, K, lda, ldb; };

struct StaticOrder {
    int nM, nN, nwg, G, c;
    __host__ __device__ __forceinline__ void init(int M, int N, int G_, int c_) { nM = M / BM; nN = N / BM; nwg = nM * nN; G = G_; c = c_; }
    __host__ __device__ __forceinline__ bool next(int i, Unit& u) const {
        const long L = (long)i * G + c; if (L >= nwg) return false;
        int wgid = (int)L; { const int q = nwg / NXCD, r = nwg % NXCD, xcd = wgid % NXCD, off = wgid / NXCD; wgid = (xcd < r ? xcd * (q + 1) : r * (q + 1) + (xcd - r) * q) + off; }
        const int nig = WGM * nN, gid = wgid / nig, fm = gid * WGM, w_ = wgid - gid * nig, rem = (nM % WGM) ? (nM % WGM) : 1;
        if ((nM - fm) < WGM) { u.pm = fm + (w_ % rem); u.pn = w_ / rem; } else { u.pm = fm + (w_ % WGM); u.pn = w_ / WGM; }
        u.ko = 0; return true;
    }
    __device__ __forceinline__ void a_ready(const Unit&) const {}
    __device__ __forceinline__ void done(const Unit&) const {}
    __device__ __forceinline__ bool zero_after(const Unit&) const { return true; }
};

template <class Epi, class Sched, bool ALIGN_EPI = false, bool SP2 = false, bool F8 = false>
__device__ __forceinline__ void gemm_phase(PG8_LAS unsigned char* lds, const Gemm g, const Sched& S, const Epi& E, f32x4 (&acc)[2][2][4][2]) {
    int tid_ = threadIdx.x; asm volatile("" : "+v"(tid_));
    const int tid = tid_, wid = __builtin_amdgcn_readfirstlane(tid >> 6), lane = tid & 63, wr = wid >> 2, wc = wid & 3, fr = lane & 15, fq = lane >> 4;
    const int K = g.K, nt = K / BK;
    unsigned voffA[2], voffB[2];
#pragma unroll
    for (int i = 0; i < 2; ++i) { int R, C; stage_rc(tid * 16 + i * 8192, R, C); const int Rb = Epi::PERM ? ((R & ~31) + perm32(R & 31)) : R;
        voffA[i] = (unsigned)(R * g.lda + C) * 2u; voffB[i] = (unsigned)(Rb * g.ldb + C) * 2u; }
    const size_t kstep = (size_t)(BK * 2);
    const size_t hstepA = (size_t)HALF * g.lda * 2, hstepB = (size_t)HALF * g.ldb * 2;
    const size_t tstepA = 2 * hstepA, tstepB = 2 * hstepB;
    const unsigned ldsw = (unsigned)wid * 1024u;
    const int aoff = lds_byte(wr * 64 + fr, fq * 8), boff = lds_byte(wc * 32 + fr, fq * 8);
#define PG8_SA(b, h) (((b) * 2 + (h)) * HTB)
#define PG8_SB(b, h) ((4 + (b) * 2 + (h)) * HTB)
#define PG8_STAGE(bufoff, gbase, voff) do { _Pragma("unroll") for (int _i = 0; _i < 2; ++_i) \
        __builtin_amdgcn_global_load_lds((const unsigned*)((const char*)(gbase) + (voff)[_i]), (PG8_LAS unsigned*)(lds + (bufoff) + ldsw + _i * 8192), 16, 0, 0); } while (0)
#define PG8_LDA(dst, b, h) do { if constexpr (F8) { _Pragma("unroll") for (int m = 0; m < 4; ++m) dst##8[m] = __builtin_shufflevector(*(const PG8_LAS i32x4*)(lds + PG8_SA(b, h) + aoff + m * 2048), *(const PG8_LAS i32x4*)(lds + PG8_SA(b, h) + aoff + m * 2048 + 1024), 0, 1, 2, 3, 4, 5, 6, 7); } \
        else { _Pragma("unroll") for (int m = 0; m < 4; ++m) _Pragma("unroll") for (int k = 0; k < 2; ++k) dst[m][k] = *(const PG8_LAS bf16x8*)(lds + PG8_SA(b, h) + aoff + m * 2048 + k * 1024); } } while (0)
#define PG8_LDB(dst, b, h) do { if constexpr (F8) { _Pragma("unroll") for (int n = 0; n < 2; ++n) dst##8[n] = __builtin_shufflevector(*(const PG8_LAS i32x4*)(lds + PG8_SB(b, h) + boff + n * 2048), *(const PG8_LAS i32x4*)(lds + PG8_SB(b, h) + boff + n * 2048 + 1024), 0, 1, 2, 3, 4, 5, 6, 7); } \
        else { _Pragma("unroll") for (int n = 0; n < 2; ++n) _Pragma("unroll") for (int k = 0; k < 2; ++k) dst[n][k] = *(const PG8_LAS bf16x8*)(lds + PG8_SB(b, h) + boff + n * 2048 + k * 1024); } } while (0)
#define PG8_CAT8(x0, x1) __builtin_shufflevector(__builtin_bit_cast(i32x4, (x0)), __builtin_bit_cast(i32x4, (x1)), 0, 1, 2, 3, 4, 5, 6, 7)
#define PG8_MMA(ai, bj, At, Bt) do { __builtin_amdgcn_s_setprio(1); \
        if constexpr (F8) { _Pragma("unroll") for (int m = 0; m < 4; ++m) _Pragma("unroll") for (int n = 0; n < 2; ++n) \
            asm volatile("v_mfma_f32_16x16x128_f8f6f4 %0, %1, %2, %0" : "+v"(acc[ai][bj][m][n]) : "v"(Bt##8[n]), "v"(At##8[m])); }   \
        else { _Pragma("unroll") for (int m = 0; m < 4; ++m) _Pragma("unroll") for (int n = 0; n < 2; ++n) _Pragma("unroll") for (int k = 0; k < 2; ++k) \
            acc[ai][bj][m][n] = __builtin_amdgcn_mfma_f32_16x16x32_bf16(Bt[n][k], At[m][k], acc[ai][bj][m][n], 0, 0, 0); } \
        __builtin_amdgcn_s_setprio(0); } while (0)
#define PG8_WAIT_V(n) asm volatile("s_waitcnt vmcnt(" #n ")" ::: "memory")
#define PG8_WAIT_L(n) asm volatile("s_waitcnt lgkmcnt(" #n ")" ::: "memory")
#define PG8_BAR __builtin_amdgcn_s_barrier()
#define PG8_SCHED __builtin_amdgcn_sched_barrier(0)
    Unit cur, nxt; int ui = 0;
    if (!S.next(0, cur)) return;
    bf16x8 At[4][2], B0[2][2], B1[2][2];
    i32x8 At8[4], B08[2], B18[2];
    const char* cA = (const char*)g.A + (size_t)cur.pm * tstepA + (size_t)cur.ko * 2; const char* cB = (const char*)g.Bt + (size_t)cur.pn * tstepB + (size_t)cur.ko * 2;
    S.a_ready(cur);
    if constexpr (SP2) {
        PG8_STAGE(PG8_SB(0, 0), cB, voffB); PG8_STAGE(PG8_SB(0, 1), cB + hstepB, voffB); PG8_STAGE(PG8_SA(0, 0), cA, voffA); PG8_STAGE(PG8_SA(0, 1), cA + hstepA, voffA);
        if (wr == 1) PG8_BAR;
        PG8_WAIT_V(2); PG8_BAR;
        PG8_STAGE(PG8_SB(1, 0), cB + kstep, voffB); PG8_STAGE(PG8_SA(1, 0), cA + kstep, voffA); PG8_STAGE(PG8_SB(1, 1), cB + hstepB + kstep, voffB);
        PG8_WAIT_V(6); PG8_BAR;
    } else {
        PG8_STAGE(PG8_SB(0, 0), cB, voffB); PG8_STAGE(PG8_SA(0, 0), cA, voffA); PG8_STAGE(PG8_SB(0, 1), cB + hstepB, voffB); PG8_STAGE(PG8_SA(0, 1), cA + hstepA, voffA);
        if (wr == 1) PG8_BAR;
        PG8_WAIT_V(4); PG8_BAR;
        PG8_STAGE(PG8_SB(1, 0), cB + kstep, voffB); PG8_STAGE(PG8_SA(1, 0), cA + kstep, voffA); PG8_STAGE(PG8_SB(1, 1), cB + hstepB + kstep, voffB);
        PG8_WAIT_V(6); PG8_BAR;
    }
    for (;;) {
        const bool has_next = S.next(ui + 1, nxt);
        const char* nA = has_next ? (const char*)g.A + (size_t)nxt.pm * tstepA + (size_t)nxt.ko * 2 : cA; const char* nB = has_next ? (const char*)g.Bt + (size_t)nxt.pn * tstepB + (size_t)nxt.ko * 2 : cB;
        for (int t = 0; t < nt; t += 2) {
            const bool last = (t == nt - 2);
            const char* a1 = cA + (size_t)(t + 1) * kstep;
            const char* a2 = last ? nA : cA + (size_t)(t + 2) * kstep; const char* b2 = last ? nB : cB + (size_t)(t + 2) * kstep;
            const char* a3 = a2 + kstep; const char* b3 = b2 + kstep;
            if (last && has_next) S.a_ready(nxt);
            if constexpr (SP2) {
            PG8_LDB(B0, 0, 0); PG8_LDB(B1, 0, 1); PG8_SCHED; PG8_LDA(At, 0, 0); PG8_STAGE(PG8_SA(1, 1), a1 + hstepA, voffA);
            PG8_WAIT_V(8); PG8_WAIT_L(0); PG8_BAR; PG8_MMA(0, 0, At, B0); PG8_MMA(0, 1, At, B1); PG8_BAR; PG8_SCHED;
            PG8_LDA(At, 0, 1); PG8_STAGE(PG8_SB(0, 0), b2, voffB); PG8_STAGE(PG8_SB(0, 1), b2 + hstepB, voffB); PG8_STAGE(PG8_SA(0, 0), a2, voffA);
            PG8_WAIT_V(8); PG8_WAIT_L(0); PG8_BAR; PG8_MMA(1, 0, At, B0); PG8_MMA(1, 1, At, B1); PG8_BAR; PG8_SCHED;
            PG8_LDB(B0, 1, 0); PG8_LDB(B1, 1, 1); PG8_SCHED; PG8_LDA(At, 1, 0); PG8_STAGE(PG8_SA(0, 1), a2 + hstepA, voffA);
            PG8_WAIT_V(8); PG8_WAIT_L(0); PG8_BAR; PG8_MMA(0, 0, At, B0); PG8_MMA(0, 1, At, B1); PG8_BAR; PG8_SCHED;
            PG8_LDA(At, 1, 1); PG8_STAGE(PG8_SB(1, 0), b3, voffB); PG8_STAGE(PG8_SB(1, 1), b3 + hstepB, voffB); PG8_STAGE(PG8_SA(1, 0), a3, voffA);
            PG8_WAIT_V(8); PG8_WAIT_L(0); PG8_BAR; PG8_MMA(1, 0, At, B0); PG8_MMA(1, 1, At, B1); PG8_BAR; PG8_SCHED;
            } else {
            PG8_LDB(B0, 0, 0); PG8_SCHED; PG8_LDA(At, 0, 0); PG8_STAGE(PG8_SA(1, 1), a1 + hstepA, voffA);
            PG8_WAIT_L(8); PG8_BAR; PG8_WAIT_L(0); PG8_MMA(0, 0, At, B0); PG8_BAR; PG8_SCHED;
            PG8_LDB(B1, 0, 1); PG8_STAGE(PG8_SB(0, 0), b2, voffB);
            PG8_BAR; PG8_WAIT_L(0); PG8_MMA(0, 1, At, B1); PG8_BAR;
            PG8_LDA(At, 0, 1); PG8_STAGE(PG8_SA(0, 0), a2, voffA);
            PG8_BAR; PG8_WAIT_L(0); PG8_MMA(1, 0, At, B0); PG8_BAR; PG8_SCHED;
            PG8_STAGE(PG8_SB(0, 1), b2 + hstepB, voffB);
            PG8_WAIT_V(6); PG8_BAR; PG8_MMA(1, 1, At, B1); PG8_BAR;
            PG8_LDB(B0, 1, 0); PG8_SCHED; PG8_LDA(At, 1, 0); PG8_STAGE(PG8_SA(0, 1), a2 + hstepA, voffA);
            PG8_WAIT_L(8); PG8_BAR; PG8_WAIT_L(0); PG8_MMA(0, 0, At, B0); PG8_BAR; PG8_SCHED;
            PG8_LDB(B1, 1, 1); PG8_STAGE(PG8_SB(1, 0), b3, voffB);
            PG8_BAR; PG8_WAIT_L(0); PG8_MMA(0, 1, At, B1); PG8_BAR;
            PG8_LDA(At, 1, 1); PG8_STAGE(PG8_SA(1, 0), a3, voffA);
            PG8_BAR; PG8_WAIT_L(0); PG8_MMA(1, 0, At, B0); PG8_BAR; PG8_SCHED;
            PG8_STAGE(PG8_SB(1, 1), b3 + hstepB, voffB);
            PG8_WAIT_V(6); PG8_BAR; PG8_MMA(1, 1, At, B1); PG8_BAR;
            }
        }
        if constexpr (ALIGN_EPI) { if (wr == 0) PG8_BAR; }
        if constexpr (F8) {
            asm volatile("s_nop 15\n\ts_nop 15\n\ts_nop 7" : "+v"(acc[0][0][0][0]), "+v"(acc[0][0][0][1]), "+v"(acc[0][0][1][0]), "+v"(acc[0][0][1][1]), "+v"(acc[0][0][2][0]), "+v"(acc[0][0][2][1]), "+v"(acc[0][0][3][0]), "+v"(acc[0][0][3][1]), "+v"(acc[0][1][0][0]), "+v"(acc[0][1][0][1]), "+v"(acc[0][1][1][0]), "+v"(acc[0][1][1][1]), "+v"(acc[0][1][2][0]), "+v"(acc[0][1][2][1]), "+v"(acc[0][1][3][0]), "+v"(acc[0][1][3][1]));
            asm volatile("" : "+v"(acc[1][0][0][0]), "+v"(acc[1][0][0][1]), "+v"(acc[1][0][1][0]), "+v"(acc[1][0][1][1]), "+v"(acc[1][0][2][0]), "+v"(acc[1][0][2][1]), "+v"(acc[1][0][3][0]), "+v"(acc[1][0][3][1]), "+v"(acc[1][1][0][0]), "+v"(acc[1][1][0][1]), "+v"(acc[1][1][1][0]), "+v"(acc[1][1][1][1]), "+v"(acc[1][1][2][0]), "+v"(acc[1][1][2][1]), "+v"(acc[1][1][3][0]), "+v"(acc[1][1][3][1])); }
        if constexpr (!Epi::AFTER_DRAIN) { E(acc, cur, wr, wc, fr, fq); S.done(cur); }
        if (!has_next) break;
        if (S.zero_after(cur)) {
#pragma unroll
        for (int a = 0; a < 2; ++a)
#pragma unroll
            for (int b = 0; b < 2; ++b)
#pragma unroll
                for (int m = 0; m < 4; ++m)
#pragma unroll
                    for (int n = 0; n < 2; ++n) acc[a][b][m][n] = (f32x4){0.f, 0.f, 0.f, 0.f};
        }
        cur = nxt; cA = nA; cB = nB; ++ui;
        if constexpr (ALIGN_EPI) { if (wr == 1) PG8_BAR; }
    }
    PG8_WAIT_V(0);
    if constexpr (!ALIGN_EPI) { if (wr == 0) PG8_BAR; }
    PG8_BAR;
    if constexpr (Epi::AFTER_DRAIN) { E.fused(acc, cur, wr, wc, fr, fq, lds, wid, lane); S.done(cur); }
#undef PG8_SA
#undef PG8_SB
#undef PG8_STAGE
#undef PG8_LDA
#undef PG8_LDB
#undef PG8_MMA
#undef PG8_CAT8
#undef PG8_WAIT_V
#undef PG8_WAIT_L
#undef PG8_BAR
#undef PG8_SCHED
}
}
#ifndef REP_IN
#define REP_IN 1
#endif
#ifndef REP_BR
#define REP_BR 1
#endif
#ifndef REP_OUT
#define REP_OUT 1
#endif
#ifndef REP_FIN
#define REP_FIN 1
#endif
#ifndef GEMM_STREAM
#define GEMM_STREAM 3
#endif
#ifndef REP_J0
#define REP_J0 1
#endif
#ifndef REP_J1
#define REP_J1 1
#endif
#ifndef REP_J2
#define REP_J2 1
#endif
#ifndef REP_SCAN
#define REP_SCAN 1
#endif
#ifndef REP_P0
#define REP_P0 1
#endif
#ifndef SEG0
#define SEG0 0
#endif
#ifndef GATELESS
#define GATELESS 1
#endif
#ifndef GEMM_ONEUNIT
#define GEMM_ONEUNIT 1
#endif
#ifndef DIAGSEL
#define DIAGSEL 4095
#endif
#ifndef NO_T4
#define NO_T4 0
#endif
#ifndef NO_T5
#define NO_T5 0
#endif
#ifndef NO_T6
#define NO_T6 0
#endif
#ifndef DIAG_SIMPLE
#define DIAG_SIMPLE 0
#endif
#ifndef GEMM_ALIGN
#define GEMM_ALIGN true
#endif
#ifndef GEMM_SP2
#define GEMM_SP2 true
#endif
#ifndef PHM
#define PHM 127
#endif
#ifndef JOBM
#define JOBM 7
#endif

#define GAS __attribute__((address_space(1)))
#define LAS __attribute__((address_space(3)))
typedef unsigned short bf16;
typedef short bf16x8 __attribute__((ext_vector_type(8)));
typedef short bf16x4 __attribute__((ext_vector_type(4)));
typedef float f32x4 __attribute__((ext_vector_type(4)));
typedef unsigned u32x4 __attribute__((ext_vector_type(4)));
typedef unsigned u32x2 __attribute__((ext_vector_type(2)));
#define DI __device__ __forceinline__
#define LDS_WAIT() asm volatile("s_waitcnt lgkmcnt(0)" ::: "memory")
typedef float f32x2_t __attribute__((ext_vector_type(2)));
typedef __bf16 bf16x2_t __attribute__((ext_vector_type(2)));
DI unsigned pk2(float lo, float hi) { const f32x2_t v = {lo, hi}; const bf16x2_t b = __builtin_convertvector(v, bf16x2_t); return __builtin_bit_cast(unsigned, b); }
DI unsigned pk4f8(float a, float b, float c, float d) { int w = 0; w = __builtin_amdgcn_cvt_pk_fp8_f32(a, b, w, false); w = __builtin_amdgcn_cvt_pk_fp8_f32(c, d, w, true); return (unsigned)w; }
DI unsigned pk4u8(float a, float b, float c, float d) { unsigned w = 0u; w = __builtin_amdgcn_cvt_pk_u8_f32(a, 0, w); w = __builtin_amdgcn_cvt_pk_u8_f32(b, 1, w); w = __builtin_amdgcn_cvt_pk_u8_f32(c, 2, w); w = __builtin_amdgcn_cvt_pk_u8_f32(d, 3, w); return w; }
DI float ub0(unsigned w) { return (float)(w & 0xffu); }
DI float ub1(unsigned w) { return (float)((w >> 8) & 0xffu); }
DI float ub2(unsigned w) { return (float)((w >> 16) & 0xffu); }
DI float ub3(unsigned w) { return (float)(w >> 24); }
DI bf16 f2bf(float f) { return (bf16)(pk2(f, 0.f) & 0xffffu); }
DI float bf2f(unsigned b) { return __uint_as_float(b << 16); }
DI float bflo(unsigned w) { return __uint_as_float(w << 16); }
DI float bfhi(unsigned w) { return __uint_as_float(w & 0xffff0000u); }
DI float sigmoidf_(float x) { return __builtin_amdgcn_rcpf(1.0f + __expf(-x)); }
DI float siluf_(float x) { return x * sigmoidf_(x); }
DI float wave_sum(float v) {
#pragma unroll
    for (int o = 1; o < 64; o <<= 1) v += __shfl_xor(v, o);
    return v;
}
#define MFMA16(a, b, c) __builtin_amdgcn_mfma_f32_16x16x32_bf16((a), (b), (c), 0, 0, 0)

constexpr int DM = 4096, MP = 8192, MS_ = 256, MT = 8448;
constexpr int BW = 2048;
constexpr int NIN = 30976;
constexpr int KBR = 6144;
constexpr float EPS = 1e-6f;
constexpr int NWAVES = 8, NTHR = 512;
constexpr int LDS_BYTES = 147456;
constexpr int MISC_OFF = LDS_BYTES - 256;

constexpr size_t O_YP = 0, O_YS = 33554432, O_HGP = 34603008, O_HGS = 36700160, O_LHP = 40894464, O_LHS = 40910848,
                 O_LCP = 40943616, O_LCS = 40992768, O_GLP = 41091072, O_GLS = 45285376, O_END = 53673984;

constexpr size_t MiB = 1u << 20;
constexpr size_t alup(size_t x) { return (x + MiB - 1) / MiB * MiB; }
constexpr size_t WS_CTL = 0, CTL_ZERO_BYTES = MiB;
constexpr size_t SZ_WIN = alup((size_t)NIN * DM * 2), SZ_WBR = alup((size_t)DM * KBR * 2), SZ_WOU = alup((size_t)DM * DM * 2);
constexpr size_t WS_WIN = MiB, WS_WBR = WS_WIN + 2 * SZ_WIN, WS_WOU = WS_WBR + 2 * SZ_WBR;
constexpr size_t WS_Z = WS_WOU + 2 * SZ_WOU;
constexpr size_t WS_HQ = WS_Z + alup((size_t)MT * DM * 2);
constexpr size_t WS_HG = WS_HQ + alup((size_t)MT * BW * 2);
constexpr size_t WS_HV = WS_HG + alup((size_t)MT * BW * 4);
constexpr size_t WS_HGATE = WS_HV + alup((size_t)MT * BW * 2);
constexpr size_t WS_LX = WS_HGATE + alup((size_t)MT * BW * 2);
constexpr size_t WS_LGATE = WS_LX + alup((size_t)MT * BW * 4);
constexpr size_t WS_CQ = WS_LGATE + alup((size_t)MT * BW * 2);
constexpr size_t WS_CK = WS_CQ + alup((size_t)MT * 1024 * 2);
constexpr size_t WS_CV = WS_CK + alup((size_t)MT * 1024 * 2);
constexpr size_t WS_CGATE = WS_CV + alup((size_t)MT * BW * 2);
constexpr size_t WS_MG = WS_CGATE + alup((size_t)MT * BW * 2);
constexpr size_t WS_CLR = WS_MG + alup((size_t)MT * 12288 * 2);
constexpr size_t WS_Y = WS_CLR + alup((size_t)MT * 16 * 4);
constexpr size_t WS_OC = WS_Y + alup((size_t)MT * KBR * 2);
constexpr size_t WS_SSQ = WS_OC + alup((size_t)MT * 2 * BW * 4);
constexpr size_t WS_MERGED = WS_SSQ + alup((size_t)MT * 32 * 4);
constexpr size_t WS_MB = WS_MERGED + alup((size_t)MT * DM * 4);
constexpr size_t WS_OUT = WS_MB + alup((size_t)MT * DM * 2);
constexpr size_t WS_X1 = WS_OUT + alup((size_t)MT * DM * 4);
constexpr size_t WS_PB = WS_X1 + alup((size_t)MT * DM * 4);
constexpr size_t WS_PO = WS_PB + alup((size_t)3 * 256 * DM * 4);
constexpr int NCHK = 136;
constexpr size_t WS_GQT = WS_PO + alup((size_t)4 * 256 * DM * 4);
constexpr size_t WS_GKT = WS_GQT + alup((size_t)MT * 1024 * 2);
constexpr size_t WS_GKH = WS_GKT + alup((size_t)MT * 1024 * 2);
constexpr size_t WS_GER = WS_GKH + alup((size_t)NCHK * 1024 * 64 * 2);
constexpr size_t WS_GEB = WS_GER + alup((size_t)NCHK * 1024 * 4);
constexpr size_t WS_Z8 = WS_GEB + alup((size_t)NCHK * 1024 * 4);
constexpr size_t SZ_W8 = alup((size_t)12288 * DM);
constexpr size_t WS_W8 = WS_Z8 + alup((size_t)MT * DM);
constexpr size_t WS_END = WS_W8 + 2 * SZ_W8;
constexpr int CW_BAR = 4096;
constexpr int CW_TEAM = 16384;

#define XB_TMO      128
#define XB_XCNT(j)  (256  + 64 * (j))
#define XB_XSUB(j)  (1280 + 64 * (j))
#define XB_XGEN(j)  (2304 + 64 * (j))
#define XB_TOP      3328
#define XB_TOPGEN   3392
#define XCD_BAR_WORDS 3456
#define XB_SPIN_CAP (1u << 18)
__device__ __forceinline__ unsigned xb_ld(unsigned* p)              { return __hip_atomic_load(p, __ATOMIC_RELAXED, __HIP_MEMORY_SCOPE_AGENT); }
__device__ __forceinline__ unsigned xb_add(unsigned* p, unsigned v) { return __hip_atomic_fetch_add(p, v, __ATOMIC_RELAXED, __HIP_MEMORY_SCOPE_AGENT); }
__device__ __forceinline__ unsigned xb_xcc_id() { return (unsigned)__builtin_amdgcn_s_getreg((3 << 11) | 20) & 0xFu; }
#define XB_SPIN(cond, bar) do { unsigned _sp = 0; while (cond) { __builtin_amdgcn_s_sleep(1); \
    if ((++_sp & 255u) == 0u) { if (xb_ld(&(bar)[XB_TMO])) break; if (_sp > XB_SPIN_CAP) { atomicAdd(&(bar)[XB_TMO], 1u); break; } } } } while (0)
struct XcdBarrier { unsigned* bar; unsigned x; volatile LAS unsigned* st; };
__device__ __forceinline__ XcdBarrier xcd_barrier_post(unsigned* bar, volatile LAS unsigned* st) {
    XcdBarrier b; b.bar = bar; b.x = xb_xcc_id(); b.st = st;
    if (threadIdx.x == 0) (void)xb_add(&bar[XB_XCNT(b.x)], 1u);
    return b;
}
__device__ __forceinline__ void xcd_barrier_complete(unsigned* bar, unsigned x, unsigned& nloc, unsigned& nx) {
    const unsigned G = gridDim.x * gridDim.y * gridDim.z;
    unsigned sum, cnt, mine, sp = 0u;
    for (;;) {
        sum = 0u; cnt = 0u; mine = 0u;
#pragma unroll
        for (unsigned j = 0; j < 16; ++j) { const unsigned c = xb_ld(&bar[XB_XCNT(j)]); sum += c; cnt += (c > 0u) ? 1u : 0u; mine = (j == x) ? c : mine; }
        if (sum == G) break;
        __builtin_amdgcn_s_sleep(1);
        if ((++sp & 255u) == 0u) { if (xb_ld(&bar[XB_TMO])) break; if (sp > XB_SPIN_CAP) { atomicAdd(&bar[XB_TMO], 1u); break; } }
    }
    nloc = mine > 0u ? mine : 1u; nx = cnt > 0u ? cnt : 1u;
}
__device__ __forceinline__ void xcd_barrier(const XcdBarrier& b) {
    asm volatile("s_waitcnt vmcnt(0)" ::: "memory");
    __syncthreads();
    if (threadIdx.x == 0) {
        unsigned* bar = b.bar;
        __builtin_amdgcn_s_waitcnt(0);
        unsigned nloc = b.st[0], nx = b.st[1];
        if (nloc == 0u) { xcd_barrier_complete(bar, b.x, nloc, nx); b.st[0] = nloc; b.st[1] = nx; }
        const unsigned old = xb_add(&bar[XB_XSUB(b.x)], 1u);
        const unsigned gen = old / nloc;
        if (old + 1u == (gen + 1u) * nloc) {
            __builtin_amdgcn_fence(__ATOMIC_RELEASE, "agent");
            asm volatile("s_waitcnt vmcnt(0)" ::: "memory");
            const unsigned og = xb_add(&bar[XB_TOP], 1u);
            const unsigned tg = og / nx;
            if (og + 1u == (tg + 1u) * nx) xb_add(&bar[XB_TOPGEN], 1u);
            else XB_SPIN(xb_ld(&bar[XB_TOPGEN]) == tg, bar);
            __builtin_amdgcn_fence(__ATOMIC_ACQUIRE, "agent");
            xb_add(&bar[XB_XGEN(b.x)], 1u);
            asm volatile("s_waitcnt vmcnt(0)" ::: "memory");
        } else {
            XB_SPIN(xb_ld(&bar[XB_XGEN(b.x)]) == gen, bar);
            __builtin_amdgcn_fence(__ATOMIC_ACQUIRE, "agent");
            asm volatile("s_waitcnt vmcnt(0)" ::: "memory");
        }
    }
    __syncthreads();
}

typedef pg8::f32x4 af4;
struct EpiInProj {
    static constexpr bool PERM = true, AFTER_DRAIN = true;
    DI void fused(af4 (&acc)[2][2][4][2], const pg8::Unit& u, int wr, int wc, int fr, int fq, LAS unsigned char*, int, int) const { (*this)(acc, u, wr, wc, fr, fq); }
    bf16 *HQ, *HV, *HGATE, *LGATE, *CQ, *CK, *CV, *CGATE; unsigned char* MG; float *HG, *LX, *CLR; const float* lbl; int layer; float mgs;
    template <int T> DI void body(const af4 (&acc)[2][2][4][2], void* base, const int ld, const int row0, const int col0) const {
        af4 lbv[2][2];
        if (T == 5) {
#pragma unroll
            for (int bj = 0; bj < 2; ++bj)
#pragma unroll
                for (int hh = 0; hh < 2; ++hh) { const af4 a0 = *(const af4*)(lbl + col0 + bj * 128 + 4 * hh), a1 = *(const af4*)(lbl + BW + col0 + bj * 128 + 4 * hh);
#pragma unroll
                    for (int j = 0; j < 4; ++j) { const float mx = fmaxf(a0[j], a1[j]); const float e0 = __expf(a0[j] - mx), e1 = __expf(a1[j] - mx); lbv[bj][hh][j] = layer ? e1 / (e0 + e1) : 0.f; } }
        }
        if (T == 2) {
            int c0 = col0; asm volatile("" : "+v"(c0)); const int odd = (c0 >> 3) & 1;
#pragma unroll
            for (int ai = 0; ai < 2; ++ai)
#pragma unroll
                for (int mp = 0; mp < 2; ++mp)
#pragma unroll
                    for (int bj = 0; bj < 2; ++bj) {
                        unsigned px[2], py[2];
#pragma unroll
                        for (int h = 0; h < 2; ++h) { af4 v0 = acc[ai][bj][2 * mp + h][0], v1 = acc[ai][bj][2 * mp + h][1];
#pragma unroll
                            for (int j = 0; j < 4; ++j) { v0[j] = fmaxf(sigmoidf_(v0[j] * mgs) * 255.0f + 0.5f, 1.0f); v1[j] = fmaxf(sigmoidf_(v1[j] * mgs) * 255.0f + 0.5f, 1.0f); }
                            px[h] = pk4u8(v0[0], v0[1], v0[2], v0[3]); py[h] = pk4u8(v1[0], v1[1], v1[2], v1[3]); __builtin_amdgcn_sched_barrier(0); }
                        const auto rx = __builtin_amdgcn_permlane16_swap(px[0], px[1], false, false); const auto ry = __builtin_amdgcn_permlane16_swap(py[0], py[1], false, false);
                        u32x4 o; o.x = rx[0]; o.y = ry[0]; o.z = rx[1]; o.w = ry[1];
                        *(u32x4*)((unsigned char*)base + (size_t)(row0 + ai * 128 + (2 * mp + odd) * 16) * ld + (c0 - 8 * odd) + bj * 128) = o;
                    }
            return;
        }
#pragma unroll
        for (int ai = 0; ai < 2; ++ai)
#pragma unroll
            for (int m = 0; m < 4; ++m) {
                const size_t rowoff = (size_t)(row0 + ai * 128 + m * 16) * ld;
#pragma unroll
                for (int bj = 0; bj < 2; ++bj) {
                    af4 v0 = acc[ai][bj][m][0], v1 = acc[ai][bj][m][1];
                    const int col = col0 + bj * 128;
                    if (T <= 3) {
#pragma unroll
                        for (int j = 0; j < 4; ++j) {
                            if (T == 1) { v0[j] = siluf_(v0[j]); v1[j] = siluf_(v1[j]); }
                            if (T == 2) { v0[j] = sigmoidf_(v0[j] * mgs); v1[j] = sigmoidf_(v1[j] * mgs); }
                            if (T == 3) { v0[j] *= 0.0625f; v1[j] *= 0.0625f; }
                        }
                        if (T == 2) {
#pragma unroll
                            for (int j = 0; j < 4; ++j) { v0[j] = fmaxf(v0[j] * 255.0f + 0.5f, 1.0f); v1[j] = fmaxf(v1[j] * 255.0f + 0.5f, 1.0f); }
                            u32x2 o; o.x = pk4u8(v0[0], v0[1], v0[2], v0[3]); o.y = pk4u8(v1[0], v1[1], v1[2], v1[3]);
                            *(u32x2*)((unsigned char*)base + rowoff + col) = o;
                        } else {
                        u32x4 o; o.x = pk2(v0[0], v0[1]); o.y = pk2(v0[2], v0[3]); o.z = pk2(v1[0], v1[1]); o.w = pk2(v1[2], v1[3]);
                        *(u32x4*)((bf16*)base + rowoff + col) = o; }
                    } else if (T == 4) {
                        float* p = (float*)base + rowoff + col; *(af4*)p = v0; *(af4*)(p + 4) = v1;
                    } else if (T == 5) {
#pragma unroll
                        for (int j = 0; j < 4; ++j) {
                            const float l0 = lbv[bj][0][j], l1 = lbv[bj][1][j];
                            v0[j] = __logf(fmaxf(l0 + (1.0f - l0) * sigmoidf_(v0[j]), 1e-6f));
                            v1[j] = __logf(fmaxf(l1 + (1.0f - l1) * sigmoidf_(v1[j]), 1e-6f));
                        }
                        float* p = (float*)base + rowoff + col; *(af4*)p = v0; *(af4*)(p + 4) = v1;
                    } else {
                        if (col < 16) { float* p = (float*)base + rowoff + col; *(af4*)p = v0; *(af4*)(p + 4) = v1; }
                    }
                }
            }
    }
    DI void operator()(const af4 (&acc)[2][2][4][2], const pg8::Unit& u, int wr, int wc, int fr, int fq) const {
        const int row0 = u.pm * 256 + wr * 64 + fr, cl = wc * 32 + 8 * fq, pn = u.pn;
        if (pn < 8)        body<1>(acc, HQ, BW, row0, pn * 256 + cl);
        else if (pn < 16)  body<(NO_T5 ? (NO_T4 ? 0 : 4) : 5)>(acc, HG, BW, row0, (pn - 8) * 256 + cl);
        else if (pn < 24)  body<0>(acc, HV, BW, row0, (pn - 16) * 256 + cl);
        else if (pn < 32)  body<1>(acc, HGATE, BW, row0, (pn - 24) * 256 + cl);
        else if (pn < 40)  body<(NO_T4 ? 0 : 4)>(acc, LX, BW, row0, (pn - 32) * 256 + cl);
        else if (pn < 48)  body<1>(acc, LGATE, BW, row0, (pn - 40) * 256 + cl);
        else if (pn < 52)  body<3>(acc, CQ, 1024, row0, (pn - 48) * 256 + cl);
        else if (pn < 56)  body<0>(acc, CK, 1024, row0, (pn - 52) * 256 + cl);
        else if (pn < 64)  body<0>(acc, CV, BW, row0, (pn - 56) * 256 + cl);
        else if (pn < 72)  body<1>(acc, CGATE, BW, row0, (pn - 64) * 256 + cl);
        else if (pn < 120) body<2>(acc, MG, 12288, row0, (pn - 72) * 256 + cl);
        else               { if (!NO_T6) body<6>(acc, CLR, 16, row0, cl); }
    }
};
struct EpiBranchSeg {
    static constexpr bool PERM = true, AFTER_DRAIN = true;
    const unsigned char* MG; bf16* MB; int seg;
    DI void operator()(af4 (&acc)[2][2][4][2], const pg8::Unit& u, int wr, int wc, int fr, int fq) const { const EpiBranchSeg E2{MG, MB, u.ko / BW}; E2.fused(acc, u, wr, wc, fr, fq, nullptr, 0, 0); }
    DI void fused(af4 (&acc)[2][2][4][2], const pg8::Unit& u, int wr, int wc, int fr, int fq, LAS unsigned char*, int, int) const {
        int fqz = fq; asm volatile("" : "+v"(fqz));
        const int odd = fqz & 1;
        const size_t row0 = (size_t)(u.pm * 256 + wr * 64 + fr); const int col0 = u.pn * 256 + wc * 32 + 8 * fqz;
        const unsigned char* gp = MG + (row0 + 16 * odd) * 12288 + (size_t)seg * DM + (col0 - 8 * odd);
#define EB_PTR(p_) (gp + (size_t)((((p_) >> 2) & 1) * 128 + (((p_) >> 1) & 1) * 32) * 12288 + ((p_) & 1) * 128)
#define EB_SPLIT(L_, G0_, G1_) do { const auto rx_ = __builtin_amdgcn_permlane16_swap((L_).x, (L_).z, false, false); const auto ry_ = __builtin_amdgcn_permlane16_swap((L_).y, (L_).w, false, false); \
            G0_.x = rx_[0]; G0_.y = ry_[0]; G1_.x = rx_[1]; G1_.y = ry_[1]; } while (0)
        if (seg < 2) {
            u32x4 a0 = *(const u32x4*)EB_PTR(0), b0 = *(const u32x4*)(EB_PTR(0) + DM), a1 = *(const u32x4*)EB_PTR(1), b1 = *(const u32x4*)(EB_PTR(1) + DM);
#pragma unroll
            for (int p = 0; p < 8; ++p) {
                u32x4 a2 = a1, b2 = b1;
                if (p + 2 < 8) { a2 = *(const u32x4*)EB_PTR(p + 2); b2 = *(const u32x4*)(EB_PTR(p + 2) + DM); }
                u32x2 ga[2], gb[2]; EB_SPLIT(a0, ga[0], ga[1]); EB_SPLIT(b0, gb[0], gb[1]);
#pragma unroll
                for (int h = 0; h < 2; ++h) {
                    af4& v0 = acc[(p >> 2) & 1][p & 1][((p >> 1) & 1) * 2 + h][0]; af4& v1 = acc[(p >> 2) & 1][p & 1][((p >> 1) & 1) * 2 + h][1];
                    v0[0] *= ub0(ga[h].x) * __builtin_amdgcn_rcpf(ub0(gb[h].x)); v0[1] *= ub1(ga[h].x) * __builtin_amdgcn_rcpf(ub1(gb[h].x));
                    v0[2] *= ub2(ga[h].x) * __builtin_amdgcn_rcpf(ub2(gb[h].x)); v0[3] *= ub3(ga[h].x) * __builtin_amdgcn_rcpf(ub3(gb[h].x));
                    v1[0] *= ub0(ga[h].y) * __builtin_amdgcn_rcpf(ub0(gb[h].y)); v1[1] *= ub1(ga[h].y) * __builtin_amdgcn_rcpf(ub1(gb[h].y));
                    v1[2] *= ub2(ga[h].y) * __builtin_amdgcn_rcpf(ub2(gb[h].y)); v1[3] *= ub3(ga[h].y) * __builtin_amdgcn_rcpf(ub3(gb[h].y));
                    asm volatile("" : "+v"(v0), "+v"(v1) :: "memory");
                }
                asm volatile("" : "+v"(a1), "+v"(b1), "+v"(a2), "+v"(b2) :: "memory");
                a0 = a1; b0 = b1; a1 = a2; b1 = b2;
            }
        } else {
            constexpr float Q = 1.0f / 255.0f;
            u32x4 a0 = *(const u32x4*)EB_PTR(0), a1 = *(const u32x4*)EB_PTR(1);
#pragma unroll
            for (int p = 0; p < 8; ++p) {
                u32x4 a2 = a1;
                if (p + 2 < 8) a2 = *(const u32x4*)EB_PTR(p + 2);
                u32x2 gw[2]; EB_SPLIT(a0, gw[0], gw[1]);
#pragma unroll
                for (int h = 0; h < 2; ++h) {
                    const int m = ((p >> 1) & 1) * 2 + h; const size_t ro = (size_t)(((p >> 2) & 1) * 128 + m * 16);
                    af4 v0 = acc[(p >> 2) & 1][p & 1][m][0], v1 = acc[(p >> 2) & 1][p & 1][m][1];
                    v0[0] *= ub0(gw[h].x) * Q; v0[1] *= ub1(gw[h].x) * Q; v0[2] *= ub2(gw[h].x) * Q; v0[3] *= ub3(gw[h].x) * Q;
                    v1[0] *= ub0(gw[h].y) * Q; v1[1] *= ub1(gw[h].y) * Q; v1[2] *= ub2(gw[h].y) * Q; v1[3] *= ub3(gw[h].y) * Q;
                    u32x4 o; o.x = pk2(v0[0], v0[1]); o.y = pk2(v0[2], v0[3]); o.z = pk2(v1[0], v1[1]); o.w = pk2(v1[2], v1[3]);
                    *(u32x4*)(MB + (row0 + ro) * DM + col0 + (p & 1) * 128) = o;
                }
                asm volatile("" : "+v"(a1), "+v"(a2) :: "memory");
                a0 = a1; a1 = a2;
            }
        }
#undef EB_SPLIT
#undef EB_PTR
    }
};
struct EpiGateSlab {
    static constexpr bool PERM = true, AFTER_DRAIN = true;
    const unsigned char* MG; float* PB; int seg;
    DI void fused(af4 (&acc)[2][2][4][2], const pg8::Unit& u, int wr, int wc, int fr, int fq, LAS unsigned char*, int, int) const {
        const size_t row0 = (size_t)(u.pm * 256 + wr * 64 + fr); const int col0 = u.pn * 256 + wc * 32 + 8 * fq;
        const unsigned char* gp = MG + row0 * 12288 + (size_t)seg * DM + col0;
        float* pb = PB + ((size_t)seg * 256 + (size_t)(wr * 64 + fr)) * DM + col0;
        u32x2 gall[2][4][2];
#pragma unroll
        for (int ai = 0; ai < 2; ++ai)
#pragma unroll
            for (int m = 0; m < 4; ++m)
#pragma unroll
                for (int bj = 0; bj < 2; ++bj) gall[ai][m][bj] = *(const u32x2*)(gp + (size_t)(ai * 128 + m * 16) * 12288 + bj * 128);
#pragma unroll
        for (int ai = 0; ai < 2; ++ai)
#pragma unroll
            for (int m = 0; m < 4; ++m) {
#pragma unroll
                for (int bj = 0; bj < 2; ++bj) {
                    const size_t ro = (size_t)(ai * 128 + m * 16);
                    const u32x2 gw = gall[ai][m][bj]; constexpr float Q = 1.0f / 255.0f;
                    af4 v0 = acc[ai][bj][m][0], v1 = acc[ai][bj][m][1];
                    v0[0] *= ub0(gw.x) * Q; v0[1] *= ub1(gw.x) * Q; v0[2] *= ub2(gw.x) * Q; v0[3] *= ub3(gw.x) * Q;
                    v1[0] *= ub0(gw.y) * Q; v1[1] *= ub1(gw.y) * Q; v1[2] *= ub2(gw.y) * Q; v1[3] *= ub3(gw.y) * Q;
                    float* q = pb + ro * DM + bj * 128; *(af4*)q = v0; *(af4*)(q + 4) = v1;
                    asm volatile("" ::: "memory");
                }
            }
    }
};
struct EpiSimple {
    static constexpr bool PERM = true, AFTER_DRAIN = true;
    DI void fused(af4 (&acc)[2][2][4][2], const pg8::Unit& u, int wr, int wc, int fr, int fq, LAS unsigned char*, int, int) const { (*this)(acc, u, wr, wc, fr, fq); }
    bf16* O; int ldc;
    DI void operator()(const af4 (&acc)[2][2][4][2], const pg8::Unit& u, int wr, int wc, int fr, int fq) const {
        const int row0 = u.pm * 256 + wr * 64 + fr, col0 = u.pn * 256 + wc * 32 + 8 * fq;
#pragma unroll
        for (int ai = 0; ai < 2; ++ai)
#pragma unroll
            for (int m = 0; m < 4; ++m) {
                bf16* rp = O + (size_t)(row0 + ai * 128 + m * 16) * ldc + col0;
#pragma unroll
                for (int bj = 0; bj < 2; ++bj) { af4 v0 = acc[ai][bj][m][0], v1 = acc[ai][bj][m][1];
#pragma unroll
                    for (int j = 0; j < 4; ++j) { v0[j] = siluf_(v0[j]); v1[j] = siluf_(v1[j]); }
                    u32x4 o; o.x = pk2(v0[0], v0[1]); o.y = pk2(v0[2], v0[3]); o.z = pk2(v1[0], v1[1]); o.w = pk2(v1[2], v1[3]); *(u32x4*)(rp + bj * 128) = o; }
            }
    }
};
struct EpiBf {
    static constexpr bool PERM = true, AFTER_DRAIN = true;
    DI void fused(af4 (&acc)[2][2][4][2], const pg8::Unit& u, int wr, int wc, int fr, int fq, LAS unsigned char*, int, int) const { (*this)(acc, u, wr, wc, fr, fq); }
    bf16* O; int ldc;
    DI void operator()(const af4 (&acc)[2][2][4][2], const pg8::Unit& u, int wr, int wc, int fr, int fq) const {
        const int row0 = u.pm * 256 + wr * 64 + fr, col0 = u.pn * 256 + wc * 32 + 8 * fq;
#pragma unroll
        for (int ai = 0; ai < 2; ++ai)
#pragma unroll
            for (int m = 0; m < 4; ++m) {
                bf16* rp = O + (size_t)(row0 + ai * 128 + m * 16) * ldc + col0;
#pragma unroll
                for (int bj = 0; bj < 2; ++bj) { const af4 v0 = acc[ai][bj][m][0], v1 = acc[ai][bj][m][1];
                    u32x4 o; o.x = pk2(v0[0], v0[1]); o.y = pk2(v0[2], v0[3]); o.z = pk2(v1[0], v1[1]); o.w = pk2(v1[2], v1[3]); *(u32x4*)(rp + bj * 128) = o; }
            }
    }
};
struct EpiF32 {
    static constexpr bool PERM = true, AFTER_DRAIN = true;
    DI void fused(af4 (&acc)[2][2][4][2], const pg8::Unit& u, int wr, int wc, int fr, int fq, LAS unsigned char*, int, int) const { (*this)(acc, u, wr, wc, fr, fq); }
    float* C; int ldc;
    DI void operator()(const af4 (&acc)[2][2][4][2], const pg8::Unit& u, int wr, int wc, int fr, int fq) const {
        const int row0 = u.pm * 256 + wr * 64 + fr, col0 = u.pn * 256 + wc * 32 + 8 * fq;
#pragma unroll
        for (int ai = 0; ai < 2; ++ai)
#pragma unroll
            for (int m = 0; m < 4; ++m) {
                float* rp = C + (size_t)(row0 + ai * 128 + m * 16) * ldc + col0;
#pragma unroll
                for (int bj = 0; bj < 2; ++bj) { *(af4*)(rp + bj * 128) = acc[ai][bj][m][0]; *(af4*)(rp + bj * 128 + 4) = acc[ai][bj][m][1]; }
            }
    }
};

struct OneUnit {
    pg8::StaticOrder S; int i;
    DI bool next(int k, pg8::Unit& u) const { return k == 0 ? S.next(i, u) : false; }
    DI void a_ready(const pg8::Unit&) const {}
    DI void done(const pg8::Unit&) const {}
    DI bool zero_after(const pg8::Unit&) const { return true; }
};
struct InOrderA {
    pg8::StaticOrder S;
    DI bool next(int i, pg8::Unit& u) const { if (!S.next(i, u)) return false; if (u.pn == 72) u.pn = 120; return true; }
    DI void a_ready(const pg8::Unit&) const {}
    DI void done(const pg8::Unit&) const {}
    DI bool zero_after(const pg8::Unit&) const { return true; }
};
struct InOrder8 {
    pg8::StaticOrder S;
    DI bool next(int i, pg8::Unit& u) const { if (!S.next(i, u)) return false; u.pn += 72; return true; }
    DI void a_ready(const pg8::Unit&) const {}
    DI void done(const pg8::Unit&) const {}
    DI bool zero_after(const pg8::Unit&) const { return true; }
};
struct BranchOrder {
    pg8::StaticOrder S;
    DI bool next(int i, pg8::Unit& u) const { const int t = i / 3; if (!S.next(t, u)) return false; u.ko = (i - 3 * t) * BW; return true; }
    DI void a_ready(const pg8::Unit&) const {}
    DI void done(const pg8::Unit&) const {}
    DI bool zero_after(const pg8::Unit& u) const { return u.ko == 2 * BW; }
};
struct FixedUnit {
    pg8::Unit u0;
    DI bool next(int k, pg8::Unit& u) const { u = u0; return k == 0; }
    DI void a_ready(const pg8::Unit&) const {}
    DI void done(const pg8::Unit&) const {}
    DI bool zero_after(const pg8::Unit&) const { return true; }
};
DI void team_barrier(unsigned* cnt, unsigned n) {
    asm volatile("s_waitcnt vmcnt(0)" ::: "memory");
    __syncthreads();
    if (threadIdx.x == 0) {
        __builtin_amdgcn_fence(__ATOMIC_RELEASE, "agent");
        asm volatile("s_waitcnt vmcnt(0)" ::: "memory");
        (void)xb_add(cnt, 1u);
        unsigned sp = 0u;
        while (xb_ld(cnt) < n) { __builtin_amdgcn_s_sleep(2); if (++sp > (1u << 20)) break; }
        __builtin_amdgcn_fence(__ATOMIC_ACQUIRE, "agent");
        asm volatile("s_waitcnt vmcnt(0)" ::: "memory");
    }
    __syncthreads();
}
DI void team_arrive(unsigned* cnt) {
    asm volatile("s_waitcnt vmcnt(0)" ::: "memory");
    __syncthreads();
    if (threadIdx.x == 0) { __builtin_amdgcn_fence(__ATOMIC_RELEASE, "agent"); asm volatile("s_waitcnt vmcnt(0)" ::: "memory"); (void)xb_add(cnt, 1u); }
}
DI void zero_acc(af4 (&acc)[2][2][4][2]) {
#pragma unroll
    for (int a = 0; a < 2; ++a)
#pragma unroll
        for (int b = 0; b < 2; ++b)
#pragma unroll
            for (int mm = 0; mm < 4; ++mm)
#pragma unroll
                for (int n = 0; n < 2; ++n) acc[a][b][mm][n] = (af4){0.f, 0.f, 0.f, 0.f};
}
template <class E> struct NoDrain : E { static constexpr bool AFTER_DRAIN = false; };
template <class Epi> DI void gemm_stream(LAS unsigned char* lds, const pg8::Gemm& g, const pg8::StaticOrder& S, const Epi& E) {
    af4 acc[2][2][4][2]; zero_acc(acc); const NoDrain<Epi> E2{E};
    pg8::gemm_phase<NoDrain<Epi>, pg8::StaticOrder, GEMM_ALIGN, GEMM_SP2>(lds, g, S, E2, acc);
}
template <class Epi> DI void gemm_units(LAS unsigned char* lds, const pg8::Gemm& g, const pg8::StaticOrder& S, const Epi& E) {
    pg8::Unit u;
    for (int i = 0; S.next(i, u); ++i) { af4 acc[2][2][4][2]; zero_acc(acc); OneUnit O{S, i}; pg8::gemm_phase<Epi, OneUnit, false, GEMM_SP2>(lds, g, O, E, acc); }
}
DI int win_src_col(int n) { return n < 16384 ? n : (n < 30720 ? n + 16 : (n < 30736 ? n - 30720 + 16384 : -1)); }
template <bool WIN> DI void tr_item(LAS unsigned char* lds, const float* W, int ldsrc, bf16* WT, size_t ldd, int k0, int n0, int dcol0, int lane) {
    const int n = n0 + 2 * lane;
    const int sc = WIN ? win_src_col(n) : n;
    const unsigned so = (unsigned)(sc >= 0 ? sc : 0);
    f32x2_t v[64];
#pragma unroll
    for (int i = 0; i < 64; ++i) { const float* rowp = W + (size_t)(k0 + i) * ldsrc; v[i] = *(const f32x2_t*)(rowp + so); }
    if (sc < 0) {
#pragma unroll
        for (int i = 0; i < 64; ++i) v[i] = (f32x2_t){0.f, 0.f};
    }
    LAS unsigned char* slab = lds + __builtin_amdgcn_readfirstlane((int)(threadIdx.x >> 6)) * 16384;
    LAS u32x4* w0 = (LAS u32x4*)(slab + lane * 256);
#pragma unroll
    for (int j = 0; j < 8; ++j) { u32x4 o; o.x = pk2(v[8 * j].x, v[8 * j + 1].x); o.y = pk2(v[8 * j + 2].x, v[8 * j + 3].x); o.z = pk2(v[8 * j + 4].x, v[8 * j + 5].x); o.w = pk2(v[8 * j + 6].x, v[8 * j + 7].x); w0[j] = o; }
#pragma unroll
    for (int j = 0; j < 8; ++j) { u32x4 o; o.x = pk2(v[8 * j].y, v[8 * j + 1].y); o.y = pk2(v[8 * j + 2].y, v[8 * j + 3].y); o.z = pk2(v[8 * j + 4].y, v[8 * j + 5].y); o.w = pk2(v[8 * j + 6].y, v[8 * j + 7].y); w0[8 + j] = o; }
    bf16* dst = WT + (size_t)(n0 + (lane >> 3)) * ldd + dcol0 + k0 + (lane & 7) * 8;
#pragma unroll
    for (int s_ = 0; s_ < 16; ++s_) { const u32x4 o = *(const LAS u32x4*)(slab + s_ * 1024 + lane * 16); *(u32x4*)(dst + (size_t)(8 * s_) * ldd) = o; }
}
DI void tr_item8(LAS unsigned char* lds, const float* W, int ldsrc, unsigned char* W8, int k0, int nl0, int lane) {
    const unsigned so = (unsigned)(18448 + nl0 + lane);
    float v[128];
#pragma unroll
    for (int i = 0; i < 128; ++i) { const float* rowp = W + (size_t)(k0 + i) * ldsrc; v[i] = rowp[so]; }
    LAS unsigned char* slab = lds + __builtin_amdgcn_readfirstlane((int)(threadIdx.x >> 6)) * 16384;
    LAS u32x4* w0 = (LAS u32x4*)(slab + lane * 128);
#pragma unroll
    for (int j = 0; j < 8; ++j) { u32x4 o; o.x = pk4f8(v[16 * j] * 64.f, v[16 * j + 1] * 64.f, v[16 * j + 2] * 64.f, v[16 * j + 3] * 64.f); o.y = pk4f8(v[16 * j + 4] * 64.f, v[16 * j + 5] * 64.f, v[16 * j + 6] * 64.f, v[16 * j + 7] * 64.f);
        o.z = pk4f8(v[16 * j + 8] * 64.f, v[16 * j + 9] * 64.f, v[16 * j + 10] * 64.f, v[16 * j + 11] * 64.f); o.w = pk4f8(v[16 * j + 12] * 64.f, v[16 * j + 13] * 64.f, v[16 * j + 14] * 64.f, v[16 * j + 15] * 64.f); w0[j] = o; }
    unsigned char* dst = W8 + (size_t)(nl0 + (lane >> 3)) * DM + k0 + (lane & 7) * 16;
#pragma unroll
    for (int s_ = 0; s_ < 8; ++s_) { const u32x4 o = *(const LAS u32x4*)(slab + s_ * 1024 + lane * 16); *(u32x4*)(dst + (size_t)(8 * s_) * DM) = o; }
}
constexpr int CV_INB = 64 * 146, CV_IN8 = 32 * 192, CV_IN = CV_INB + CV_IN8, CV_BR = 3 * 32 * 32, CV_OU = 64 * 32, CV_L = CV_IN + CV_BR + CV_OU;
#ifndef CVX_ITEMS
#define CVX_ITEMS 5000
#endif
constexpr int CVX = CVX_ITEMS;
DI void convert_items(LAS unsigned char* lds, const float* w_in, const float* w_branch, const float* w_out, unsigned char* ws, int l, int it0, int it1, int gw, int NGW, int lane) {
    for (int it = it0 + gw; it < it1; it += NGW) {
        int r = it;
        if (r < CV_INB) { const int kb = r / 146, nb = r % 146; const int n0 = nb < 144 ? nb * 128 : 30720 + (nb - 144) * 128;
            tr_item<true>(lds, w_in + (size_t)l * DM * 30736, 30736, (bf16*)(ws + WS_WIN + l * SZ_WIN), DM, kb * 64, n0, 0, lane); continue; }
        r -= CV_INB;
        if (r < CV_IN8) { const int kb = r / 192, nb = r % 192;
            tr_item8(lds, w_in + (size_t)l * DM * 30736, 30736, ws + WS_W8 + l * SZ_W8, kb * 128, nb * 64, lane); continue; }
        r -= CV_IN8;
        if (r < CV_BR) { const int n = r / (32 * 32), rr = r % (32 * 32), kb = rr / 32, nb = rr % 32;
            tr_item<false>(lds, w_branch + ((size_t)l * 3 + n) * BW * DM, DM, (bf16*)(ws + WS_WBR + l * SZ_WBR), KBR, kb * 64, nb * 128, n * BW, lane); continue; }
        r -= CV_BR;
        { const int kb = r / 32, nb = r % 32;
            tr_item<false>(lds, w_out + (size_t)l * DM * DM, DM, (bf16*)(ws + WS_WOU + l * SZ_WOU), DM, kb * 64, nb * 128, 0, lane); }
    }
}
DI void tail_convert(LAS unsigned char* lds, const float* w_in, const float* w_branch, const float* w_out, unsigned char* ws, int l, int it0, int it1, int nunits, int G, int bx, int wave, int lane_in) {
    int lane = lane_in; asm volatile("" : "+v"(lane));
    const int rounds = (nunits + G - 1) / G, busy = nunits - (rounds - 1) * G, idle = G - busy;
    if (idle > 0) { if (bx >= busy) convert_items(lds, w_in, w_branch, w_out, ws, l, it0, it1, (bx - busy) * NWAVES + wave, idle * NWAVES, lane); }
    else convert_items(lds, w_in, w_branch, w_out, ws, l, it0, it1, bx * NWAVES + wave, G * NWAVES, lane);
}
DI void norm_rows(const float* xp, const float* xs, const float* nw, bf16* Z, unsigned char* Z8, int gw, int NGW, int lane) {
    asm volatile("" : "+v"(lane), "+s"(gw));
    for (int m = gw; m < MT; m += NGW) {
        const f32x4* xr = (const f32x4*)(m < MP ? xp + (size_t)m * DM : xs + (size_t)(m - MP) * DM) + lane;
        f32x4 v[16]; float s = 0.f;
#pragma unroll
        for (int j = 0; j < 16; ++j) { v[j] = xr[64 * j]; s += (v[j].x * v[j].x + v[j].y * v[j].y) + (v[j].z * v[j].z + v[j].w * v[j].w); }
        const float rstd = 1.0f / sqrtf(wave_sum(s) * (1.0f / DM) + EPS);
        u32x2* o8 = (u32x2*)(Z + (size_t)m * DM) + lane; unsigned* q8 = (unsigned*)(Z8 + (size_t)m * DM) + lane;
#pragma unroll
        for (int j = 0; j < 16; ++j) { const f32x4 w4 = ((const f32x4*)nw)[lane + 64 * j]; const float z0 = v[j].x * rstd * w4.x, z1 = v[j].y * rstd * w4.y, z2 = v[j].z * rstd * w4.z, z3 = v[j].w * rstd * w4.w;
            u32x2 o; o.x = pk2(z0, z1); o.y = pk2(z2, z3); o8[64 * j] = o; q8[64 * j] = pk4f8(z0, z1, z2, z3); }
    }
}
DI void sum_slabs_rows(const float* PB, bf16* MB, int gw, int NGW, int lane) {
    asm volatile("" : "+v"(lane), "+s"(gw));
    for (int h = gw; h < 512; h += NGW) {
        const int r = h >> 1, j0 = (h & 1) * 8;
        const f32x4* a = (const f32x4*)(PB + (size_t)r * DM) + lane + 64 * j0; const f32x4* b = a + (size_t)256 * DM / 4; const f32x4* c = b + (size_t)256 * DM / 4;
        u32x2* o8 = (u32x2*)(MB + (size_t)(MP + r) * DM) + lane + 64 * j0;
        f32x4 va[8], vb[8], vc[8];
#pragma unroll
        for (int j = 0; j < 8; ++j) { va[j] = a[64 * j]; vb[j] = b[64 * j]; vc[j] = c[64 * j]; }
#pragma unroll
        for (int j = 0; j < 8; ++j) { const f32x4 v = (va[j] + vb[j]) + vc[j]; u32x2 o; o.x = pk2(v.x, v.y); o.y = pk2(v.z, v.w); o8[64 * j] = o; }
    }
}
template <bool XB, bool YB> DI void final_rows(const void* xp_, const void* xs_, const bf16* OUT, const float* PO, const float* npost, void* ydst_, const float* npre_next, bf16* Z, unsigned char* Z8, int gw, int NGW, int lane) {
    asm volatile("" : "+v"(lane), "+s"(gw));
    for (int m = gw; m < MT; m += NGW) {
        const f32x4* xr = (const f32x4*)(m < MP ? (const float*)xp_ + (size_t)m * DM : (const float*)xs_ + (size_t)(m - MP) * DM) + lane;
        const u32x2* xrb = (const u32x2*)(m < MP ? (const bf16*)xp_ + (size_t)m * DM : (const bf16*)xs_ + (size_t)(m - MP) * DM) + lane;
        f32x4 v[16]; float s = 0.f;
        if (PO && m >= MP) { typedef const __attribute__((address_space(1))) f32x4* gp4;
            gp4 p0 = (gp4)(PO + (size_t)(m - MP) * DM) + lane; gp4 p1 = p0 + (size_t)256 * DM / 4; gp4 p2 = p1 + (size_t)256 * DM / 4; gp4 p3 = p2 + (size_t)256 * DM / 4;
#pragma unroll
            for (int jb = 0; jb < 16; jb += 4) { f32x4 t0[4], t1[4], t2[4], t3[4];
#pragma unroll
                for (int jj = 0; jj < 4; ++jj) { t0[jj] = p0[64 * (jb + jj)]; t1[jj] = p1[64 * (jb + jj)]; t2[jj] = p2[64 * (jb + jj)]; t3[jj] = p3[64 * (jb + jj)]; }
#pragma unroll
                for (int jj = 0; jj < 4; ++jj) v[jb + jj] = (t0[jj] + t1[jj]) + (t2[jj] + t3[jj]); } }
        else { const u32x2* orow = (const u32x2*)(OUT + (size_t)m * DM) + lane;
#pragma unroll
            for (int j = 0; j < 16; ++j) { const u32x2 ov = orow[64 * j]; v[j] = (f32x4){bflo(ov.x), bfhi(ov.x), bflo(ov.y), bfhi(ov.y)}; } }
#pragma unroll
        for (int j = 0; j < 16; ++j) s += (v[j].x * v[j].x + v[j].y * v[j].y) + (v[j].z * v[j].z + v[j].w * v[j].w);
        const float rstd = 1.0f / sqrtf(wave_sum(s) * (1.0f / DM) + EPS);
        f32x4* yo = (f32x4*)((float*)ydst_ + (size_t)m * DM) + lane; u32x2* yob = (u32x2*)((bf16*)ydst_ + (size_t)m * DM) + lane; float s2 = 0.f;
#pragma unroll
        for (int j = 0; j < 16; ++j) { const f32x4 w4 = ((const f32x4*)npost)[lane + 64 * j]; f32x4 x4;
            if constexpr (XB) { const u32x2 xb = xrb[64 * j]; x4 = (f32x4){bflo(xb.x), bfhi(xb.x), bflo(xb.y), bfhi(xb.y)}; } else x4 = xr[64 * j];
            v[j] = x4 + v[j] * rstd * w4;
            if constexpr (YB) { u32x2 yb; yb.x = pk2(v[j].x, v[j].y); yb.y = pk2(v[j].z, v[j].w); yob[64 * j] = yb; } else yo[64 * j] = v[j];
            s2 += (v[j].x * v[j].x + v[j].y * v[j].y) + (v[j].z * v[j].z + v[j].w * v[j].w); }
        if (Z) {
            const float r2 = 1.0f / sqrtf(wave_sum(s2) * (1.0f / DM) + EPS);
            u32x2* o8 = (u32x2*)(Z + (size_t)m * DM) + lane; unsigned* q8 = (unsigned*)(Z8 + (size_t)m * DM) + lane;
#pragma unroll
            for (int j = 0; j < 16; ++j) { const f32x4 w4 = ((const f32x4*)npre_next)[lane + 64 * j]; const float z0 = v[j].x * r2 * w4.x, z1 = v[j].y * r2 * w4.y, z2 = v[j].z * r2 * w4.z, z3 = v[j].w * r2 * w4.w;
                u32x2 o; o.x = pk2(z0, z1); o.y = pk2(z2, z3); o8[64 * j] = o; q8[64 * j] = pk4f8(z0, z1, z2, z3); }
        }
    }
}
DI void mix_fix_rows(const bf16* OA, const float* SSQ, const float* hnw, const bf16* HGATE, const float* gnw, const bf16* CGATE, bf16* Y, int m0, int m1, int gw, int NGW, int lane) {
    asm volatile("" : "+v"(lane), "+s"(gw));
    for (int m = m0 + gw; m < m1; m += NGW) {
        const f32x4* sq = (const f32x4*)(SSQ + (size_t)m * 32);
        float rs[4];
#pragma unroll
        for (int h = 0; h < 4; ++h) { const f32x4 s = sq[4 + h]; rs[h] = 1.0f / sqrtf(((s.x + s.y) + (s.z + s.w)) * (1.0f / 512.0f) + EPS); }
#pragma unroll
        for (int j = 0; j < 8; ++j) { const int col = 4 * (lane + 64 * j);
            const u32x2 ob = *(const u32x2*)(OA + (size_t)m * (2 * BW) + BW + col); const f32x4 o = (f32x4){bflo(ob.x), bfhi(ob.x), bflo(ob.y), bfhi(ob.y)}, w4 = *(const f32x4*)(gnw + col); const u32x2 g = *(const u32x2*)(CGATE + (size_t)m * BW + col);
            const float r = rs[j >> 1]; u32x2 y; y.x = pk2(o.x * r * w4.x * bflo(g.x), o.y * r * w4.y * bfhi(g.x)); y.y = pk2(o.z * r * w4.z * bflo(g.y), o.w * r * w4.w * bfhi(g.y));
            *(u32x2*)(Y + (size_t)m * KBR + 2 * BW + col) = y; }
    }
}
DI void gl_rows(const float* CLR, const float* w2, const float* b2, float* GL, int bx, int G, int tid_in) {
    int tid = tid_in; asm volatile("" : "+v"(tid));
    float wa[16], wb[16];
#pragma unroll
    for (int r = 0; r < 16; ++r) { wa[r] = w2[r * 1024 + tid]; wb[r] = w2[r * 1024 + 512 + tid]; }
    const float ba = b2[tid], bb = b2[512 + tid];
    for (int m = bx; m < MT; m += G) {
        const f32x4* cp = (const f32x4*)(CLR + (size_t)m * 16); float xa = ba, xb = bb;
#pragma unroll
        for (int q = 0; q < 4; ++q) { const f32x4 cv = cp[q];
            xa += cv.x * wa[4 * q] + cv.y * wa[4 * q + 1] + cv.z * wa[4 * q + 2] + cv.w * wa[4 * q + 3];
            xb += cv.x * wb[4 * q] + cv.y * wb[4 * q + 1] + cv.z * wb[4 * q + 2] + cv.w * wb[4 * q + 3]; }
        GL[(size_t)m * 1024 + tid] = -(fmaxf(-xa, 0.f) + __logf(1.0f + __expf(-fabsf(xa)))) * 0.0625f;
        GL[(size_t)m * 1024 + 512 + tid] = -(fmaxf(-xb, 0.f) + __logf(1.0f + __expf(-fabsf(xb)))) * 0.0625f;
    }
}

template <int DK> struct SL {
    static constexpr int QS = (DK + 8) * 2;
    static constexpr int KHS = 72 * 2;
    static constexpr int VS = 136 * 2;
    static constexpr int QT = 0, KT = QT + 64 * QS, KH = KT + 64 * QS, VT = KH + DK * KHS, PP = VT + 64 * VS;
    static constexpr int PTOT = PP + 64 * KHS, ER = PTOT + 2048, EBL = ER + DK * 4, SSQ = EBL + DK * 4, END = SSQ + 2048;
};
static_assert(SL<256>::END <= MISC_OFF, "scan LDS map");
struct LaArgs {
    const bf16* Q; int ldq;
    const float* G; int ldg;
    const bf16* K;
    const bf16* V;
    int row0, T;
    const float* S0; float* S1; int lds;
    const float* nw; const bf16* gate; bf16* Y;
};
template <int DK, bool GLA>
DI void la_job(LAS unsigned char* lds, const int tid_in, const LaArgs& A) {
    int tid = tid_in; asm volatile("" : "+v"(tid));
    typedef SL<DK> L;
    constexpr int NPART = 512 / DK, TPT = 64 / NPART, NDKT = DK / 16, NKS = DK / 32, NQ = DK / 64;
    const int lane = tid & 63, w = __builtin_amdgcn_readfirstlane(tid >> 6), fr = lane & 15, fq = lane >> 4;
    const int d = tid % DK, part = __builtin_amdgcn_readfirstlane(tid / DK);
    f32x4 S[NDKT];
#pragma unroll
    for (int k = 0; k < NDKT; ++k) {
        if (A.S0) {
#pragma unroll
            for (int j = 0; j < 4; ++j) S[k][j] = A.S0[(size_t)(16 * k + 4 * fq + j) * A.lds + 16 * w + fr];
        } else S[k] = (f32x4){0.f, 0.f, 0.f, 0.f};
    }
    const int nchunk = (A.T + 63) >> 6;
    const f32x4 nw4 = *(const f32x4*)(A.nw + 16 * w + 4 * fq);
    u32x4 pq[NQ], pk[NQ], pv[2]; float pg[TPT];
    constexpr int RPI = 512 / (DK / 8);
    const int tq = tid / (DK / 8), cq = tid % (DK / 8), tv = tid >> 4, cv = tid & 15;
    int b_q = L::QT + fr * L::QS + 16 * fq, b_q4 = L::QT + fr * L::QS + 8 * fq, b_k = L::KT + fr * L::QS + 16 * fq, b_kh = L::KH + fr * L::KHS + 16 * fq, b_p = L::PP + fr * L::KHS + 16 * fq, b_e = 16 * fq;
    asm volatile("" : "+v"(b_q), "+v"(b_q4), "+v"(b_k), "+v"(b_kh), "+v"(b_p), "+v"(b_e));
    const unsigned qoff = (unsigned)(tq * A.ldq + cq * 8), koff = (unsigned)(tq * 1024 + cq * 8), voff = (unsigned)(tv * BW + cv * 8);
#define LA_PREFETCH(cc) do { int t0_ = (cc) * 64; asm volatile("" : "+s"(t0_)); const size_t rowc_ = (size_t)A.row0 + t0_; const int nval_ = (A.T - t0_) < 64 ? (A.T - t0_) : 64; \
        _Pragma("unroll") for (int i_ = 0; i_ < NQ; ++i_) { const bf16* qb_ = A.Q + (rowc_ + RPI * i_) * A.ldq; \
            pq[i_] = (u32x4){0u, 0u, 0u, 0u}; if (tq + RPI * i_ < nval_) pq[i_] = *(const u32x4*)(qb_ + qoff); \
            } \
        _Pragma("unroll") for (int i_ = 0; i_ < 2; ++i_) { const bf16* vb_ = A.V + (rowc_ + 32 * i_) * BW; \
            pv[i_] = (u32x4){0u, 0u, 0u, 0u}; if (tv + 32 * i_ < nval_) pv[i_] = *(const u32x4*)(vb_ + voff); } \
        } while (0)
#define LA_LOAD_G(rowc_, nval_) do { _Pragma("unroll") for (int i_ = 0; i_ < TPT; ++i_) { const int t_ = part * TPT + i_; const float* gb_ = A.G + ((rowc_) + t_) * A.ldg; pg[i_] = (t_ < (nval_)) ? gb_[d] : 0.f; } } while (0)
#define LA_PREFETCH_G(cc) do { int t0_ = (cc) * 64; asm volatile("" : "+s"(t0_)); const size_t rowc_ = (size_t)A.row0 + t0_; const int nval_ = (A.T - t0_) < 64 ? (A.T - t0_) : 64; \
        if constexpr (GLA) { _Pragma("unroll") for (int i_ = 0; i_ < NQ; ++i_) { const bf16* kb_ = A.K + (rowc_ + RPI * i_) * 1024; pk[i_] = (u32x4){0u, 0u, 0u, 0u}; if (tq + RPI * i_ < nval_) pk[i_] = *(const u32x4*)(kb_ + koff); } } \
        if constexpr (!GLA) { LA_LOAD_G(rowc_, nval_); } } while (0)
    LA_PREFETCH(0); LA_PREFETCH_G(0);
    for (int c = 0; c < nchunk; ++c) {
        const int t0 = c * 64; const size_t rowc = (size_t)A.row0 + t0; const int nval = (A.T - t0) < 64 ? (A.T - t0) : 64;
        if constexpr (GLA) { LA_LOAD_G(rowc, nval); }
#pragma unroll
        for (int i = 0; i < NQ; ++i) { *(LAS u32x4*)(lds + L::QT + (tq + RPI * i) * L::QS + cq * 16) = pq[i];
            if constexpr (GLA) *(LAS u32x4*)(lds + L::KT + (tq + RPI * i) * L::QS + cq * 16) = pk[i]; }
#pragma unroll
        for (int i = 0; i < 2; ++i) *(LAS u32x4*)(lds + L::VT + (tv + 32 * i) * L::VS + cv * 16) = pv[i];
        float g[TPT];
        { float run = 0.f;
#pragma unroll
            for (int i = 0; i < TPT; ++i) { g[i] = pg[i]; run += g[i]; }
            *(LAS float*)(lds + L::PTOT + (part * DK + d) * 4) = run; }
        __syncthreads();
        float pre = 0.f, tot = 0.f, rr = 0.f;
#pragma unroll
        for (int p = 0; p < NPART; ++p) { const float v = *(const LAS float*)(lds + L::PTOT + (p * DK + d) * 4); pre += (p < part) ? v : 0.f; tot += v; rr += (p < NPART / 2) ? v : 0.f; }
        {
            float bb = pre; const float etr = __expf(tot - rr);
#pragma unroll
            for (int i8 = 0; i8 < TPT / 8; ++i8) { float kh[8];
#pragma unroll
                for (int ii = 0; ii < 8; ++ii) { const int i = 8 * i8 + ii; const int t = part * TPT + i; bb += g[i];
                    LAS bf16* qp = (LAS bf16*)(lds + L::QT + t * L::QS + d * 2); LAS bf16* kp = (LAS bf16*)(lds + L::KT + t * L::QS + d * 2);
                    const float qr = bf2f(*qp); float kr;
                    if constexpr (GLA) kr = bf2f(*kp); else kr = 1.0f - __expf(g[i]);
                    const float e1 = __expf(bb - rr), e2 = __expf(rr - bb);
                    *qp = f2bf(qr * e1); const float kt = kr * e2; *kp = f2bf(kt); kh[ii] = kt * etr; }
                u32x4 o; o.x = pk2(kh[0], kh[1]); o.y = pk2(kh[2], kh[3]); o.z = pk2(kh[4], kh[5]); o.w = pk2(kh[6], kh[7]);
                *(LAS u32x4*)(lds + L::KH + d * L::KHS + (part * TPT + 8 * i8) * 2) = o;
                asm volatile("" ::: "memory"); }
            if (part == 0) { *(LAS float*)(lds + L::ER + d * 4) = __expf(rr); *(LAS float*)(lds + L::EBL + d * 4) = __expf(tot); }
        }
        __syncthreads();
        if (c + 1 < nchunk) LA_PREFETCH(c + 1);
        bf16x8 Vf[2];
#pragma unroll
        for (int ks = 0; ks < 2; ++ks) {
            const bf16x4 lo = __builtin_amdgcn_ds_read_tr16_b64_v4i16((LAS bf16x4*)(lds + L::VT + (32 * ks + 8 * fq + (fr >> 2)) * L::VS + (16 * w + 4 * (fr & 3)) * 2));
            const bf16x4 hi = __builtin_amdgcn_ds_read_tr16_b64_v4i16((LAS bf16x4*)(lds + L::VT + (32 * ks + 8 * fq + 4 + (fr >> 2)) * L::VS + (16 * w + 4 * (fr & 3)) * 2));
            Vf[ks] = (bf16x8){lo[0], lo[1], lo[2], lo[3], hi[0], hi[1], hi[2], hi[3]}; }
        { const int ti = w >> 1; const int pk_base = b_k + ((w & 1) * 2) * 16 * L::QS, pq_base = b_q + ti * 16 * L::QS;
#pragma unroll
            for (int sj = 0; sj < 2; ++sj) { const int si = (w & 1) * 2 + sj; f32x4 acc = (f32x4){0.f, 0.f, 0.f, 0.f};
                if (si <= ti) {
#pragma unroll
                    for (int ks = 0; ks < NKS; ++ks) { const bf16x8 a = *(const LAS bf16x8*)(lds + pk_base + sj * 16 * L::QS + ks * 64);
                        const bf16x8 bq = *(const LAS bf16x8*)(lds + pq_base + ks * 64); acc = MFMA16(a, bq, acc); } }
                const int t = 16 * ti + fr, s0 = 16 * si + 4 * fq;
#pragma unroll
                for (int j = 0; j < 4; ++j) if (s0 + j > t) acc[j] = 0.f;
                u32x2 pw; pw.x = pk2(acc[0], acc[1]); pw.y = pk2(acc[2], acc[3]);
                *(LAS u32x2*)(lds + L::PP + t * L::KHS + s0 * 2) = pw; } }
        f32x4 O[4];
#pragma unroll
        for (int ti = 0; ti < 4; ++ti) O[ti] = (f32x4){0.f, 0.f, 0.f, 0.f};
#pragma unroll
        for (int p = 0; p < NKS; ++p) { const f32x4 ea = *(const LAS f32x4*)(lds + b_e + L::ER + 128 * p), eb = *(const LAS f32x4*)(lds + b_e + L::ER + 128 * p + 64);
            u32x4 o; o.x = pk2(S[2 * p][0] * ea[0], S[2 * p][1] * ea[1]); o.y = pk2(S[2 * p][2] * ea[2], S[2 * p][3] * ea[3]);
            o.z = pk2(S[2 * p + 1][0] * eb[0], S[2 * p + 1][1] * eb[1]); o.w = pk2(S[2 * p + 1][2] * eb[2], S[2 * p + 1][3] * eb[3]); const bf16x8 Sf = __builtin_bit_cast(bf16x8, o);
#pragma unroll
            for (int ti = 0; ti < 4; ++ti) { const u32x2 q0 = *(const LAS u32x2*)(lds + b_q4 + ti * 16 * L::QS + 64 * p), q1 = *(const LAS u32x2*)(lds + b_q4 + ti * 16 * L::QS + 64 * p + 32);
                u32x4 qq; qq.x = q0.x; qq.y = q0.y; qq.z = q1.x; qq.w = q1.y; O[ti] = MFMA16(Sf, __builtin_bit_cast(bf16x8, qq), O[ti]); }
            }
        __syncthreads();
        u32x2 gt[4];
#pragma unroll
        for (int ti = 0; ti < 4; ++ti) { f32x4 acc = O[ti];
#pragma unroll
            for (int ks = 0; ks < 2; ++ks) { const bf16x8 bp = *(const LAS bf16x8*)(lds + b_p + ti * 16 * L::KHS + ks * 64); acc = MFMA16(Vf[ks], bp, acc); }
            O[ti] = acc;
            const int t = 16 * ti + fr;
            gt[ti] = (u32x2){0u, 0u}; if (t < nval) gt[ti] = *(const u32x2*)(A.gate + (rowc + t) * BW + 16 * w + 4 * fq);
            float s = (acc[0] * acc[0] + acc[1] * acc[1]) + (acc[2] * acc[2] + acc[3] * acc[3]); s += __shfl_xor(s, 16); s += __shfl_xor(s, 32);
            if (fq == 0) *(LAS float*)(lds + L::SSQ + (t * 8 + w) * 4) = s; }
        if (c + 1 < nchunk) LA_PREFETCH_G(c + 1);
#pragma unroll
        for (int k = 0; k < NDKT; ++k) { const f32x4 e = *(const LAS f32x4*)(lds + b_e + L::EBL + 64 * k); f32x4 acc = S[k] * e;
#pragma unroll
            for (int ks = 0; ks < 2; ++ks) { const bf16x8 a = *(const LAS bf16x8*)(lds + b_kh + k * 16 * L::KHS + ks * 64); acc = MFMA16(a, Vf[ks], acc); }
            S[k] = acc; }
        __syncthreads();
#pragma unroll
        for (int ti = 0; ti < 4; ++ti) { const int t = 16 * ti + fr;
            const f32x4 sa = *(const LAS f32x4*)(lds + L::SSQ + t * 32), sb = *(const LAS f32x4*)(lds + L::SSQ + t * 32 + 16);
            const float r = 1.0f / sqrtf((((sa.x + sa.y) + (sa.z + sa.w)) + ((sb.x + sb.y) + (sb.z + sb.w))) * (1.0f / 128.0f) + EPS);
            const f32x4 o = O[ti]; u32x2 y; y.x = pk2(o[0] * r * nw4[0] * bflo(gt[ti].x), o[1] * r * nw4[1] * bfhi(gt[ti].x)); y.y = pk2(o[2] * r * nw4[2] * bflo(gt[ti].y), o[3] * r * nw4[3] * bfhi(gt[ti].y));
            if (t < nval) *(u32x2*)(A.Y + (rowc + t) * KBR + 16 * w + 4 * fq) = y; }
    }
#undef LA_PREFETCH
#undef LA_PREFETCH_G
#undef LA_LOAD_G
#pragma unroll
    for (int k = 0; k < NDKT; ++k)
#pragma unroll
        for (int j = 0; j < 4; ++j) A.S1[(size_t)(16 * k + 4 * fq + j) * A.lds + 16 * w + fr] = S[k][j];
}

struct GPrep { const bf16* CQ; const bf16* CK; const float* CLR; const float* w2; const float* b2; bf16* QT; bf16* KT; bf16* KH; float* ER; float* EB; };
DI void gla_prep(LAS unsigned char* lds, const int tid_in, const GPrep& P, const int ci, const int hh) {
    int tid = tid_in; asm volatile("" : "+v"(tid));
    const int d = tid & 255, part = __builtin_amdgcn_readfirstlane(tid >> 8);
    const int row0 = ci < 128 ? ci * 64 : MP + (ci - 128) * 32, nval = ci < 128 ? 64 : 32;
    const int ch = hh * 256 + d;
    LAS float* ptot = (LAS float*)lds; LAS float* clrs = (LAS float*)(lds + 4096);
    if (tid < 256) { const int t = tid >> 2, q4 = tid & 3; f32x4 v = (f32x4){0.f, 0.f, 0.f, 0.f}; if (t < nval) v = *(const f32x4*)(P.CLR + ((size_t)row0 + t) * 16 + q4 * 4);
        *(LAS f32x4*)(clrs + t * 16 + q4 * 4) = v; }
    float w2r[16];
#pragma unroll
    for (int r = 0; r < 16; ++r) w2r[r] = P.w2[r * 1024 + ch];
    const float b2v = P.b2[ch];
    unsigned qk[32];
    { const bf16* qi = P.CQ + (size_t)row0 * 1024 + ch; const bf16* ki = P.CK + (size_t)row0 * 1024 + ch;
#pragma unroll
      for (int i = 0; i < 32; ++i) { const int t = part * 32 + i; const int tc = t < nval ? t : 0; const unsigned qv = qi[(size_t)tc * 1024], kv = ki[(size_t)tc * 1024]; qk[i] = (t < nval) ? (qv | (kv << 16)) : 0u; } }
    __syncthreads();
    float g[32]; float run = 0.f;
#pragma unroll
    for (int i = 0; i < 32; ++i) { const int t = part * 32 + i; const LAS f32x4* cp = (const LAS f32x4*)(clrs + t * 16);
        float x = b2v;
#pragma unroll
        for (int q = 0; q < 4; ++q) { const f32x4 cv = cp[q]; x += cv.x * w2r[4 * q] + cv.y * w2r[4 * q + 1] + cv.z * w2r[4 * q + 2] + cv.w * w2r[4 * q + 3]; }
        const float ls = -(fmaxf(-x, 0.f) + __logf(1.0f + __expf(-fabsf(x))));
        g[i] = (t < nval) ? ls * 0.0625f : 0.f; run += g[i]; }
    ptot[part * 256 + d] = run;
    __syncthreads();
    const float p0 = ptot[d], p1 = ptot[256 + d];
    const float rr = p0, tot = p0 + p1, etr = __expf(tot - rr);
    float bb = part ? p0 : 0.f;
    bf16* qo = P.QT + (size_t)row0 * 1024 + ch; bf16* ko = P.KT + (size_t)row0 * 1024 + ch;
    u32x4* kho = (u32x4*)(P.KH + ((size_t)ci * 1024 + ch) * 64 + part * 32);
#pragma unroll
    for (int i8 = 0; i8 < 4; ++i8) { float kh[8];
#pragma unroll
        for (int ii = 0; ii < 8; ++ii) { const int i = 8 * i8 + ii; const int t = part * 32 + i; bb += g[i];
            const float qr = bflo(qk[i]), kr = bfhi(qk[i]);
            const float e1 = __expf(bb - rr), e2 = __expf(rr - bb); const float kt = kr * e2;
            if (t < nval) { qo[(size_t)t * 1024] = f2bf(qr * e1); ko[(size_t)t * 1024] = f2bf(kt); }
            kh[ii] = kt * etr; }
        u32x4 o; o.x = pk2(kh[0], kh[1]); o.y = pk2(kh[2], kh[3]); o.z = pk2(kh[4], kh[5]); o.w = pk2(kh[6], kh[7]); kho[i8] = o; }
    if (part == 0) { P.ER[(size_t)ci * 1024 + ch] = __expf(rr); P.EB[(size_t)ci * 1024 + ch] = __expf(tot); }
    __syncthreads();
}
struct GArgs { const bf16* QT; const bf16* KT; const bf16* KH; const float* ER; const float* EB; const bf16* V; int ci0, row0, T; const float* S0; float* S1; int lds; bf16* OA; float* SSQ; };
DI void gla_job(LAS unsigned char* lds, const int tid_in, const GArgs& A) {
    int tid = tid_in; asm volatile("" : "+v"(tid));
    typedef SL<256> L;
    constexpr int NDKT = 16, NKS = 8;
    const int lane = tid & 63, w = __builtin_amdgcn_readfirstlane(tid >> 6), fr = lane & 15, fq = lane >> 4;
    f32x4 S[NDKT];
#pragma unroll
    for (int k = 0; k < NDKT; ++k) {
        if (A.S0) {
#pragma unroll
            for (int j = 0; j < 4; ++j) S[k][j] = A.S0[(size_t)(16 * k + 4 * fq + j) * A.lds + 16 * w + fr];
        } else S[k] = (f32x4){0.f, 0.f, 0.f, 0.f};
    }
    const int nchunk = (A.T + 63) >> 6;
    u32x4 pq[4], pk[4], ph[4], pv[2]; f32x4 pe = (f32x4){0.f, 0.f, 0.f, 0.f};
    int b_q = L::QT + fr * L::QS + 16 * fq, b_q4 = L::QT + fr * L::QS + 8 * fq, b_k = L::KT + fr * L::QS + 16 * fq, b_kh = L::KH + fr * L::KHS + 16 * fq, b_p = L::PP + fr * L::KHS + 16 * fq, b_e = 16 * fq;
    asm volatile("" : "+v"(b_q), "+v"(b_q4), "+v"(b_k), "+v"(b_kh), "+v"(b_p), "+v"(b_e));
#define G_IDX() int t_ = tid; asm volatile("" : "+v"(t_)); const int tq = t_ >> 5, cq = t_ & 31, tv = t_ >> 4, cv = t_ & 15, th = t_ >> 3, chh = t_ & 7; \
        const unsigned qoff = (unsigned)(tq * 1024 + cq * 8), voff = (unsigned)(tv * BW + cv * 8), hoff = (unsigned)(th * 64 + chh * 8); (void)tq; (void)cq; (void)tv; (void)cv; (void)th; (void)chh; (void)qoff; (void)voff; (void)hoff
#define G_LOAD_QK(cc) do { G_IDX(); int c_ = (cc); asm volatile("" : "+s"(c_)); const size_t rowc_ = (size_t)A.row0 + c_ * 64; const int nval_ = (A.T - c_ * 64) < 64 ? (A.T - c_ * 64) : 64; \
        _Pragma("unroll") for (int i_ = 0; i_ < 4; ++i_) { const bf16* qb_ = A.QT + (rowc_ + 16 * i_) * 1024; const bf16* kb_ = A.KT + (rowc_ + 16 * i_) * 1024; \
            pq[i_] = (u32x4){0u, 0u, 0u, 0u}; pk[i_] = (u32x4){0u, 0u, 0u, 0u}; if (tq + 16 * i_ < nval_) { pq[i_] = *(const u32x4*)(qb_ + qoff); pk[i_] = *(const u32x4*)(kb_ + qoff); } } } while (0)
#define G_LOAD_HV(cc) do { G_IDX(); int c_ = (cc); asm volatile("" : "+s"(c_)); const size_t rowc_ = (size_t)A.row0 + c_ * 64; const int nval_ = (A.T - c_ * 64) < 64 ? (A.T - c_ * 64) : 64; \
        _Pragma("unroll") for (int i_ = 0; i_ < 4; ++i_) { const bf16* hb_ = A.KH + ((size_t)(A.ci0 + c_) * 1024 + 64 * i_) * 64; ph[i_] = *(const u32x4*)(hb_ + hoff); } \
        _Pragma("unroll") for (int i_ = 0; i_ < 2; ++i_) { const bf16* vb_ = A.V + (rowc_ + 32 * i_) * BW; pv[i_] = (u32x4){0u, 0u, 0u, 0u}; if (tv + 32 * i_ < nval_) pv[i_] = *(const u32x4*)(vb_ + voff); } \
        if (tid < 128) { const float* eb_ = (tid < 64 ? A.ER : A.EB) + (size_t)(A.ci0 + c_) * 1024; pe = *(const f32x4*)(eb_ + 4 * (tid & 63)); } } while (0)
#define G_LAND_QK() do { G_IDX(); _Pragma("unroll") for (int i_ = 0; i_ < 4; ++i_) { *(LAS u32x4*)(lds + L::QT + (tq + 16 * i_) * L::QS + cq * 16) = pq[i_]; *(LAS u32x4*)(lds + L::KT + (tq + 16 * i_) * L::QS + cq * 16) = pk[i_]; } } while (0)
#define G_LAND_HV() do { G_IDX(); _Pragma("unroll") for (int i_ = 0; i_ < 4; ++i_) *(LAS u32x4*)(lds + L::KH + (th + 64 * i_) * L::KHS + chh * 16) = ph[i_]; \
        _Pragma("unroll") for (int i_ = 0; i_ < 2; ++i_) *(LAS u32x4*)(lds + L::VT + (tv + 32 * i_) * L::VS + cv * 16) = pv[i_]; \
        if (tid < 128) *(LAS f32x4*)(lds + L::ER + 16 * tid) = pe; } while (0)
    G_LOAD_QK(0); G_LOAD_HV(0); G_LAND_QK();
    for (int c = 0; c < nchunk; ++c) {
        const int t0 = c * 64; const size_t rowc = (size_t)A.row0 + t0; const int nval = (A.T - t0) < 64 ? (A.T - t0) : 64;
        G_LAND_HV();
        __syncthreads();
        if (c + 1 < nchunk) G_LOAD_QK(c + 1);
        bf16x8 Vf[2];
#pragma unroll
        for (int ks = 0; ks < 2; ++ks) {
            const bf16x4 lo = __builtin_amdgcn_ds_read_tr16_b64_v4i16((LAS bf16x4*)(lds + L::VT + (32 * ks + 8 * fq + (fr >> 2)) * L::VS + (16 * w + 4 * (fr & 3)) * 2));
            const bf16x4 hi = __builtin_amdgcn_ds_read_tr16_b64_v4i16((LAS bf16x4*)(lds + L::VT + (32 * ks + 8 * fq + 4 + (fr >> 2)) * L::VS + (16 * w + 4 * (fr & 3)) * 2));
            Vf[ks] = (bf16x8){lo[0], lo[1], lo[2], lo[3], hi[0], hi[1], hi[2], hi[3]}; }
        { const int ti = w >> 1; const int pk_base = b_k + ((w & 1) * 2) * 16 * L::QS, pq_base = b_q + ti * 16 * L::QS;
#pragma unroll
            for (int sj = 0; sj < 2; ++sj) { const int si = (w & 1) * 2 + sj; f32x4 acc = (f32x4){0.f, 0.f, 0.f, 0.f};
                if (si <= ti) {
#pragma unroll
                    for (int ks = 0; ks < NKS; ++ks) { const bf16x8 a = *(const LAS bf16x8*)(lds + pk_base + sj * 16 * L::QS + ks * 64);
                        const bf16x8 bq = *(const LAS bf16x8*)(lds + pq_base + ks * 64); acc = MFMA16(a, bq, acc); } }
                const int t = 16 * ti + fr, s0 = 16 * si + 4 * fq;
#pragma unroll
                for (int j = 0; j < 4; ++j) if (s0 + j > t) acc[j] = 0.f;
                u32x2 pw; pw.x = pk2(acc[0], acc[1]); pw.y = pk2(acc[2], acc[3]);
                *(LAS u32x2*)(lds + L::PP + t * L::KHS + s0 * 2) = pw; } }
        f32x4 O[4];
#pragma unroll
        for (int ti = 0; ti < 4; ++ti) O[ti] = (f32x4){0.f, 0.f, 0.f, 0.f};
#pragma unroll
        for (int p = 0; p < NKS; ++p) { const f32x4 ea = *(const LAS f32x4*)(lds + b_e + L::ER + 128 * p), eb = *(const LAS f32x4*)(lds + b_e + L::ER + 128 * p + 64);
            u32x4 o; o.x = pk2(S[2 * p][0] * ea[0], S[2 * p][1] * ea[1]); o.y = pk2(S[2 * p][2] * ea[2], S[2 * p][3] * ea[3]);
            o.z = pk2(S[2 * p + 1][0] * eb[0], S[2 * p + 1][1] * eb[1]); o.w = pk2(S[2 * p + 1][2] * eb[2], S[2 * p + 1][3] * eb[3]); const bf16x8 Sf = __builtin_bit_cast(bf16x8, o);
#pragma unroll
            for (int ti = 0; ti < 4; ++ti) { const u32x2 q0 = *(const LAS u32x2*)(lds + b_q4 + ti * 16 * L::QS + 64 * p), q1 = *(const LAS u32x2*)(lds + b_q4 + ti * 16 * L::QS + 64 * p + 32);
                u32x4 qq; qq.x = q0.x; qq.y = q0.y; qq.z = q1.x; qq.w = q1.y; O[ti] = MFMA16(Sf, __builtin_bit_cast(bf16x8, qq), O[ti]); }
            }
        __syncthreads();
        if (c + 1 < nchunk) { G_LAND_QK(); G_LOAD_HV(c + 1); }
#pragma unroll
        for (int ti = 0; ti < 4; ++ti) { f32x4 acc = O[ti];
#pragma unroll
            for (int ks = 0; ks < 2; ++ks) { const bf16x8 bp = *(const LAS bf16x8*)(lds + b_p + ti * 16 * L::KHS + ks * 64); acc = MFMA16(Vf[ks], bp, acc); }
            const int t = 16 * ti + fr;
            if (t < nval) { u32x2 ob; ob.x = pk2(acc[0], acc[1]); ob.y = pk2(acc[2], acc[3]); *(u32x2*)(A.OA + (rowc + t) * (2 * BW) + 16 * w + 4 * fq) = ob; }
            float s = (acc[0] * acc[0] + acc[1] * acc[1]) + (acc[2] * acc[2] + acc[3] * acc[3]); s += __shfl_xor(s, 16); s += __shfl_xor(s, 32);
            if (fq == 0) *(LAS float*)(lds + L::SSQ + (t * 8 + w) * 4) = s; }
#pragma unroll
        for (int k = 0; k < NDKT; ++k) { const f32x4 e = *(const LAS f32x4*)(lds + b_e + L::EBL + 64 * k); f32x4 acc = S[k] * e;
#pragma unroll
            for (int ks = 0; ks < 2; ++ks) { const bf16x8 a = *(const LAS bf16x8*)(lds + b_kh + k * 16 * L::KHS + ks * 64); acc = MFMA16(a, Vf[ks], acc); }
            S[k] = acc; }
        __syncthreads();
        if (tid < 64 && tid < nval) { const f32x4 sa = *(const LAS f32x4*)(lds + L::SSQ + tid * 32), sb = *(const LAS f32x4*)(lds + L::SSQ + tid * 32 + 16);
            A.SSQ[(rowc + tid) * 32] = ((sa.x + sa.y) + (sa.z + sa.w)) + ((sb.x + sb.y) + (sb.z + sb.w)); }
    }
#undef G_IDX
#undef G_LOAD_QK
#undef G_LOAD_HV
#undef G_LAND_QK
#undef G_LAND_HV
#pragma unroll
    for (int k = 0; k < NDKT; ++k)
#pragma unroll
        for (int j = 0; j < 4; ++j) A.S1[(size_t)(16 * k + 4 * fq + j) * A.lds + 16 * w + fr] = S[k][j];
}

struct LruArgs { const float* LX; int row0, T; const float* cst; const float* h0; const float* cw; const float* cb; const float* wa; const float* ba;
                 const float* wx; const float* bx; const float* lam; const bf16* lgate; bf16* Y; float* newh; float* newconv; };
constexpr int LR_XB = 0, LR_XF = 17408, LR_AA = LR_XF + 32768, LR_UU = LR_AA + 32768, LR_END = LR_UU + 32768;
static_assert(LR_END <= MISC_OFF, "lru LDS map");
DI void lru_job(LAS unsigned char* lds, const int tid_in, const LruArgs& A) {
    int tid = tid_in; asm volatile("" : "+v"(tid));
    const int lane = tid & 63, w = __builtin_amdgcn_readfirstlane(tid >> 6), fr = lane & 15, fq = lane >> 4;
    const int c = tid & 127, part = __builtin_amdgcn_readfirstlane(tid >> 7), cc = 16 * w + fr;
    bf16x8 Wf[2][4];
#pragma unroll
    for (int ks = 0; ks < 4; ++ks) { float a[8], x[8];
#pragma unroll
        for (int j = 0; j < 8; ++j) { const int i = 32 * ks + 8 * fq + j; a[j] = A.wa[i * 128 + cc]; x[j] = A.wx[i * 128 + cc]; }
        u32x4 oa, ox; oa.x = pk2(a[0], a[1]); oa.y = pk2(a[2], a[3]); oa.z = pk2(a[4], a[5]); oa.w = pk2(a[6], a[7]);
        ox.x = pk2(x[0], x[1]); ox.y = pk2(x[2], x[3]); ox.z = pk2(x[4], x[5]); ox.w = pk2(x[6], x[7]);
        Wf[0][ks] = __builtin_bit_cast(bf16x8, oa); Wf[1][ks] = __builtin_bit_cast(bf16x8, ox); }
    const float bav = A.ba[cc], bxv = A.bx[cc]; const float lamv = A.lam[cc];
    const float sp8 = -8.0f * (fmaxf(-lamv, 0.f) + log1pf(expf(-fabsf(lamv))));
    const float cw0 = A.cw[c], cw1 = A.cw[BW + c], cw2 = A.cw[2 * BW + c], cw3 = A.cw[3 * BW + c], cbv = A.cb[c];
    float hc = (tid < 128 && A.h0) ? A.h0[c] : 0.f;
    const int nchunk = (A.T + 63) >> 6;
    float xv[19]; unsigned lgn[16];
#define LRU_PREFETCH(chn) do { int t0_ = (chn) * 64; asm volatile("" : "+s"(t0_)); const int nval_ = (A.T - t0_) < 64 ? (A.T - t0_) : 64; \
        _Pragma("unroll") for (int i_ = 0; i_ < 19; ++i_) { const int ta_ = t0_ + 16 * part - 3 + i_; float v_ = 0.f; \
            if (ta_ < 0) { if (A.cst) v_ = A.cst[(3 + ta_) * BW + c]; } else if (ta_ < A.T) { const float* xb_ = A.LX + (size_t)(A.row0 + ta_) * BW; v_ = xb_[c]; } \
            xv[i_] = v_; } \
        _Pragma("unroll") for (int i_ = 0; i_ < 16; ++i_) { const int t_ = 16 * part + i_; const bf16* gb_ = A.lgate + ((size_t)A.row0 + t0_ + t_) * BW; lgn[i_] = (t_ < nval_) ? (unsigned)gb_[c] : 0u; } } while (0)
    LRU_PREFETCH(0);
    for (int ch = 0; ch < nchunk; ++ch) {
        const int t0 = ch * 64; const size_t rowc = (size_t)A.row0 + t0; const int nval = (A.T - t0) < 64 ? (A.T - t0) : 64;
        unsigned lg[16];
#pragma unroll
        for (int i = 0; i < 16; ++i) lg[i] = lgn[i];
#pragma unroll
        for (int i = 0; i < 16; ++i) { const int t = 16 * part + i; const float xc = cbv + xv[i] * cw0 + xv[i + 1] * cw1 + xv[i + 2] * cw2 + xv[i + 3] * cw3;
            *(LAS float*)(lds + LR_XF + (t * 128 + c) * 4) = xc; *(LAS bf16*)(lds + LR_XB + t * 272 + c * 2) = f2bf(xc); }
        __syncthreads();
        if (ch + 1 < nchunk) LRU_PREFETCH(ch + 1);
#pragma unroll
        for (int ti = 0; ti < 4; ++ti) { f32x4 ar = (f32x4){0.f, 0.f, 0.f, 0.f}, ai = (f32x4){0.f, 0.f, 0.f, 0.f};
#pragma unroll
            for (int ks = 0; ks < 4; ++ks) { const bf16x8 a = *(const LAS bf16x8*)(lds + LR_XB + (16 * ti + fr) * 272 + (32 * ks + 8 * fq) * 2); ar = MFMA16(a, Wf[0][ks], ar); ai = MFMA16(a, Wf[1][ks], ai); }
#pragma unroll
            for (int j = 0; j < 4; ++j) { const int t = 16 * ti + 4 * fq + j;
                const float r = sigmoidf_(ar[j] + bav), ig = sigmoidf_(ai[j] + bxv); const float la = r * sp8;
                float a_ = __expf(la); const float t2 = 2.0f * la;
                const float om = (t2 > -0.03f) ? -t2 * (1.0f + t2 * (0.5f + t2 * (0.16666667f + t2 * 0.041666668f))) : 1.0f - a_ * a_;
                float u = __builtin_amdgcn_sqrtf(fmaxf(om, 0.f)) * ig * *(const LAS float*)(lds + LR_XF + (t * 128 + cc) * 4);
                if (t >= nval) { a_ = 1.0f; u = 0.f; }
                *(LAS float*)(lds + LR_AA + (t * 128 + cc) * 4) = a_; *(LAS float*)(lds + LR_UU + (t * 128 + cc) * 4) = u; } }
        __syncthreads();
        if (tid < 128) {
#pragma unroll 16
            for (int t = 0; t < 64; ++t) { const float a_ = *(const LAS float*)(lds + LR_AA + (t * 128 + c) * 4); LAS float* up = (LAS float*)(lds + LR_UU + (t * 128 + c) * 4);
                hc = a_ * hc + *up; *up = hc; }
        }
        __syncthreads();
#pragma unroll
        for (int i = 0; i < 16; ++i) { const int t = 16 * part + i; const float ht = *(const LAS float*)(lds + LR_UU + (t * 128 + c) * 4);
            if (t < nval) { bf16* yb = A.Y + (rowc + t) * KBR; yb[c] = f2bf(ht * bf2f(lg[i])); } }
    }
#undef LRU_PREFETCH
    if (tid < 128) { A.newh[c] = hc;
#pragma unroll
        for (int j = 0; j < 3; ++j) A.newconv[j * BW + c] = A.LX[(size_t)(A.row0 + A.T - 3 + j) * BW + c]; }
    __syncthreads();
}

struct Args { const float* in[23]; float* out; unsigned char* ws; int ph_lo, ph_hi, use_bar, pad; };
enum { I_XP = 0, I_XS, I_SHG, I_SLH, I_SLC, I_SGL, I_NPRE, I_NPOST, I_WIN, I_LBL, I_HGN, I_CW, I_CB, I_WA, I_BA, I_WX, I_BX, I_LAM, I_W2, I_B2, I_GLN, I_WBR, I_WOU };
constexpr int NPHASE = 15;


#define WSZ() unsigned char* wsz = ws; asm volatile("" : "+s"(wsz))
#define wHQ ((bf16*)(wsz + WS_HQ))
#define wHG ((float*)(wsz + WS_HG))
#define wHV ((bf16*)(wsz + WS_HV))
#define wHGATE ((bf16*)(wsz + WS_HGATE))
#define wLX ((float*)(wsz + WS_LX))
#define wLGATE ((bf16*)(wsz + WS_LGATE))
#define wCQ ((bf16*)(wsz + WS_CQ))
#define wCK ((bf16*)(wsz + WS_CK))
#define wCV ((bf16*)(wsz + WS_CV))
#define wCGATE ((bf16*)(wsz + WS_CGATE))
#define wMG ((unsigned char*)(wsz + WS_MG))
#define wCLR ((float*)(wsz + WS_CLR))
#define wY ((bf16*)(wsz + WS_Y))
#define wOC ((bf16*)(wsz + WS_OC))
#define wSSQ ((float*)(wsz + WS_SSQ))
#define wGL ((float*)(wsz + WS_MERGED))
#define wMB ((bf16*)(wsz + WS_MB))
#define wOUT ((bf16*)(wsz + WS_OUT))
__global__ void __launch_bounds__(NTHR, 2) mega(Args args) {
    extern __shared__ __attribute__((aligned(16))) unsigned char lds_raw[];
    LAS unsigned char* lds = (LAS unsigned char*)lds_raw;
    const int wave = __builtin_amdgcn_readfirstlane((int)threadIdx.x >> 6);
#define tid ((int)threadIdx.x)
#define lane ((int)(threadIdx.x & 63u))
    const int G = gridDim.x, bx = blockIdx.x;
    const int gw = bx * NWAVES + wave, NGW = G * NWAVES;
#define chain (gridDim.x == 256u)
#define MM (chain ? MP : MT)
    unsigned char* ws = args.ws;
    volatile LAS unsigned* MISC = (volatile LAS unsigned*)(lds + MISC_OFF);
    if (tid < 64) MISC[tid] = 0u;
    __syncthreads();
    XcdBarrier bar; bar.bar = (unsigned*)(ws + WS_CTL) + CW_BAR; bar.x = 0; bar.st = nullptr;
    if (args.use_bar) bar = xcd_barrier_post((unsigned*)(ws + WS_CTL) + CW_BAR, MISC);
    const int lo = args.ph_lo, hi = args.ph_hi;
#define IN(k) (lo <= (k) && (k) < hi)
#define SEAM(k) do { if (IN(k) && IN((k) + 1)) xcd_barrier(bar); } while (0)
    const float* xp = args.in[I_XP]; const float* xs = args.in[I_XS];
    bf16* Z = (bf16*)(ws + WS_Z);
    bf16* X1 = (bf16*)(ws + WS_X1);

    for (int rep_ = 0; rep_ < REP_P0; ++rep_) if (IN(0) && (PHM & 64)) {
        { int lz = lane, gz = gw; asm volatile("" : "+v"(lz), "+s"(gz));
          convert_items(lds, args.in[I_WIN], args.in[I_WBR], args.in[I_WOU], ws, 0, 0, CV_IN, gz, NGW, lz); }
        norm_rows(xp, xs, args.in[I_NPRE], Z, ws + WS_Z8, gw, NGW, lane);
        __syncthreads();
    }
    SEAM(0);
    for (int l = 0; l < 2; ++l) {
        const int pb = 1 + 7 * l;
        for (int rp_ = 0; rp_ < REP_IN; ++rp_) if (IN(pb) && (PHM & 1)) { WSZ();
            const NoDrain<EpiInProj> E{{wHQ, wHV, wHGATE, wLGATE, wCQ, wCK, wCV, wCGATE, wMG, wHG, wLX, wCLR, args.in[I_LBL], l, 0.015625f}};
            { pg8::Gemm g{Z, (const bf16*)(ws + WS_WIN + l * SZ_WIN), MT, NIN, DM, DM, DM}; int bz = bx; asm volatile("" : "+s"(bz)); InOrderA SA; SA.S.init(MT, 73 * 256, G, bz);
              af4 acc[2][2][4][2]; zero_acc(acc); pg8::gemm_phase<NoDrain<EpiInProj>, InOrderA, GEMM_ALIGN, GEMM_SP2, false>(lds, g, SA, E, acc); }
            { pg8::Gemm g{(const bf16*)(ws + WS_Z8), (const bf16*)(ws + WS_W8 + l * SZ_W8) - (size_t)72 * 256 * 2048, MT, 12288, 2048, 2048, 2048}; InOrder8 S8; int bz = bx; asm volatile("" : "+s"(bz)); S8.S.init(MT, 48 * 256, G, G == 256 ? ((bz + 48) & 255) : bz);
              af4 acc[2][2][4][2]; zero_acc(acc); pg8::gemm_phase<NoDrain<EpiInProj>, InOrder8, GEMM_ALIGN, GEMM_SP2, true>(lds, g, S8, E, acc); }
            if (G == 256) { if (bx >= 105 && bx < 208) { int lz = lane; asm volatile("" : "+v"(lz)); convert_items(lds, args.in[I_WIN], args.in[I_WBR], args.in[I_WOU], ws, l, CV_IN, CV_L, (bx - 105) * NWAVES + wave, 103 * NWAVES, lz); } }
            else { int lz = lane; asm volatile("" : "+v"(lz)); convert_items(lds, args.in[I_WIN], args.in[I_WBR], args.in[I_WOU], ws, l, CV_IN, CV_L, bx * NWAVES + wave, G * NWAVES, lz); }
        }
        SEAM(pb);
        if (!chain) {
            if (IN(pb + 1)) { WSZ();
                const GPrep P{wCQ, wCK, wCLR, args.in[I_W2] + (size_t)l * 16 * 1024, args.in[I_B2] + l * 1024, (bf16*)(wsz + WS_GQT), (bf16*)(wsz + WS_GKT), (bf16*)(wsz + WS_GKH), (float*)(wsz + WS_GER), (float*)(wsz + WS_GEB)};
                for (int it = bx; it < NCHK * 4; it += G) gla_prep(lds, tid, P, it >> 2, it & 3);
            }
            SEAM(pb + 1);
        }
        for (int rep_ = 0; rep_ < REP_SCAN; ++rep_) if (IN(pb + 2) && (PHM & 2)) { WSZ();
            constexpr int NLONG = 192;
            const bool split = G > NLONG;
            const int mytype = split ? (bx < NLONG ? bx / 64 : -1) : -2;
            const int sw = bx - NLONG, nsw = G - NLONG;
            if (chain && mytype != 2) {
                const GPrep P{wCQ, wCK, wCLR, args.in[I_W2] + (size_t)l * 16 * 1024, args.in[I_B2] + l * 1024, (bf16*)(wsz + WS_GQT), (bf16*)(wsz + WS_GKT), (bf16*)(wsz + WS_GKH), (float*)(wsz + WS_GER), (float*)(wsz + WS_GEB)};
                for (int it = (bx < 128 ? bx : bx - 64); it < NCHK * 4; it += 192) gla_prep(lds, tid, P, it >> 2, it & 3);
                if (mytype == 1) team_arrive((unsigned*)(ws + WS_CTL) + CW_TEAM + 2048 + l * 64 + rep_ * 16);
                else team_barrier((unsigned*)(ws + WS_CTL) + CW_TEAM + 2048 + l * 64 + rep_ * 16, 192u);
            }
#define JOB_RANGE(TYPE, j0, j1, js) int j0, j1, js; \
            if (mytype == -2) { j0 = bx; j1 = 192; js = G; } else if (mytype == (TYPE)) { j0 = bx - 64 * (TYPE); j1 = j0 + 1; js = 1; } else if (mytype == -1) { j0 = 64 + sw; j1 = 192; js = nsw; } else { j0 = 0; j1 = 0; js = 1; }
#define JOB_DECODE(idx) const int seq = (idx) < 64 ? (idx) / 16 : 4 + ((idx) - 64) / 16; const int sub = (idx) % 16; const bool smp = seq >= 4; const int sb = smp ? seq - 4 : seq; \
            const int row0 = smp ? MP + sb * 32 : sb * 2048, T = smp ? 32 : 2048;
            for (int rj_ = 0; rj_ < REP_J0; ++rj_) if (JOBM & 1) { JOB_RANGE(0, j0, j1, js)
                for (int idx = j0; idx < j1; idx += js) { JOB_DECODE(idx)
                    const int hd = sub >> 2, sl = sub & 3;
                    GArgs A; A.QT = (const bf16*)(wsz + WS_GQT) + hd * 256; A.KT = (const bf16*)(wsz + WS_GKT) + hd * 256; A.KH = (const bf16*)(wsz + WS_GKH) + (size_t)hd * 256 * 64;
                    A.ER = (const float*)(wsz + WS_GER) + hd * 256; A.EB = (const float*)(wsz + WS_GEB) + hd * 256; A.ci0 = smp ? 128 + sb : sb * 32;
                    A.V = wCV + hd * 512 + sl * 128; A.row0 = row0; A.T = T;
                    const size_t so = ((size_t)hd * 256) * 512 + sl * 128;
                    A.S0 = smp ? args.in[I_SGL] + ((size_t)l * 8 + sb) * 4 * 256 * 512 + so : nullptr;
                    A.S1 = args.out + (smp ? O_GLS + ((size_t)l * 8 + sb) * 4 * 256 * 512 : O_GLP + ((size_t)l * 4 + sb) * 4 * 256 * 512) + so; A.lds = 512;
                    A.OA = wOC + BW + hd * 512 + sl * 128; A.SSQ = wSSQ + 16 + hd * 4 + sl;
                    gla_job(lds, tid, A);
                    __syncthreads(); } }
            for (int rj_ = 0; rj_ < REP_J1; ++rj_) if (JOBM & 2) { JOB_RANGE(1, j0, j1, js)
                for (int idx = j0; idx < j1; idx += js) { JOB_DECODE(idx)
                    const int h = sub;
                    LaArgs A; A.Q = wHQ + h * 128; A.ldq = BW; A.G = wHG + h * 128; A.ldg = BW; A.K = nullptr;
                    A.V = wHV + h * 128; A.row0 = row0; A.T = T;
                    A.S0 = smp ? args.in[I_SHG] + (((size_t)l * 8 + sb) * 16 + h) * 16384 : nullptr;
                    A.S1 = args.out + (smp ? O_HGS + (((size_t)l * 8 + sb) * 16 + h) * 16384 : O_HGP + (((size_t)l * 4 + sb) * 16 + h) * 16384); A.lds = 128;
                    A.nw = args.in[I_HGN] + l * BW + h * 128; A.gate = wHGATE + h * 128; A.Y = wY + h * 128;
                    la_job<128, false>(lds, tid, A);
                    __syncthreads(); } }
            for (int rj_ = 0; rj_ < REP_J2; ++rj_) if (JOBM & 4) { JOB_RANGE(2, j0, j1, js)
                for (int idx = j0; idx < j1; idx += js) { JOB_DECODE(idx)
                    const int hb = sub;
                    LruArgs A; A.LX = wLX + hb * 128; A.row0 = row0; A.T = T;
                    A.cst = smp ? args.in[I_SLC] + ((size_t)l * 8 + sb) * 3 * BW + hb * 128 : nullptr;
                    A.h0 = smp ? args.in[I_SLH] + ((size_t)l * 8 + sb) * BW + hb * 128 : nullptr;
                    A.cw = args.in[I_CW] + (size_t)l * 4 * BW + hb * 128; A.cb = args.in[I_CB] + l * BW + hb * 128;
                    A.wa = args.in[I_WA] + ((size_t)l * 16 + hb) * 16384; A.ba = args.in[I_BA] + l * BW + hb * 128;
                    A.wx = args.in[I_WX] + ((size_t)l * 16 + hb) * 16384; A.bx = args.in[I_BX] + l * BW + hb * 128;
                    A.lam = args.in[I_LAM] + l * BW + hb * 128; A.lgate = wLGATE + hb * 128; A.Y = wY + BW + hb * 128;
                    A.newh = args.out + (smp ? O_LHS + ((size_t)l * 8 + sb) * BW : O_LHP + ((size_t)l * 4 + sb) * BW) + hb * 128;
                    A.newconv = args.out + (smp ? O_LCS + ((size_t)l * 8 + sb) * 3 * BW : O_LCP + ((size_t)l * 4 + sb) * 3 * BW) + hb * 128;
                    lru_job(lds, tid, A);
                    __syncthreads(); } }
            if (chain && bx >= 192) {
                const int sw = bx - 192;
                unsigned* tb = (unsigned*)(ws + WS_CTL) + CW_TEAM + (l * 4) * 64 + rep_ * 16;
                team_barrier(tb, 64u);
                mix_fix_rows(wOC, wSSQ, args.in[I_HGN] + l * BW, wHGATE, args.in[I_GLN] + l * BW, wCGATE, wY, MP, MT, sw * NWAVES + wave, 64 * NWAVES, lane);
                team_barrier(tb + 64, 64u);
                if (sw < 48) {
                    const int pn = sw / 3, seg = sw - 3 * pn;
                    const FixedUnit FU{pg8::Unit{MP / 256, pn}};
                    af4 acc[2][2][4][2]; zero_acc(acc); const bf16* WB = (const bf16*)(ws + WS_WBR + l * SZ_WBR);
                    pg8::Gemm g{wY + seg * BW, WB + seg * BW, MT, DM, BW, KBR, KBR}; EpiGateSlab E{wMG, (float*)(wsz + WS_PB), seg};
                    pg8::gemm_phase<EpiGateSlab, FixedUnit, false, GEMM_SP2>(lds, g, FU, E, acc);
                }
                team_barrier(tb + 128, 64u);
                sum_slabs_rows((const float*)(wsz + WS_PB), wMB, sw * NWAVES + wave, 64 * NWAVES, lane);
                team_barrier(tb + 192, 64u);
                {
                    const int pn = sw >> 2, kq = sw & 3;
                    const FixedUnit FU{pg8::Unit{MP / 256, pn}};
                    af4 acc[2][2][4][2]; zero_acc(acc);
                    pg8::Gemm g{wMB + kq * 1024, (const bf16*)(ws + WS_WOU + l * SZ_WOU) + kq * 1024, MT, DM, 1024, DM, DM};
                    EpiF32 E{(float*)(wsz + WS_PO) + (size_t)kq * 256 * DM - (size_t)MP * DM, DM};
                    pg8::gemm_phase<EpiF32, FixedUnit, false, GEMM_SP2>(lds, g, FU, E, acc);
                }
                if (l == 0) {
                    int lz = lane; asm volatile("" : "+v"(lz));
                    convert_items(lds, args.in[I_WIN], args.in[I_WBR], args.in[I_WOU], ws, 1, 0, CVX, sw * NWAVES + wave, 64 * NWAVES, lz);
                }
            }
        }
        SEAM(pb + 2);
        for (int rp_ = 0; rp_ < REP_FIN; ++rp_) if (IN(pb + 3) && (PHM & 4)) { WSZ(); mix_fix_rows(wOC, wSSQ, args.in[I_HGN] + l * BW, wHGATE, args.in[I_GLN] + l * BW, wCGATE, wY, 0, MM, gw, NGW, lane); }
        SEAM(pb + 3);
        for (int rp_ = 0; rp_ < REP_BR; ++rp_) if (IN(pb + 4) && (PHM & 8)) { WSZ();
            const bf16* WB = (const bf16*)(ws + WS_WBR + l * SZ_WBR);
            BranchOrder BO; BO.S.init(MM, DM, G, bx);
            { af4 acc[2][2][4][2]; zero_acc(acc); pg8::Gemm g{wY, WB, MT, DM, BW, KBR, KBR}; const NoDrain<EpiBranchSeg> E{{wMG, wMB, 0}};
              pg8::gemm_phase<NoDrain<EpiBranchSeg>, BranchOrder, GEMM_ALIGN, GEMM_SP2>(lds, g, BO, E, acc); }
            if (l == 0) tail_convert(lds, args.in[I_WIN], args.in[I_WBR], args.in[I_WOU], ws, 1, chain ? CVX : 0, CV_IN, (MM / 256) * (DM / 256), G, bx, wave, lane);
        }
        SEAM(pb + 4);
        for (int rp_ = 0; rp_ < REP_OUT; ++rp_) if (IN(pb + 5) && (PHM & 16)) { WSZ();
            pg8::Gemm g{wMB, (const bf16*)(ws + WS_WOU + l * SZ_WOU), MT, DM, DM, DM, DM}; pg8::StaticOrder S; S.init(MM, DM, G, bx);
            EpiBf E{wOUT, DM}; if (GEMM_STREAM & 2) gemm_stream<EpiBf>(lds, g, S, E); else gemm_units<EpiBf>(lds, g, S, E);
        }
        SEAM(pb + 5);
        for (int rp_ = 0; rp_ < REP_FIN; ++rp_) if (IN(pb + 6) && (PHM & 32)) { WSZ();
            if (l == 0) final_rows<false, true>(xp, xs, wOUT, chain ? (const float*)(wsz + WS_PO) : nullptr, args.in[I_NPOST], X1, args.in[I_NPRE] + DM, Z, ws + WS_Z8, gw, NGW, lane);
            else        final_rows<true, false>(X1, X1 + (size_t)MP * DM, wOUT, chain ? (const float*)(wsz + WS_PO) : nullptr, args.in[I_NPOST] + DM, args.out, nullptr, nullptr, nullptr, gw, NGW, lane);
        }
        if (l == 0) SEAM(pb + 6);
    }
}

#undef tid
#undef lane
#undef chain
#undef MM
#ifndef PHM
#define PHM 127
#endif
#ifndef N_LAUNCH_MODE
#define N_LAUNCH_MODE 0
#endif
extern "C" void kernel_launch(void* const* d_in, const int* in_sizes, int n_in, void* d_out, int out_size, void* d_ws, size_t ws_size, hipStream_t stream) {
    static int grid = 0;
    if (grid == 0) {
        if (n_in != 23 || (size_t)out_size != O_END || ws_size < WS_END) { fprintf(stderr, "kernel_launch: unexpected shapes (n_in %d out %d ws %zu need %zu)\n", n_in, out_size, ws_size, (size_t)WS_END); grid = -1; return; }
        int dev = 0, cus = 0, per_cu = 0;
        if (hipGetDevice(&dev) != hipSuccess || hipDeviceGetAttribute(&cus, hipDeviceAttributeMultiprocessorCount, dev) != hipSuccess) { grid = -1; return; }
        if (hipFuncSetAttribute((const void*)mega, hipFuncAttributeMaxDynamicSharedMemorySize, LDS_BYTES) != hipSuccess) { fprintf(stderr, "kernel_launch: hipFuncSetAttribute failed\n"); grid = -1; return; }
        if (hipOccupancyMaxActiveBlocksPerMultiprocessor(&per_cu, (const void*)mega, NTHR, LDS_BYTES) != hipSuccess || per_cu < 1) { fprintf(stderr, "kernel_launch: occupancy query says %d\n", per_cu); grid = -1; return; }
        grid = cus;
    }
    if (grid < 0) return;
    hipMemsetAsync((char*)d_ws + WS_CTL, 0, CTL_ZERO_BYTES, stream);
    Args a{};
    for (int i = 0; i < 23; ++i) a.in[i] = (const float*)d_in[i];
    a.out = (float*)d_out; a.ws = (unsigned char*)d_ws; a.pad = 0;
#if N_LAUNCH_MODE == 1
    a.ph_lo = 0; a.ph_hi = NPHASE; a.use_bar = 1;
    hipLaunchKernelGGL(mega, dim3(grid), dim3(NTHR), LDS_BYTES, stream, a);
#else
    for (int p = 0; p < NPHASE; ++p) { a.ph_lo = p; a.ph_hi = p + 1; a.use_bar = 0; hipLaunchKernelGGL(mega, dim3(grid), dim3(NTHR), LDS_BYTES, stream, a); }
#endif
}
```

```cpp
#include <hip/hip_runtime.h>
#include <cstdio>
#include <cstdint>
#define N_LAUNCH_MODE 1
#ifndef PG8_WGM
#define PG8_WGM 8
#endif
namespace pg8 {
#define PG8_LAS __attribute__((address_space(3)))
typedef unsigned short bf16_t;
typedef short bf16x8 __attribute__((ext_vector_type(8)));
typedef float f32x4 __attribute__((ext_vector_type(4)));
typedef unsigned u32x4 __attribute__((ext_vector_type(4)));
typedef int i32x4 __attribute__((ext_vector_type(4)));
typedef int i32x8 __attribute__((ext_vector_type(8)));
constexpr int BM = 256, BK = 64, HALF = 128, HTB = HALF * BK * 2  , STAGE_BYTES = 8 * HTB, NXCD = 8, WGM = PG8_WGM;

__host__ __device__ __forceinline__ int lds_byte(int r, int c) { const int st = (r >> 4) * 2 + (c >> 5), rr = r & 15, cc = c & 31, ob = rr * 64 + cc * 2; return st * 1024 + (ob ^ (((ob >> 9) & 1) << 5)); }
__host__ __device__ __forceinline__ void stage_rc(int b, int& R, int& C) { const int st = b / 1024, sb = b % 1024, swz = sb ^ (((sb >> 9) & 1) << 5); R = (st >> 1) * 16 + swz / 64; C = (st & 1) * 32 + (swz % 64) / 2; }
__host__ __device__ __forceinline__ int perm32(int rho) { const int n = rho >> 4, i = rho & 15; return 8 * (i >> 2) + 4 * n + (i & 3); }

struct Unit { int pm, pn, ko; };
struct Gemm { const bf16_t* A; const bf16_t* Bt; int M, N, K, lda, ldb; };

struct StaticOrder {
    int nM, nN, nwg, G, c;
    __host__ __device__ __forceinline__ void init(int M, int N, int G_, int c_) { nM = M / BM; nN = N / BM; nwg = nM * nN; G = G_; c = c_; }
    __host__ __device__ __forceinline__ bool next(int i, Unit& u) const {
        const long L = (long)i * G + c; if (L >= nwg) return false;
        int wgid = (int)L; { const int q = nwg / NXCD, r = nwg % NXCD, xcd = wgid % NXCD, off = wgid / NXCD; wgid = (xcd < r ? xcd * (q + 1) : r * (q + 1) + (xcd - r) * q) + off; }
        const int nig = WGM * nN, gid = wgid / nig, fm = gid * WGM, w_ = wgid - gid * nig, rem = (nM % WGM) ? (nM % WGM) : 1;
        if ((nM - fm) < WGM) { u.pm = fm + (w_ % rem); u.pn = w_ / rem; } else { u.pm = fm + (w_ % WGM); u.pn = w_ / WGM; }
        u.ko = 0; return true;
    }
    __device__ __forceinline__ void a_ready(const Unit&) const {}
    __device__ __forceinline__ void done(const Unit&) const {}
    __device__ __forceinline__ bool zero_after(const Unit&) const { return true; }
};

template <class Epi, class Sched, bool ALIGN_EPI = false, bool SP2 = false, bool F8 = false>
__device__ __forceinline__ void gemm_phase(PG8_LAS unsigned char* lds, const Gemm g, const Sched& S, const Epi& E, f32x4 (&acc)[2][2][4][2]) {
    int tid_ = threadIdx.x; asm volatile("" : "+v"(tid_));
    const int tid = tid_, wid = __builtin_amdgcn_readfirstlane(tid >> 6), lane = tid & 63, wr = wid >> 2, wc = wid & 3, fr = lane & 15, fq = lane >> 4;
    const int K = g.K, nt = K / BK;
    unsigned voffA[2], voffB[2];
#pragma unroll
    for (int i = 0; i < 2; ++i) { int R, C; stage_rc(tid * 16 + i * 8192, R, C); const int Rb = Epi::PERM ? ((R & ~31) + perm32(R & 31)) : R;
        voffA[i] = (unsigned)(R * g.lda + C) * 2u; voffB[i] = (unsigned)(Rb * g.ldb + C) * 2u; }
    const size_t kstep = (size_t)(BK * 2);
    const size_t hstepA = (size_t)HALF * g.lda * 2, hstepB = (size_t)HALF * g.ldb * 2;
    const size_t tstepA = 2 * hstepA, tstepB = 2 * hstepB;
    const unsigned ldsw = (unsigned)wid * 1024u;
    const int aoff = lds_byte(wr * 64 + fr, fq * 8), boff = lds_byte(wc * 32 + fr, fq * 8);
#define PG8_SA(b, h) (((b) * 2 + (h)) * HTB)
#define PG8_SB(b, h) ((4 + (b) * 2 + (h)) * HTB)
#define PG8_STAGE(bufoff, gbase, voff) do { _Pragma("unroll") for (int _i = 0; _i < 2; ++_i) \
        __builtin_amdgcn_global_load_lds((const unsigned*)((const char*)(gbase) + (voff)[_i]), (PG8_LAS unsigned*)(lds + (bufoff) + ldsw + _i * 8192), 16, 0, 0); } while (0)
#define PG8_LDA(dst, b, h) do { if constexpr (F8) { _Pragma("unroll") for (int m = 0; m < 4; ++m) dst##8[m] = __builtin_shufflevector(*(const PG8_LAS i32x4*)(lds + PG8_SA(b, h) + aoff + m * 2048), *(const PG8_LAS i32x4*)(lds + PG8_SA(b, h) + aoff + m * 2048 + 1024), 0, 1, 2, 3, 4, 5, 6, 7); } \
        else { _Pragma("unroll") for (int m = 0; m < 4; ++m) _Pragma("unroll") for (int k = 0; k < 2; ++k) dst[m][k] = *(const PG8_LAS bf16x8*)(lds + PG8_SA(b, h) + aoff + m * 2048 + k * 1024); } } while (0)
#define PG8_LDB(dst, b, h) do { if constexpr (F8) { _Pragma("unroll") for (int n = 0; n < 2; ++n) dst##8[n] = __builtin_shufflevector(*(const PG8_LAS i32x4*)(lds + PG8_SB(b, h) + boff + n * 2048), *(const PG8_LAS i32x4*)(lds + PG8_SB(b, h) + boff + n * 2048 + 1024), 0, 1, 2, 3, 4, 5, 6, 7); } \
        else { _Pragma("unroll") for (int n = 0; n < 2; ++n) _Pragma("unroll") for (int k = 0; k < 2; ++k) dst[n][k] = *(const PG8_LAS bf16x8*)(lds + PG8_SB(b, h) + boff + n * 2048 + k * 1024); } } while (0)
#define PG8_CAT8(x0, x1) __builtin_shufflevector(__builtin_bit_cast(i32x4, (x0)), __builtin_bit_cast(i32x4, (x1)), 0, 1, 2, 3, 4, 5, 6, 7)
#define PG8_MMA(ai, bj, At, Bt) do { __builtin_amdgcn_s_setprio(1); \
        if constexpr (F8) { _Pragma("unroll") for (int m = 0; m < 4; ++m) _Pragma("unroll") for (int n = 0; n < 2; ++n) \
            asm volatile("v_mfma_f32_16x16x128_f8f6f4 %0, %1, %2, %0" : "+v"(acc[ai][bj][m][n]) : "v"(Bt##8[n]), "v"(At##8[m])); }   \
        else { _Pragma("unroll") for (int m = 0; m < 4; ++m) _Pragma("unroll") for (int n = 0; n < 2; ++n) _Pragma("unroll") for (int k = 0; k < 2; ++k) \
            acc[ai][bj][m][n] = __builtin_amdgcn_mfma_f32_16x16x32_bf16(Bt[n][k], At[m][k], acc[ai][bj][m][n], 0, 0, 0); } \
        __builtin_amdgcn_s_setprio(0); } while (0)
#define PG8_WAIT_V(n) asm volatile("s_waitcnt vmcnt(" #n ")" ::: "memory")
#define PG8_WAIT_L(n) asm volatile("s_waitcnt lgkmcnt(" #n ")" ::: "memory")
#define PG8_BAR __builtin_amdgcn_s_barrier()
#define PG8_SCHED __builtin_amdgcn_sched_barrier(0)
    Unit cur, nxt; int ui = 0;
    if (!S.next(0, cur)) return;
    bf16x8 At[4][2], B0[2][2], B1[2][2];
    i32x8 At8[4], B08[2], B18[2];
    const char* cA = (const char*)g.A + (size_t)cur.pm * tstepA + (size_t)cur.ko * 2; const char* cB = (const char*)g.Bt + (size_t)cur.pn * tstepB + (size_t)cur.ko * 2;
    S.a_ready(cur);
    if constexpr (SP2) {
        PG8_STAGE(PG8_SB(0, 0), cB, voffB); PG8_STAGE(PG8_SB(0, 1), cB + hstepB, voffB); PG8_STAGE(PG8_SA(0, 0), cA, voffA); PG8_STAGE(PG8_SA(0, 1), cA + hstepA, voffA);
        if (wr == 1) PG8_BAR;
        PG8_WAIT_V(2); PG8_BAR;
        PG8_STAGE(PG8_SB(1, 0), cB + kstep, voffB); PG8_STAGE(PG8_SA(1, 0), cA + kstep, voffA); PG8_STAGE(PG8_SB(1, 1), cB + hstepB + kstep, voffB);
        PG8_WAIT_V(6); PG8_BAR;
    } else {
        PG8_STAGE(PG8_SB(0, 0), cB, voffB); PG8_STAGE(PG8_SA(0, 0), cA, voffA); PG8_STAGE(PG8_SB(0, 1), cB + hstepB, voffB); PG8_STAGE(PG8_SA(0, 1), cA + hstepA, voffA);
        if (wr == 1) PG8_BAR;
        PG8_WAIT_V(4); PG8_BAR;
        PG8_STAGE(PG8_SB(1, 0), cB + kstep, voffB); PG8_STAGE(PG8_SA(1, 0), cA + kstep, voffA); PG8_STAGE(PG8_SB(1, 1), cB + hstepB + kstep, voffB);
        PG8_WAIT_V(6); PG8_BAR;
    }
    for (;;) {
        const bool has_next = S.next(ui + 1, nxt);
        const char* nA = has_next ? (const char*)g.A + (size_t)nxt.pm * tstepA + (size_t)nxt.ko * 2 : cA; const char* nB = has_next ? (const char*)g.Bt + (size_t)nxt.pn * tstepB + (size_t)nxt.ko * 2 : cB;
        for (int t = 0; t < nt; t += 2) {
            const bool last = (t == nt - 2);
            const char* a1 = cA + (size_t)(t + 1) * kstep;
            const char* a2 = last ? nA : cA + (size_t)(t + 2) * kstep; const char* b2 = last ? nB : cB + (size_t)(t + 2) * kstep;
            const char* a3 = a2 + kstep; const char* b3 = b2 + kstep;
            if (last && has_next) S.a_ready(nxt);
            if constexpr (SP2) {
            PG8_LDB(B0, 0, 0); PG8_LDB(B1, 0, 1); PG8_SCHED; PG8_LDA(At, 0, 0); PG8_STAGE(PG8_SA(1, 1), a1 + hstepA, voffA);
            PG8_WAIT_V(8); PG8_WAIT_L(0); PG8_BAR; PG8_MMA(0, 0, At, B0); PG8_MMA(0, 1, At, B1); PG8_BAR; PG8_SCHED;
            PG8_LDA(At, 0, 1); PG8_STAGE(PG8_SB(0, 0), b2, voffB); PG8_STAGE(PG8_SB(0, 1), b2 + hstepB, voffB); PG8_STAGE(PG8_SA(0, 0), a2, voffA);
            PG8_WAIT_V(8); PG8_WAIT_L(0); PG8_BAR; PG8_MMA(1, 0, At, B0); PG8_MMA(1, 1, At, B1); PG8_BAR; PG8_SCHED;
            PG8_LDB(B0, 1, 0); PG8_LDB(B1, 1, 1); PG8_SCHED; PG8_LDA(At, 1, 0); PG8_STAGE(PG8_SA(0, 1), a2 + hstepA, voffA);
            PG8_WAIT_V(8); PG8_WAIT_L(0); PG8_BAR; PG8_MMA(0, 0, At, B0); PG8_MMA(0, 1, At, B1); PG8_BAR; PG8_SCHED;
            PG8_LDA(At, 1, 1); PG8_STAGE(PG8_SB(1, 0), b3, voffB); PG8_STAGE(PG8_SB(1, 1), b3 + hstepB, voffB); PG8_STAGE(PG8_SA(1, 0), a3, voffA);
            PG8_WAIT_V(8); PG8_WAIT_L(0); PG8_BAR; PG8_MMA(1, 0, At, B0); PG8_MMA(1, 1, At, B1); PG8_BAR; PG8_SCHED;
            } else {
            PG8_LDB(B0, 0, 0); PG8_SCHED; PG8_LDA(At, 0, 0); PG8_STAGE(PG8_SA(1, 1), a1 + hstepA, voffA);
            PG8_WAIT_L(8); PG8_BAR; PG8_WAIT_L(0); PG8_MMA(0, 0, At, B0); PG8_BAR; PG8_SCHED;
            PG8_LDB(B1, 0, 1); PG8_STAGE(PG8_SB(0, 0), b2, voffB);
            PG8_BAR; PG8_WAIT_L(0); PG8_MMA(0, 1, At, B1); PG8_BAR;
            PG8_LDA(At, 0, 1); PG8_STAGE(PG8_SA(0, 0), a2, voffA);
            PG8_BAR; PG8_WAIT_L(0); PG8_MMA(1, 0, At, B0); PG8_BAR; PG8_SCHED;
            PG8_STAGE(PG8_SB(0, 1), b2 + hstepB, voffB);
            PG8_WAIT_V(6); PG8_BAR; PG8_MMA(1, 1, At, B1); PG8_BAR;
            PG8_LDB(B0, 1, 0); PG8_SCHED; PG8_LDA(At, 1, 0); PG8_STAGE(PG8_SA(0, 1), a2 + hstepA, voffA);
            PG8_WAIT_L(8); PG8_BAR; PG8_WAIT_L(0); PG8_MMA(0, 0, At, B0); PG8_BAR; PG8_SCHED;
            PG8_LDB(B1, 1, 1); PG8_STAGE(PG8_SB(1, 0), b3, voffB);
            PG8_BAR; PG8_WAIT_L(0); PG8_MMA(0, 1, At, B1); PG8_BAR;
            PG8_LDA(At, 1, 1); PG8_STAGE(PG8_SA(1, 0), a3, voffA);
            PG8_BAR; PG8_WAIT_L(0); PG8_MMA(1, 0, At, B0); PG8_BAR; PG8_SCHED;
            PG8_STAGE(PG8_SB(1, 1), b3 + hstepB, voffB);
            PG8_WAIT_V(6); PG8_BAR; PG8_MMA(1, 1, At, B1); PG8_BAR;
            }
        }
        if constexpr (ALIGN_EPI) { if (wr == 0) PG8_BAR; }
        if constexpr (F8) {
            asm volatile("s_nop 15\n\ts_nop 15\n\ts_nop 7" : "+v"(acc[0][0][0][0]), "+v"(acc[0][0][0][1]), "+v"(acc[0][0][1][0]), "+v"(acc[0][0][1][1]), "+v"(acc[0][0][2][0]), "+v"(acc[0][0][2][1]), "+v"(acc[0][0][3][0]), "+v"(acc[0][0][3][1]), "+v"(acc[0][1][0][0]), "+v"(acc[0][1][0][1]), "+v"(acc[0][1][1][0]), "+v"(acc[0][1][1][1]), "+v"(acc[0][1][2][0]), "+v"(acc[0][1][2][1]), "+v"(acc[0][1][3][0]), "+v"(acc[0][1][3][1]));
            asm volatile("" : "+v"(acc[1][0][0][0]), "+v"(acc[1][0][0][1]), "+v"(acc[1][0][1][0]), "+v"(acc[1][0][1][1]), "+v"(acc[1][0][2][0]), "+v"(acc[1][0][2][1]), "+v"(acc[1][0][3][0]), "+v"(acc[1][0][3][1]), "+v"(acc[1][1][0][0]), "+v"(acc[1][1][0][1]), "+v"(acc[1][1][1][0]), "+v"(acc[1][1][1][1]), "+v"(acc[1][1][2][0]), "+v"(acc[1][1][2][1]), "+v"(acc[1][1][3][0]), "+v"(acc[1][1][3][1])); }
        if constexpr (!Epi::AFTER_DRAIN) { E(acc, cur, wr, wc, fr, fq); S.done(cur); }
        if (!has_next) break;
        if (S.zero_after(cur)) {
#pragma unroll
        for (int a = 0; a < 2; ++a)
#pragma unroll
            for (int b = 0; b < 2; ++b)
#pragma unroll
                for (int m = 0; m < 4; ++m)
#pragma unroll
                    for (int n = 0; n < 2; ++n) acc[a][b][m][n] = (f32x4){0.f, 0.f, 0.f, 0.f};
        }
        cur = nxt; cA = nA; cB = nB; ++ui;
        if constexpr (ALIGN_EPI) { if (wr == 1) PG8_BAR; }
    }
    PG8_WAIT_V(0);
    if constexpr (!ALIGN_EPI) { if (wr == 0) PG8_BAR; }
    PG8_BAR;
    if constexpr (Epi::AFTER_DRAIN) { E.fused(acc, cur, wr, wc, fr, fq, lds, wid, lane); S.done(cur); }
#undef PG8_SA
#undef PG8_SB
#undef PG8_STAGE
#undef PG8_LDA
#undef PG8_LDB
#undef PG8_MMA
#undef PG8_CAT8
#undef PG8_WAIT_V
#undef PG8_WAIT_L
#undef PG8_BAR
#undef PG8_SCHED
}
}
#ifndef REP_IN
#define REP_IN 1
#endif
#ifndef REP_BR
#define REP_BR 1
#endif
#ifndef REP_OUT
#define REP_OUT 1
#endif
#ifndef REP_FIN
#define REP_FIN 1
#endif
#ifndef GEMM_STREAM
#define GEMM_STREAM 3
#endif
#ifndef REP_J0
#define REP_J0 1
#endif
#ifndef REP_J1
#define REP_J1 1
#endif
#ifndef REP_J2
#define REP_J2 1
#endif
#ifndef REP_SCAN
#define REP_SCAN 1
#endif
#ifndef REP_P0
#define REP_P0 1
#endif
#ifndef SEG0
#define SEG0 0
#endif
#ifndef GATELESS
#define GATELESS 1
#endif
#ifndef GEMM_ONEUNIT
#define GEMM_ONEUNIT 1
#endif
#ifndef DIAGSEL
#define DIAGSEL 4095
#endif
#ifndef NO_T4
#define NO_T4 0
#endif
#ifndef NO_T5
#define NO_T5 0
#endif
#ifndef NO_T6
#define NO_T6 0
#endif
#ifndef DIAG_SIMPLE
#define DIAG_SIMPLE 0
#endif
#ifndef GEMM_ALIGN
#define GEMM_ALIGN true
#endif
#ifndef GEMM_SP2
#define GEMM_SP2 true
#endif
#ifndef PHM
#define PHM 127
#endif
#ifndef JOBM
#define JOBM 7
#endif

#define GAS __attribute__((address_space(1)))
#define LAS __attribute__((address_space(3)))
typedef unsigned short bf16;
typedef short bf16x8 __attribute__((ext_vector_type(8)));
typedef short bf16x4 __attribute__((ext_vector_type(4)));
typedef float f32x4 __attribute__((ext_vector_type(4)));
typedef unsigned u32x4 __attribute__((ext_vector_type(4)));
typedef unsigned u32x2 __attribute__((ext_vector_type(2)));
#define DI __device__ __forceinline__
#define LDS_WAIT() asm volatile("s_waitcnt lgkmcnt(0)" ::: "memory")
typedef float f32x2_t __attribute__((ext_vector_type(2)));
typedef __bf16 bf16x2_t __attribute__((ext_vector_type(2)));
DI unsigned pk2(float lo, float hi) { const f32x2_t v = {lo, hi}; const bf16x2_t b = __builtin_convertvector(v, bf16x2_t); return __builtin_bit_cast(unsigned, b); }
DI unsigned pk4f8(float a, float b, float c, float d) { int w = 0; w = __builtin_amdgcn_cvt_pk_fp8_f32(a, b, w, false); w = __builtin_amdgcn_cvt_pk_fp8_f32(c, d, w, true); return (unsigned)w; }
DI unsigned pk4u8(float a, float b, float c, float d) { unsigned w = 0u; w = __builtin_amdgcn_cvt_pk_u8_f32(a, 0, w); w = __builtin_amdgcn_cvt_pk_u8_f32(b, 1, w); w = __builtin_amdgcn_cvt_pk_u8_f32(c, 2, w); w = __builtin_amdgcn_cvt_pk_u8_f32(d, 3, w); return w; }
DI float ub0(unsigned w) { return (float)(w & 0xffu); }
DI float ub1(unsigned w) { return (float)((w >> 8) & 0xffu); }
DI float ub2(unsigned w) { return (float)((w >> 16) & 0xffu); }
DI float ub3(unsigned w) { return (float)(w >> 24); }
DI bf16 f2bf(float f) { return (bf16)(pk2(f, 0.f) & 0xffffu); }
DI float bf2f(unsigned b) { return __uint_as_float(b << 16); }
DI float bflo(unsigned w) { return __uint_as_float(w << 16); }
DI float bfhi(unsigned w) { return __uint_as_float(w & 0xffff0000u); }
DI float sigmoidf_(float x) { return __builtin_amdgcn_rcpf(1.0f + __expf(-x)); }
DI float siluf_(float x) { return x * sigmoidf_(x); }
DI float wave_sum(float v) {
#pragma unroll
    for (int o = 1; o < 64; o <<= 1) v += __shfl_xor(v, o);
    return v;
}
#define MFMA16(a, b, c) __builtin_amdgcn_mfma_f32_16x16x32_bf16((a), (b), (c), 0, 0, 0)

constexpr int DM = 4096, MP = 8192, MS_ = 256, MT = 8448;
constexpr int BW = 2048;
constexpr int NIN = 30976;
constexpr int KBR = 6144;
constexpr float EPS = 1e-6f;
constexpr int NWAVES = 8, NTHR = 512;
constexpr int LDS_BYTES = 147456;
constexpr int MISC_OFF = LDS_BYTES - 256;

constexpr size_t O_YP = 0, O_YS = 33554432, O_HGP = 34603008, O_HGS = 36700160, O_LHP = 40894464, O_LHS = 40910848,
                 O_LCP = 40943616, O_LCS = 40992768, O_GLP = 41091072, O_GLS = 45285376, O_END = 53673984;

constexpr size_t MiB = 1u << 20;
constexpr size_t alup(size_t x) { return (x + MiB - 1) / MiB * MiB; }
constexpr size_t WS_CTL = 0, CTL_ZERO_BYTES = MiB;
constexpr size_t SZ_WIN = alup((size_t)NIN * DM * 2), SZ_WBR = alup((size_t)DM * KBR * 2), SZ_WOU = alup((size_t)DM * DM * 2);
constexpr size_t WS_WIN = MiB, WS_WBR = WS_WIN + 2 * SZ_WIN, WS_WOU = WS_WBR + 2 * SZ_WBR;
constexpr size_t WS_Z = WS_WOU + 2 * SZ_WOU;
constexpr size_t WS_HQ = WS_Z + alup((size_t)MT * DM * 2);
constexpr size_t WS_HG = WS_HQ + alup((size_t)MT * BW * 2);
constexpr size_t WS_HV = WS_HG + alup((size_t)MT * BW * 4);
constexpr size_t WS_HGATE = WS_HV + alup((size_t)MT * BW * 2);
constexpr size_t WS_LX = WS_HGATE + alup((size_t)MT * BW * 2);
constexpr size_t WS_LGATE = WS_LX + alup((size_t)MT * BW * 4);
constexpr size_t WS_CQ = WS_LGATE + alup((size_t)MT * BW * 2);
constexpr size_t WS_CK = WS_CQ + alup((size_t)MT * 1024 * 2);
constexpr size_t WS_CV = WS_CK + alup((size_t)MT * 1024 * 2);
constexpr size_t WS_CGATE = WS_CV + alup((size_t)MT * BW * 2);
constexpr size_t WS_MG = WS_CGATE + alup((size_t)MT * BW * 2);
constexpr size_t WS_CLR = WS_MG + alup((size_t)MT * 12288 * 2);
constexpr size_t WS_Y = WS_CLR + alup((size_t)MT * 16 * 4);
constexpr size_t WS_OC = WS_Y + alup((size_t)MT * KBR * 2);
constexpr size_t WS_SSQ = WS_OC + alup((size_t)MT * 2 * BW * 4);
constexpr size_t WS_MERGED = WS_SSQ + alup((size_t)MT * 32 * 4);
constexpr size_t WS_MB = WS_MERGED + alup((size_t)MT * DM * 4);
constexpr size_t WS_OUT = WS_MB + alup((size_t)MT * DM * 2);
constexpr size_t WS_X1 = WS_OUT + alup((size_t)MT * DM * 4);
constexpr size_t WS_PB = WS_X1 + alup((size_t)MT * DM * 4);
constexpr size_t WS_PO = WS_PB + alup((size_t)3 * 256 * DM * 4);
constexpr int NCHK = 136;
constexpr size_t WS_GQT = WS_PO + alup((size_t)4 * 256 * DM * 4);
constexpr size_t WS_GKT = WS_GQT + alup((size_t)MT * 1024 * 2);
constexpr size_t WS_GKH = WS_GKT + alup((size_t)MT * 1024 * 2);
constexpr size_t WS_GER = WS_GKH + alup((size_t)NCHK * 1024 * 64 * 2);
constexpr size_t WS_GEB = WS_GER + alup((size_t)NCHK * 1024 * 4);
constexpr size_t WS_Z8 = WS_GEB + alup((size_t)NCHK * 1024 * 4);
constexpr size_t SZ_W8 = alup((size_t)12288 * DM);
constexpr size_t WS_W8 = WS_Z8 + alup((size_t)MT * DM);
constexpr size_t WS_END = WS_W8 + 2 * SZ_W8;
constexpr int CW_BAR = 4096;
constexpr int CW_TEAM = 16384;

#define XB_TMO      128
#define XB_XCNT(j)  (256  + 64 * (j))
#define XB_XSUB(j)  (1280 + 64 * (j))
#define XB_XGEN(j)  (2304 + 64 * (j))
#define XB_TOP      3328
#define XB_TOPGEN   3392
#define XCD_BAR_WORDS 3456
#define XB_SPIN_CAP (1u << 18)
__device__ __forceinline__ unsigned xb_ld(unsigned* p)              { return __hip_atomic_load(p, __ATOMIC_RELAXED, __HIP_MEMORY_SCOPE_AGENT); }
__device__ __forceinline__ unsigned xb_add(unsigned* p, unsigned v) { return __hip_atomic_fetch_add(p, v, __ATOMIC_RELAXED, __HIP_MEMORY_SCOPE_AGENT); }
__device__ __forceinline__ unsigned xb_xcc_id() { return (unsigned)__builtin_amdgcn_s_getreg((3 << 11) | 20) & 0xFu; }
#define XB_SPIN(cond, bar) do { unsigned _sp = 0; while (cond) { __builtin_amdgcn_s_sleep(1); \
    if ((++_sp & 255u) == 0u) { if (xb_ld(&(bar)[XB_TMO])) break; if (_sp > XB_SPIN_CAP) { atomicAdd(&(bar)[XB_TMO], 1u); break; } } } } while (0)
struct XcdBarrier { unsigned* bar; unsigned x; volatile LAS unsigned* st; };
__device__ __forceinline__ XcdBarrier xcd_barrier_post(unsigned* bar, volatile LAS unsigned* st) {
    XcdBarrier b; b.bar = bar; b.x = xb_xcc_id(); b.st = st;
    if (threadIdx.x == 0) (void)xb_add(&bar[XB_XCNT(b.x)], 1u);
    return b;
}
__device__ __forceinline__ void xcd_barrier_complete(unsigned* bar, unsigned x, unsigned& nloc, unsigned& nx) {
    const unsigned G = gridDim.x * gridDim.y * gridDim.z;
    unsigned sum, cnt, mine, sp = 0u;
    for (;;) {
        sum = 0u; cnt = 0u; mine = 0u;
#pragma unroll
        for (unsigned j = 0; j < 16; ++j) { const unsigned c = xb_ld(&bar[XB_XCNT(j)]); sum += c; cnt += (c > 0u) ? 1u : 0u; mine = (j == x) ? c : mine; }
        if (sum == G) break;
        __builtin_amdgcn_s_sleep(1);
        if ((++sp & 255u) == 0u) { if (xb_ld(&bar[XB_TMO])) break; if (sp > XB_SPIN_CAP) { atomicAdd(&bar[XB_TMO], 1u); break; } }
    }
    nloc = mine > 0u ? mine : 1u; nx = cnt > 0u ? cnt : 1u;
}
__device__ __forceinline__ void xcd_barrier(const XcdBarrier& b) {
    asm volatile("s_waitcnt vmcnt(0)" ::: "memory");
    __syncthreads();
    if (threadIdx.x == 0) {
        unsigned* bar = b.bar;
        __builtin_amdgcn_s_waitcnt(0);
        unsigned nloc = b.st[0], nx = b.st[1];
        if (nloc == 0u) { xcd_barrier_complete(bar, b.x, nloc, nx); b.st[0] = nloc; b.st[1] = nx; }
        const unsigned old = xb_add(&bar[XB_XSUB(b.x)], 1u);
        const unsigned gen = old / nloc;
        if (old + 1u == (gen + 1u) * nloc) {
            __builtin_amdgcn_fence(__ATOMIC_RELEASE, "agent");
            asm volatile("s_waitcnt vmcnt(0)" ::: "memory");
            const unsigned og = xb_add(&bar[XB_TOP], 1u);
            const unsigned tg = og / nx;
            if (og + 1u == (tg + 1u) * nx) xb_add(&bar[XB_TOPGEN], 1u);
            else XB_SPIN(xb_ld(&bar[XB_TOPGEN]) == tg, bar);
            __builtin_amdgcn_fence(__ATOMIC_ACQUIRE, "agent");
            xb_add(&bar[XB_XGEN(b.x)], 1u);
            asm volatile("s_waitcnt vmcnt(0)" ::: "memory");
        } else {
            XB_SPIN(xb_ld(&bar[XB_XGEN(b.x)]) == gen, bar);
            __builtin_amdgcn_fence(__ATOMIC_ACQUIRE, "agent");
            asm volatile("s_waitcnt vmcnt(0)" ::: "memory");
        }
    }
    __syncthreads();
}

typedef pg8::f32x4 af4;
struct EpiInProj {
    static constexpr bool PERM = true, AFTER_DRAIN = true;
    DI void fused(af4 (&acc)[2][2][4][2], const pg8::Unit& u, int wr, int wc, int fr, int fq, LAS unsigned char*, int, int) const { (*this)(acc, u, wr, wc, fr, fq); }
    bf16 *HQ, *HV, *HGATE, *LGATE, *CQ, *CK, *CV, *CGATE; unsigned char* MG; float *HG, *LX, *CLR; const float* lbl; int layer; float mgs;
    template <int T> DI void body(const af4 (&acc)[2][2][4][2], void* base, const int ld, const int row0, const int col0) const {
        af4 lbv[2][2];
        if (T == 5) {
#pragma unroll
            for (int bj = 0; bj < 2; ++bj)
#pragma unroll
                for (int hh = 0; hh < 2; ++hh) { const af4 a0 = *(const af4*)(lbl + col0 + bj * 128 + 4 * hh), a1 = *(const af4*)(lbl + BW + col0 + bj * 128 + 4 * hh);
#pragma unroll
                    for (int j = 0; j < 4; ++j) { const float mx = fmaxf(a0[j], a1[j]); const float e0 = __expf(a0[j] - mx), e1 = __expf(a1[j] - mx); lbv[bj][hh][j] = layer ? e1 / (e0 + e1) : 0.f; } }
        }
        if (T == 2) {
            int c0 = col0; asm volatile("" : "+v"(c0)); const int odd = (c0 >> 3) & 1;
#pragma unroll
            for (int ai = 0; ai < 2; ++ai)
#pragma unroll
                for (int mp = 0; mp < 2; ++mp)
#pragma unroll
                    for (int bj = 0; bj < 2; ++bj) {
                        unsigned px[2], py[2];
#pragma unroll
                        for (int h = 0; h < 2; ++h) { af4 v0 = acc[ai][bj][2 * mp + h][0], v1 = acc[ai][bj][2 * mp + h][1];
#pragma unroll
                            for (int j = 0; j < 4; ++j) { v0[j] = fmaxf(sigmoidf_(v0[j] * mgs) * 255.0f + 0.5f, 1.0f); v1[j] = fmaxf(sigmoidf_(v1[j] * mgs) * 255.0f + 0.5f, 1.0f); }
                            px[h] = pk4u8(v0[0], v0[1], v0[2], v0[3]); py[h] = pk4u8(v1[0], v1[1], v1[2], v1[3]); __builtin_amdgcn_sched_barrier(0); }
                        const auto rx = __builtin_amdgcn_permlane16_swap(px[0], px[1], false, false); const auto ry = __builtin_amdgcn_permlane16_swap(py[0], py[1], false, false);
                        u32x4 o; o.x = rx[0]; o.y = ry[0]; o.z = rx[1]; o.w = ry[1];
                        *(u32x4*)((unsigned char*)base + (size_t)(row0 + ai * 128 + (2 * mp + odd) * 16) * ld + (c0 - 8 * odd) + bj * 128) = o;
                    }
            return;
        }
#pragma unroll
        for (int ai = 0; ai < 2; ++ai)
#pragma unroll
            for (int m = 0; m < 4; ++m) {
                const size_t rowoff = (size_t)(row0 + ai * 128 + m * 16) * ld;
#pragma unroll
                for (int bj = 0; bj < 2; ++bj) {
                    af4 v0 = acc[ai][bj][m][0], v1 = acc[ai][bj][m][1];
                    const int col = col0 + bj * 128;
                    if (T <= 3) {
#pragma unroll
                        for (int j = 0; j < 4; ++j) {
                            if (T == 1) { v0[j] = siluf_(v0[j]); v1[j] = siluf_(v1[j]); }
                            if (T == 2) { v0[j] = sigmoidf_(v0[j] * mgs); v1[j] = sigmoidf_(v1[j] * mgs); }
                            if (T == 3) { v0[j] *= 0.0625f; v1[j] *= 0.0625f; }
                        }
                        if (T == 2) {
#pragma unroll
                            for (int j = 0; j < 4; ++j) { v0[j] = fmaxf(v0[j] * 255.0f + 0.5f, 1.0f); v1[j] = fmaxf(v1[j] * 255.0f + 0.5f, 1.0f); }
                            u32x2 o; o.x = pk4u8(v0[0], v0[1], v0[2], v0[3]); o.y = pk4u8(v1[0], v1[1], v1[2], v1[3]);
                            *(u32x2*)((unsigned char*)base + rowoff + col) = o;
                        } else {
                        u32x4 o; o.x = pk2(v0[0], v0[1]); o.y = pk2(v0[2], v0[3]); o.z = pk2(v1[0], v1[1]); o.w = pk2(v1[2], v1[3]);
                        *(u32x4*)((bf16*)base + rowoff + col) = o; }
                    } else if (T == 4) {
                        float* p = (float*)base + rowoff + col; *(af4*)p = v0; *(af4*)(p + 4) = v1;
                    } else if (T == 5) {
#pragma unroll
                        for (int j = 0; j < 4; ++j) {
                            const float l0 = lbv[bj][0][j], l1 = lbv[bj][1][j];
                            v0[j] = __logf(fmaxf(l0 + (1.0f - l0) * sigmoidf_(v0[j]), 1e-6f));
                            v1[j] = __logf(fmaxf(l1 + (1.0f - l1) * sigmoidf_(v1[j]), 1e-6f));
                        }
                        float* p = (float*)base + rowoff + col; *(af4*)p = v0; *(af4*)(p + 4) = v1;
                    } else {
                        if (col < 16) { float* p = (float*)base + rowoff + col; *(af4*)p = v0; *(af4*)(p + 4) = v1; }
                    }
                }
            }
    }
    DI void operator()(const af4 (&acc)[2][2][4][2], const pg8::Unit& u, int wr, int wc, int fr, int fq) const {
        const int row0 = u.pm * 256 + wr * 64 + fr, cl = wc * 32 + 8 * fq, pn = u.pn;
        if (pn < 8)        body<1>(acc, HQ, BW, row0, pn * 256 + cl);
        else if (pn < 16)  body<(NO_T5 ? (NO_T4 ? 0 : 4) : 5)>(acc, HG, BW, row0, (pn - 8) * 256 + cl);
        else if (pn < 24)  body<0>(acc, HV, BW, row0, (pn - 16) * 256 + cl);
        else if (pn < 32)  body<1>(acc, HGATE, BW, row0, (pn - 24) * 256 + cl);
        else if (pn < 40)  body<(NO_T4 ? 0 : 4)>(acc, LX, BW, row0, (pn - 32) * 256 + cl);
        else if (pn < 48)  body<1>(acc, LGATE, BW, row0, (pn - 40) * 256 + cl);
        else if (pn < 52)  body<3>(acc, CQ, 1024, row0, (pn - 48) * 256 + cl);
        else if (pn < 56)  body<0>(acc, CK, 1024, row0, (pn - 52) * 256 + cl);
        else if (pn < 64)  body<0>(acc, CV, BW, row0, (pn - 56) * 256 + cl);
        else if (pn < 72)  body<1>(acc, CGATE, BW, row0, (pn - 64) * 256 + cl);
        else if (pn < 120) body<2>(acc, MG, 12288, row0, (pn - 72) * 256 + cl);
        else               { if (!NO_T6) body<6>(acc, CLR, 16, row0, cl); }
    }
};
struct EpiBranchSeg {
    static constexpr bool PERM = true, AFTER_DRAIN = true;
    const unsigned char* MG; bf16* MB; int seg;
    DI void operator()(af4 (&acc)[2][2][4][2], const pg8::Unit& u, int wr, int wc, int fr, int fq) const { const EpiBranchSeg E2{MG, MB, u.ko / BW}; E2.fused(acc, u, wr, wc, fr, fq, nullptr, 0, 0); }
    DI void fused(af4 (&acc)[2][2][4][2], const pg8::Unit& u, int wr, int wc, int fr, int fq, LAS unsigned char*, int, int) const {
        int fqz = fq; asm volatile("" : "+v"(fqz));
        const int odd = fqz & 1;
        const size_t row0 = (size_t)(u.pm * 256 + wr * 64 + fr); const int col0 = u.pn * 256 + wc * 32 + 8 * fqz;
        const unsigned char* gp = MG + (row0 + 16 * odd) * 12288 + (size_t)seg * DM + (col0 - 8 * odd);
#define EB_PTR(p_) (gp + (size_t)((((p_) >> 2) & 1) * 128 + (((p_) >> 1) & 1) * 32) * 12288 + ((p_) & 1) * 128)
#define EB_SPLIT(L_, G0_, G1_) do { const auto rx_ = __builtin_amdgcn_permlane16_swap((L_).x, (L_).z, false, false); const auto ry_ = __builtin_amdgcn_permlane16_swap((L_).y, (L_).w, false, false); \
            G0_.x = rx_[0]; G0_.y = ry_[0]; G1_.x = rx_[1]; G1_.y = ry_[1]; } while (0)
        if (seg < 2) {
            u32x4 a0 = *(const u32x4*)EB_PTR(0), b0 = *(const u32x4*)(EB_PTR(0) + DM), a1 = *(const u32x4*)EB_PTR(1), b1 = *(const u32x4*)(EB_PTR(1) + DM);
#pragma unroll
            for (int p = 0; p < 8; ++p) {
                u32x4 a2 = a1, b2 = b1;
                if (p + 2 < 8) { a2 = *(const u32x4*)EB_PTR(p + 2); b2 = *(const u32x4*)(EB_PTR(p + 2) + DM); }
                u32x2 ga[2], gb[2]; EB_SPLIT(a0, ga[0], ga[1]); EB_SPLIT(b0, gb[0], gb[1]);
#pragma unroll
                for (int h = 0; h < 2; ++h) {
                    af4& v0 = acc[(p >> 2) & 1][p & 1][((p >> 1) & 1) * 2 + h][0]; af4& v1 = acc[(p >> 2) & 1][p & 1][((p >> 1) & 1) * 2 + h][1];
                    v0[0] *= ub0(ga[h].x) * __builtin_amdgcn_rcpf(ub0(gb[h].x)); v0[1] *= ub1(ga[h].x) * __builtin_amdgcn_rcpf(ub1(gb[h].x));
                    v0[2] *= ub2(ga[h].x) * __builtin_amdgcn_rcpf(ub2(gb[h].x)); v0[3] *= ub3(ga[h].x) * __builtin_amdgcn_rcpf(ub3(gb[h].x));
                    v1[0] *= ub0(ga[h].y) * __builtin_amdgcn_rcpf(ub0(gb[h].y)); v1[1] *= ub1(ga[h].y) * __builtin_amdgcn_rcpf(ub1(gb[h].y));
                    v1[2] *= ub2(ga[h].y) * __builtin_amdgcn_rcpf(ub2(gb[h].y)); v1[3] *= ub3(ga[h].y) * __builtin_amdgcn_rcpf(ub3(gb[h].y));
                    asm volatile("" : "+v"(v0), "+v"(v1) :: "memory");
                }
                asm volatile("" : "+v"(a1), "+v"(b1), "+v"(a2), "+v"(b2) :: "memory");
                a0 = a1; b0 = b1; a1 = a2; b1 = b2;
            }
        } else {
            constexpr float Q = 1.0f / 255.0f;
            u32x4 a0 = *(const u32x4*)EB_PTR(0), a1 = *(const u32x4*)EB_PTR(1);
#pragma unroll
            for (int p = 0; p < 8; ++p) {
                u32x4 a2 = a1;
                if (p + 2 < 8) a2 = *(const u32x4*)EB_PTR(p + 2);
                u32x2 gw[2]; EB_SPLIT(a0, gw[0], gw[1]);
#pragma unroll
                for (int h = 0; h < 2; ++h) {
                    const int m = ((p >> 1) & 1) * 2 + h; const size_t ro = (size_t)(((p >> 2) & 1) * 128 + m * 16);
                    af4 v0 = acc[(p >> 2) & 1][p & 1][m][0], v1 = acc[(p >> 2) & 1][p & 1][m][1];
                    v0[0] *= ub0(gw[h].x) * Q; v0[1] *= ub1(gw[h].x) * Q; v0[2] *= ub2(gw[h].x) * Q; v0[3] *= ub3(gw[h].x) * Q;
                    v1[0] *= ub0(gw[h].y) * Q; v1[1] *= ub1(gw[h].y) * Q; v1[2] *= ub2(gw[h].y) * Q; v1[3] *= ub3(gw[h].y) * Q;
                    u32x4 o; o.x = pk2(v0[0], v0[1]); o.y = pk2(v0[2], v0[3]); o.z = pk2(v1[0], v1[1]); o.w = pk2(v1[2], v1[3]);
                    *(u32x4*)(MB + (row0 + ro) * DM + col0 + (p & 1) * 128) = o;
                }
                asm volatile("" : "+v"(a1), "+v"(a2) :: "memory");
                a0 = a1; a1 = a2;
            }
        }
#undef EB_SPLIT
#undef EB_PTR
    }
};
struct EpiGateSlab {
    static constexpr bool PERM = true, AFTER_DRAIN = true;
    const unsigned char* MG; float* PB; int seg;
    DI void fused(af4 (&acc)[2][2][4][2], const pg8::Unit& u, int wr, int wc, int fr, int fq, LAS unsigned char*, int, int) const {
        const size_t row0 = (size_t)(u.pm * 256 + wr * 64 + fr); const int col0 = u.pn * 256 + wc * 32 + 8 * fq;
        const unsigned char* gp = MG + row0 * 12288 + (size_t)seg * DM + col0;
        float* pb = PB + ((size_t)seg * 256 + (size_t)(wr * 64 + fr)) * DM + col0;
        u32x2 gall[2][4][2];
#pragma unroll
        for (int ai = 0; ai < 2; ++ai)
#pragma unroll
            for (int m = 0; m < 4; ++m)
#pragma unroll
                for (int bj = 0; bj < 2; ++bj) gall[ai][m][bj] = *(const u32x2*)(gp + (size_t)(ai * 128 + m * 16) * 12288 + bj * 128);
#pragma unroll
        for (int ai = 0; ai < 2; ++ai)
#pragma unroll
            for (int m = 0; m < 4; ++m) {
#pragma unroll
                for (int bj = 0; bj < 2; ++bj) {
                    const size_t ro = (size_t)(ai * 128 + m * 16);
                    const u32x2 gw = gall[ai][m][bj]; constexpr float Q = 1.0f / 255.0f;
                    af4 v0 = acc[ai][bj][m][0], v1 = acc[ai][bj][m][1];
                    v0[0] *= ub0(gw.x) * Q; v0[1] *= ub1(gw.x) * Q; v0[2] *= ub2(gw.x) * Q; v0[3] *= ub3(gw.x) * Q;
                    v1[0] *= ub0(gw.y) * Q; v1[1] *= ub1(gw.y) * Q; v1[2] *= ub2(gw.y) * Q; v1[3] *= ub3(gw.y) * Q;
                    float* q = pb + ro * DM + bj * 128; *(af4*)q = v0; *(af4*)(q + 4) = v1;
                    asm volatile("" ::: "memory");
                }
            }
    }
};
struct EpiSimple {
    static constexpr bool PERM = true, AFTER_DRAIN = true;
    DI void fused(af4 (&acc)[2][2][4][2], const pg8::Unit& u, int wr, int wc, int fr, int fq, LAS unsigned char*, int, int) const { (*this)(acc, u, wr, wc, fr, fq); }
    bf16* O; int ldc;
    DI void operator()(const af4 (&acc)[2][2][4][2], const pg8::Unit& u, int wr, int wc, int fr, int fq) const {
        const int row0 = u.pm * 256 + wr * 64 + fr, col0 = u.pn * 256 + wc * 32 + 8 * fq;
#pragma unroll
        for (int ai = 0; ai < 2; ++ai)
#pragma unroll
            for (int m = 0; m < 4; ++m) {
                bf16* rp = O + (size_t)(row0 + ai * 128 + m * 16) * ldc + col0;
#pragma unroll
                for (int bj = 0; bj < 2; ++bj) { af4 v0 = acc[ai][bj][m][0], v1 = acc[ai][bj][m][1];
#pragma unroll
                    for (int j = 0; j < 4; ++j) { v0[j] = siluf_(v0[j]); v1[j] = siluf_(v1[j]); }
                    u32x4 o; o.x = pk2(v0[0], v0[1]); o.y = pk2(v0[2], v0[3]); o.z = pk2(v1[0], v1[1]); o.w = pk2(v1[2], v1[3]); *(u32x4*)(rp + bj * 128) = o; }
            }
    }
};
struct EpiBf {
    static constexpr bool PERM = true, AFTER_DRAIN = true;
    DI void fused(af4 (&acc)[2][2][4][2], const pg8::Unit& u, int wr, int wc, int fr, int fq, LAS unsigned char*, int, int) const { (*this)(acc, u, wr, wc, fr, fq); }
    bf16* O; int ldc;
    DI void operator()(const af4 (&acc)[2][2][4][2], const pg8::Unit& u, int wr, int wc, int fr, int fq) const {
        const int row0 = u.pm * 256 + wr * 64 + fr, col0 = u.pn * 256 + wc * 32 + 8 * fq;
#pragma unroll
        for (int ai = 0; ai < 2; ++ai)
#pragma unroll
            for (int m = 0; m < 4; ++m) {
                bf16* rp = O + (size_t)(row0 + ai * 128 + m * 16) * ldc + col0;
#pragma unroll
                for (int bj = 0; bj < 2; ++bj) { const af4 v0 = acc[ai][bj][m][0], v1 = acc[ai][bj][m][1];
                    u32x4 o; o.x = pk2(v0[0], v0[1]); o.y = pk2(v0[2], v0[3]); o.z = pk2(v1[0], v1[1]); o.w = pk2(v1[2], v1[3]); *(u32x4*)(rp + bj * 128) = o; }
            }
    }
};
struct EpiF32 {
    static constexpr bool PERM = true, AFTER_DRAIN = true;
    DI void fused(af4 (&acc)[2][2][4][2], const pg8::Unit& u, int wr, int wc, int fr, int fq, LAS unsigned char*, int, int) const { (*this)(acc, u, wr, wc, fr, fq); }
    float* C; int ldc;
    DI void operator()(const af4 (&acc)[2][2][4][2], const pg8::Unit& u, int wr, int wc, int fr, int fq) const {
        const int row0 = u.pm * 256 + wr * 64 + fr, col0 = u.pn * 256 + wc * 32 + 8 * fq;
#pragma unroll
        for (int ai = 0; ai < 2; ++ai)
#pragma unroll
            for (int m = 0; m < 4; ++m) {
                float* rp = C + (size_t)(row0 + ai * 128 + m * 16) * ldc + col0;
#pragma unroll
                for (int bj = 0; bj < 2; ++bj) { *(af4*)(rp + bj * 128) = acc[ai][bj][m][0]; *(af4*)(rp + bj * 128 + 4) = acc[ai][bj][m][1]; }
            }
    }
};

struct OneUnit {
    pg8::StaticOrder S; int i;
    DI bool next(int k, pg8::Unit& u) const { return k == 0 ? S.next(i, u) : false; }
    DI void a_ready(const pg8::Unit&) const {}
    DI void done(const pg8::Unit&) const {}
    DI bool zero_after(const pg8::Unit&) const { return true; }
};
struct InOrderA {
    pg8::StaticOrder S;
    DI bool next(int i, pg8::Unit& u) const { if (!S.next(i, u)) return false; if (u.pn == 72) u.pn = 120; return true; }
    DI void a_ready(const pg8::Unit&) const {}
    DI void done(const pg8::Unit&) const {}
    DI bool zero_after(const pg8::Unit&) const { return true; }
};
struct InOrder8 {
    pg8::StaticOrder S;
    DI bool next(int i, pg8::Unit& u) const { if (!S.next(i, u)) return false; u.pn += 72; return true; }
    DI void a_ready(const pg8::Unit&) const {}
    DI void done(const pg8::Unit&) const {}
    DI bool zero_after(const pg8::Unit&) const { return true; }
};
struct BranchOrder {
    pg8::StaticOrder S;
    DI bool next(int i, pg8::Unit& u) const { const int t = i / 3; if (!S.next(t, u)) return false; u.ko = (i - 3 * t) * BW; return true; }
    DI void a_ready(const pg8::Unit&) const {}
    DI void done(const pg8::Unit&) const {}
    DI bool zero_after(const pg8::Unit& u) const { return u.ko == 2 * BW; }
};
struct FixedUnit {
    pg8::Unit u0;
    DI bool next(int k, pg8::Unit& u) const { u = u0; return k == 0; }
    DI void a_ready(const pg8::Unit&) const {}
    DI void done(const pg8::Unit&) const {}
    DI bool zero_after(const pg8::Unit&) const { return true; }
};
DI void team_barrier(unsigned* cnt, unsigned n) {
    asm volatile("s_waitcnt vmcnt(0)" ::: "memory");
    __syncthreads();
    if (threadIdx.x == 0) {
        __builtin_amdgcn_fence(__ATOMIC_RELEASE, "agent");
        asm volatile("s_waitcnt vmcnt(0)" ::: "memory");
        (void)xb_add(cnt, 1u);
        unsigned sp = 0u;
        while (xb_ld(cnt) < n) { __builtin_amdgcn_s_sleep(2); if (++sp > (1u << 20)) break; }
        __builtin_amdgcn_fence(__ATOMIC_ACQUIRE, "agent");
        asm volatile("s_waitcnt vmcnt(0)" ::: "memory");
    }
    __syncthreads();
}
DI void team_arrive(unsigned* cnt) {
    asm volatile("s_waitcnt vmcnt(0)" ::: "memory");
    __syncthreads();
    if (threadIdx.x == 0) { __builtin_amdgcn_fence(__ATOMIC_RELEASE, "agent"); asm volatile("s_waitcnt vmcnt(0)" ::: "memory"); (void)xb_add(cnt, 1u); }
}
DI void zero_acc(af4 (&acc)[2][2][4][2]) {
#pragma unroll
    for (int a = 0; a < 2; ++a)
#pragma unroll
        for (int b = 0; b < 2; ++b)
#pragma unroll
            for (int mm = 0; mm < 4; ++mm)
#pragma unroll
                for (int n = 0; n < 2; ++n) acc[a][b][mm][n] = (af4){0.f, 0.f, 0.f, 0.f};
}
template <class E> struct NoDrain : E { static constexpr bool AFTER_DRAIN = false; };
template <class Epi> DI void gemm_stream(LAS unsigned char* lds, const pg8::Gemm& g, const pg8::StaticOrder& S, const Epi& E) {
    af4 acc[2][2][4][2]; zero_acc(acc); const NoDrain<Epi> E2{E};
    pg8::gemm_phase<NoDrain<Epi>, pg8::StaticOrder, GEMM_ALIGN, GEMM_SP2>(lds, g, S, E2, acc);
}
template <class Epi> DI void gemm_units(LAS unsigned char* lds, const pg8::Gemm& g, const pg8::StaticOrder& S, const Epi& E) {
    pg8::Unit u;
    for (int i = 0; S.next(i, u); ++i) { af4 acc[2][2][4][2]; zero_acc(acc); OneUnit O{S, i}; pg8::gemm_phase<Epi, OneUnit, false, GEMM_SP2>(lds, g, O, E, acc); }
}
DI int win_src_col(int n) { return n < 16384 ? n : (n < 30720 ? n + 16 : (n < 30736 ? n - 30720 + 16384 : -1)); }
template <bool WIN> DI void tr_item(LAS unsigned char* lds, const float* W, int ldsrc, bf16* WT, size_t ldd, int k0, int n0, int dcol0, int lane) {
    const int n = n0 + 2 * lane;
    const int sc = WIN ? win_src_col(n) : n;
    const unsigned so = (unsigned)(sc >= 0 ? sc : 0);
    f32x2_t v[64];
#pragma unroll
    for (int i = 0; i < 64; ++i) { const float* rowp = W + (size_t)(k0 + i) * ldsrc; v[i] = *(const f32x2_t*)(rowp + so); }
    if (sc < 0) {
#pragma unroll
        for (int i = 0; i < 64; ++i) v[i] = (f32x2_t){0.f, 0.f};
    }
    LAS unsigned char* slab = lds + __builtin_amdgcn_readfirstlane((int)(threadIdx.x >> 6)) * 16384;
    LAS u32x4* w0 = (LAS u32x4*)(slab + lane * 256);
#pragma unroll
    for (int j = 0; j < 8; ++j) { u32x4 o; o.x = pk2(v[8 * j].x, v[8 * j + 1].x); o.y = pk2(v[8 * j + 2].x, v[8 * j + 3].x); o.z = pk2(v[8 * j + 4].x, v[8 * j + 5].x); o.w = pk2(v[8 * j + 6].x, v[8 * j + 7].x); w0[j] = o; }
#pragma unroll
    for (int j = 0; j < 8; ++j) { u32x4 o; o.x = pk2(v[8 * j].y, v[8 * j + 1].y); o.y = pk2(v[8 * j + 2].y, v[8 * j + 3].y); o.z = pk2(v[8 * j + 4].y, v[8 * j + 5].y); o.w = pk2(v[8 * j + 6].y, v[8 * j + 7].y); w0[8 + j] = o; }
    bf16* dst = WT + (size_t)(n0 + (lane >> 3)) * ldd + dcol0 + k0 + (lane & 7) * 8;
#pragma unroll
    for (int s_ = 0; s_ < 16; ++s_) { const u32x4 o = *(const LAS u32x4*)(slab + s_ * 1024 + lane * 16); *(u32x4*)(dst + (size_t)(8 * s_) * ldd) = o; }
}
DI void tr_item8(LAS unsigned char* lds, const float* W, int ldsrc, unsigned char* W8, int k0, int nl0, int lane) {
    const unsigned so = (unsigned)(18448 + nl0 + lane);
    float v[128];
#pragma unroll
    for (int i = 0; i < 128; ++i) { const float* rowp = W + (size_t)(k0 + i) * ldsrc; v[i] = rowp[so]; }
    LAS unsigned char* slab = lds + __builtin_amdgcn_readfirstlane((int)(threadIdx.x >> 6)) * 16384;
    LAS u32x4* w0 = (LAS u32x4*)(slab + lane * 128);
#pragma unroll
    for (int j = 0; j < 8; ++j) { u32x4 o; o.x = pk4f8(v[16 * j] * 64.f, v[16 * j + 1] * 64.f, v[16 * j + 2] * 64.f, v[16 * j + 3] * 64.f); o.y = pk4f8(v[16 * j + 4] * 64.f, v[16 * j + 5] * 64.f, v[16 * j + 6] * 64.f, v[16 * j + 7] * 64.f);
        o.z = pk4f8(v[16 * j + 8] * 64.f, v[16 * j + 9] * 64.f, v[16 * j + 10] * 64.f, v[16 * j + 11] * 64.f); o.w = pk4f8(v[16 * j + 12] * 64.f, v[16 * j + 13] * 64.f, v[16 * j + 14] * 64.f, v[16 * j + 15] * 64.f); w0[j] = o; }
    unsigned char* dst = W8 + (size_t)(nl0 + (lane >> 3)) * DM + k0 + (lane & 7) * 16;
#pragma unroll
    for (int s_ = 0; s_ < 8; ++s_) { const u32x4 o = *(const LAS u32x4*)(slab + s_ * 1024 + lane * 16); *(u32x4*)(dst + (size_t)(8 * s_) * DM) = o; }
}
constexpr int CV_INB = 64 * 146, CV_IN8 = 32 * 192, CV_IN = CV_INB + CV_IN8, CV_BR = 3 * 32 * 32, CV_OU = 64 * 32, CV_L = CV_IN + CV_BR + CV_OU;
#ifndef CVX_ITEMS
#define CVX_ITEMS 5000
#endif
constexpr int CVX = CVX_ITEMS;
DI void convert_items(LAS unsigned char* lds, const float* w_in, const float* w_branch, const float* w_out, unsigned char* ws, int l, int it0, int it1, int gw, int NGW, int lane) {
    for (int it = it0 + gw; it < it1; it += NGW) {
        int r = it;
        if (r < CV_INB) { const int kb = r / 146, nb = r % 146; const int n0 = nb < 144 ? nb * 128 : 30720 + (nb - 144) * 128;
            tr_item<true>(lds, w_in + (size_t)l * DM * 30736, 30736, (bf16*)(ws + WS_WIN + l * SZ_WIN), DM, kb * 64, n0, 0, lane); continue; }
        r -= CV_INB;
        if (r < CV_IN8) { const int kb = r / 192, nb = r % 192;
            tr_item8(lds, w_in + (size_t)l * DM * 30736, 30736, ws + WS_W8 + l * SZ_W8, kb * 128, nb * 64, lane); continue; }
        r -= CV_IN8;
        if (r < CV_BR) { const int n = r / (32 * 32), rr = r % (32 * 32), kb = rr / 32, nb = rr % 32;
            tr_item<false>(lds, w_branch + ((size_t)l * 3 + n) * BW * DM, DM, (bf16*)(ws + WS_WBR + l * SZ_WBR), KBR, kb * 64, nb * 128, n * BW, lane); continue; }
        r -= CV_BR;
        { const int kb = r / 32, nb = r % 32;
            tr_item<false>(lds, w_out + (size_t)l * DM * DM, DM, (bf16*)(ws + WS_WOU + l * SZ_WOU), DM, kb * 64, nb * 128, 0, lane); }
    }
}
DI void tail_convert(LAS unsigned char* lds, const float* w_in, const float* w_branch, const float* w_out, unsigned char* ws, int l, int it0, int it1, int nunits, int G, int bx, int wave, int lane_in) {
    int lane = lane_in; asm volatile("" : "+v"(lane));
    const int rounds = (nunits + G - 1) / G, busy = nunits - (rounds - 1) * G, idle = G - busy;
    if (idle > 0) { if (bx >= busy) convert_items(lds, w_in, w_branch, w_out, ws, l, it0, it1, (bx - busy) * NWAVES + wave, idle * NWAVES, lane); }
    else convert_items(lds, w_in, w_branch, w_out, ws, l, it0, it1, bx * NWAVES + wave, G * NWAVES, lane);
}
DI void norm_rows(const float* xp, const float* xs, const float* nw, bf16* Z, unsigned char* Z8, int gw, int NGW, int lane) {
    asm volatile("" : "+v"(lane), "+s"(gw));
    for (int m = gw; m < MT; m += NGW) {
        const f32x4* xr = (const f32x4*)(m < MP ? xp + (size_t)m * DM : xs + (size_t)(m - MP) * DM) + lane;
        f32x4 v[16]; float s = 0.f;
#pragma unroll
        for (int j = 0; j < 16; ++j) { v[j] = xr[64 * j]; s += (v[j].x * v[j].x + v[j].y * v[j].y) + (v[j].z * v[j].z + v[j].w * v[j].w); }
        f32x4 wq[16];
#pragma unroll
        for (int j = 0; j < 16; ++j) wq[j] = ((const f32x4*)nw)[lane + 64 * j];
        const float rstd = 1.0f / sqrtf(wave_sum(s) * (1.0f / DM) + EPS);
        u32x2* o8 = (u32x2*)(Z + (size_t)m * DM) + lane; unsigned* q8 = (unsigned*)(Z8 + (size_t)m * DM) + lane;
#pragma unroll
        for (int j = 0; j < 16; ++j) { const f32x4 w4 = wq[j]; const float z0 = v[j].x * rstd * w4.x, z1 = v[j].y * rstd * w4.y, z2 = v[j].z * rstd * w4.z, z3 = v[j].w * rstd * w4.w;
            u32x2 o; o.x = pk2(z0, z1); o.y = pk2(z2, z3); o8[64 * j] = o; q8[64 * j] = pk4f8(z0, z1, z2, z3); }
    }
}
DI void sum_slabs_rows(const float* PB, bf16* MB, int gw, int NGW, int lane) {
    asm volatile("" : "+v"(lane), "+s"(gw));
    for (int h = gw; h < 512; h += NGW) {
        const int r = h >> 1, j0 = (h & 1) * 8;
        const f32x4* a = (const f32x4*)(PB + (size_t)r * DM) + lane + 64 * j0; const f32x4* b = a + (size_t)256 * DM / 4; const f32x4* c = b + (size_t)256 * DM / 4;
        u32x2* o8 = (u32x2*)(MB + (size_t)(MP + r) * DM) + lane + 64 * j0;
        f32x4 va[8], vb[8], vc[8];
#pragma unroll
        for (int j = 0; j < 8; ++j) { va[j] = a[64 * j]; vb[j] = b[64 * j]; vc[j] = c[64 * j]; }
#pragma unroll
        for (int j = 0; j < 8; ++j) { const f32x4 v = (va[j] + vb[j]) + vc[j]; u32x2 o; o.x = pk2(v.x, v.y); o.y = pk2(v.z, v.w); o8[64 * j] = o; }
    }
}
template <bool XB, bool YB> DI void final_rows(const void* xp_, const void* xs_, const bf16* OUT, const float* PO, const float* npost, void* ydst_, const float* npre_next, bf16* Z, unsigned char* Z8, int gw, int NGW, int lane) {
    asm volatile("" : "+v"(lane), "+s"(gw));
    for (int m = gw; m < MT; m += NGW) {
        const f32x4* xr = (const f32x4*)(m < MP ? (const float*)xp_ + (size_t)m * DM : (const float*)xs_ + (size_t)(m - MP) * DM) + lane;
        const u32x2* xrb = (const u32x2*)(m < MP ? (const bf16*)xp_ + (size_t)m * DM : (const bf16*)xs_ + (size_t)(m - MP) * DM) + lane;
        f32x4 v[16]; float s = 0.f;
        if (PO && m >= MP) { typedef const __attribute__((address_space(1))) f32x4* gp4;
            gp4 p0 = (gp4)(PO + (size_t)(m - MP) * DM) + lane; gp4 p1 = p0 + (size_t)256 * DM / 4; gp4 p2 = p1 + (size_t)256 * DM / 4; gp4 p3 = p2 + (size_t)256 * DM / 4;
#pragma unroll
            for (int jb = 0; jb < 16; jb += 4) { f32x4 t0[4], t1[4], t2[4], t3[4];
#pragma unroll
                for (int jj = 0; jj < 4; ++jj) { t0[jj] = p0[64 * (jb + jj)]; t1[jj] = p1[64 * (jb + jj)]; t2[jj] = p2[64 * (jb + jj)]; t3[jj] = p3[64 * (jb + jj)]; }
#pragma unroll
                for (int jj = 0; jj < 4; ++jj) v[jb + jj] = (t0[jj] + t1[jj]) + (t2[jj] + t3[jj]); } }
        else { const u32x2* orow = (const u32x2*)(OUT + (size_t)m * DM) + lane;
#pragma unroll
            for (int j = 0; j < 16; ++j) { const u32x2 ov = orow[64 * j]; v[j] = (f32x4){bflo(ov.x), bfhi(ov.x), bflo(ov.y), bfhi(ov.y)}; } }
        f32x4 xq[XB ? 1 : 16]; u32x2 xqb[XB ? 16 : 1];
#pragma unroll
        for (int j = 0; j < 16; ++j) { if constexpr (XB) xqb[j] = xrb[64 * j]; else xq[j] = xr[64 * j]; }
#pragma unroll
        for (int j = 0; j < 16; ++j) s += (v[j].x * v[j].x + v[j].y * v[j].y) + (v[j].z * v[j].z + v[j].w * v[j].w);
        const float rstd = 1.0f / sqrtf(wave_sum(s) * (1.0f / DM) + EPS);
        f32x4* yo = (f32x4*)((float*)ydst_ + (size_t)m * DM) + lane; u32x2* yob = (u32x2*)((bf16*)ydst_ + (size_t)m * DM) + lane; float s2 = 0.f;
        f32x4 wq[4];
#pragma unroll
        for (int j = 0; j < 16; ++j) {
            if ((j & 3) == 0) { _Pragma("unroll") for (int jj = 0; jj < 4; ++jj) wq[jj] = ((const f32x4*)npost)[lane + 64 * (j + jj)]; }
            const f32x4 w4 = wq[j & 3]; f32x4 x4;
            if constexpr (XB) { const u32x2 xb = xqb[j]; x4 = (f32x4){bflo(xb.x), bfhi(xb.x), bflo(xb.y), bfhi(xb.y)}; } else x4 = xq[j];
            v[j] = x4 + v[j] * rstd * w4;
            if constexpr (YB) { u32x2 yb; yb.x = pk2(v[j].x, v[j].y); yb.y = pk2(v[j].z, v[j].w); yob[64 * j] = yb; } else yo[64 * j] = v[j];
            s2 += (v[j].x * v[j].x + v[j].y * v[j].y) + (v[j].z * v[j].z + v[j].w * v[j].w); }
        if (Z) {
            const float r2 = 1.0f / sqrtf(wave_sum(s2) * (1.0f / DM) + EPS);
            u32x2* o8 = (u32x2*)(Z + (size_t)m * DM) + lane; unsigned* q8 = (unsigned*)(Z8 + (size_t)m * DM) + lane;
#pragma unroll
            for (int j = 0; j < 16; ++j) {
                if ((j & 3) == 0) { _Pragma("unroll") for (int jj = 0; jj < 4; ++jj) wq[jj] = ((const f32x4*)npre_next)[lane + 64 * (j + jj)]; }
                const f32x4 w4 = wq[j & 3]; const float z0 = v[j].x * r2 * w4.x, z1 = v[j].y * r2 * w4.y, z2 = v[j].z * r2 * w4.z, z3 = v[j].w * r2 * w4.w;
                u32x2 o; o.x = pk2(z0, z1); o.y = pk2(z2, z3); o8[64 * j] = o; q8[64 * j] = pk4f8(z0, z1, z2, z3); }
        }
    }
}
DI void mix_fix_rows(const bf16* OA, const float* SSQ, const float* hnw, const bf16* HGATE, const float* gnw, const bf16* CGATE, bf16* Y, int m0, int m1, int gw, int NGW, int lane) {
    asm volatile("" : "+v"(lane), "+s"(gw));
    for (int m = m0 + gw; m < m1; m += NGW) {
        const f32x4* sq = (const f32x4*)(SSQ + (size_t)m * 32);
        float rs[4];
#pragma unroll
        for (int h = 0; h < 4; ++h) { const f32x4 s = sq[4 + h]; rs[h] = 1.0f / sqrtf(((s.x + s.y) + (s.z + s.w)) * (1.0f / 512.0f) + EPS); }
#pragma unroll
        for (int j = 0; j < 8; ++j) { const int col = 4 * (lane + 64 * j);
            const u32x2 ob = *(const u32x2*)(OA + (size_t)m * (2 * BW) + BW + col); const f32x4 o = (f32x4){bflo(ob.x), bfhi(ob.x), bflo(ob.y), bfhi(ob.y)}, w4 = *(const f32x4*)(gnw + col); const u32x2 g = *(const u32x2*)(CGATE + (size_t)m * BW + col);
            const float r = rs[j >> 1]; u32x2 y; y.x = pk2(o.x * r * w4.x * bflo(g.x), o.y * r * w4.y * bfhi(g.x)); y.y = pk2(o.z * r * w4.z * bflo(g.y), o.w * r * w4.w * bfhi(g.y));
            *(u32x2*)(Y + (size_t)m * KBR + 2 * BW + col) = y; }
    }
}
DI void gl_rows(const float* CLR, const float* w2, const float* b2, float* GL, int bx, int G, int tid_in) {
    int tid = tid_in; asm volatile("" : "+v"(tid));
    float wa[16], wb[16];
#pragma unroll
    for (int r = 0; r < 16; ++r) { wa[r] = w2[r * 1024 + tid]; wb[r] = w2[r * 1024 + 512 + tid]; }
    const float ba = b2[tid], bb = b2[512 + tid];
    for (int m = bx; m < MT; m += G) {
        const f32x4* cp = (const f32x4*)(CLR + (size_t)m * 16); float xa = ba, xb = bb;
#pragma unroll
        for (int q = 0; q < 4; ++q) { const f32x4 cv = cp[q];
            xa += cv.x * wa[4 * q] + cv.y * wa[4 * q + 1] + cv.z * wa[4 * q + 2] + cv.w * wa[4 * q + 3];
            xb += cv.x * wb[4 * q] + cv.y * wb[4 * q + 1] + cv.z * wb[4 * q + 2] + cv.w * wb[4 * q + 3]; }
        GL[(size_t)m * 1024 + tid] = -(fmaxf(-xa, 0.f) + __logf(1.0f + __expf(-fabsf(xa)))) * 0.0625f;
        GL[(size_t)m * 1024 + 512 + tid] = -(fmaxf(-xb, 0.f) + __logf(1.0f + __expf(-fabsf(xb)))) * 0.0625f;
    }
}

template <int DK> struct SL {
    static constexpr int QS = (DK + 8) * 2;
    static constexpr int KHS = 72 * 2;
    static constexpr int VS = 136 * 2;
    static constexpr int QT = 0, KT = QT + 64 * QS, KH = KT + 64 * QS, VT = KH + DK * KHS, PP = VT + 64 * VS;
    static constexpr int PTOT = PP + 64 * KHS, ER = PTOT + 2048, EBL = ER + DK * 4, SSQ = EBL + DK * 4, END = SSQ + 2048;
};
static_assert(SL<256>::END <= MISC_OFF, "scan LDS map");
struct LaArgs {
    const bf16* Q; int ldq;
    const float* G; int ldg;
    const bf16* K;
    const bf16* V;
    int row0, T;
    const float* S0; float* S1; int lds;
    const float* nw; const bf16* gate; bf16* Y;
};
template <int DK, bool GLA>
DI void la_job(LAS unsigned char* lds, const int tid_in, const LaArgs& A) {
    int tid = tid_in; asm volatile("" : "+v"(tid));
    typedef SL<DK> L;
    constexpr int NPART = 512 / DK, TPT = 64 / NPART, NDKT = DK / 16, NKS = DK / 32, NQ = DK / 64;
    const int lane = tid & 63, w = __builtin_amdgcn_readfirstlane(tid >> 6), fr = lane & 15, fq = lane >> 4;
    const int d = tid % DK, part = __builtin_amdgcn_readfirstlane(tid / DK);
    f32x4 S[NDKT];
#pragma unroll
    for (int k = 0; k < NDKT; ++k) {
        if (A.S0) {
#pragma unroll
            for (int j = 0; j < 4; ++j) S[k][j] = A.S0[(size_t)(16 * k + 4 * fq + j) * A.lds + 16 * w + fr];
        } else S[k] = (f32x4){0.f, 0.f, 0.f, 0.f};
    }
    const int nchunk = (A.T + 63) >> 6;
    const f32x4 nw4 = *(const f32x4*)(A.nw + 16 * w + 4 * fq);
    u32x4 pq[NQ], pk[NQ], pv[2]; float pg[TPT];
    constexpr int RPI = 512 / (DK / 8);
    const int tq = tid / (DK / 8), cq = tid % (DK / 8), tv = tid >> 4, cv = tid & 15;
    int b_q = L::QT + fr * L::QS + 16 * fq, b_q4 = L::QT + fr * L::QS + 8 * fq, b_k = L::KT + fr * L::QS + 16 * fq, b_kh = L::KH + fr * L::KHS + 16 * fq, b_p = L::PP + fr * L::KHS + 16 * fq, b_e = 16 * fq;
    asm volatile("" : "+v"(b_q), "+v"(b_q4), "+v"(b_k), "+v"(b_kh), "+v"(b_p), "+v"(b_e));
    const unsigned qoff = (unsigned)(tq * A.ldq + cq * 8), koff = (unsigned)(tq * 1024 + cq * 8), voff = (unsigned)(tv * BW + cv * 8);
#define LA_PREFETCH(cc) do { int t0_ = (cc) * 64; asm volatile("" : "+s"(t0_)); const size_t rowc_ = (size_t)A.row0 + t0_; const int nval_ = (A.T - t0_) < 64 ? (A.T - t0_) : 64; \
        _Pragma("unroll") for (int i_ = 0; i_ < NQ; ++i_) { const bf16* qb_ = A.Q + (rowc_ + RPI * i_) * A.ldq; \
            pq[i_] = (u32x4){0u, 0u, 0u, 0u}; if (tq + RPI * i_ < nval_) pq[i_] = *(const u32x4*)(qb_ + qoff); \
            } \
        _Pragma("unroll") for (int i_ = 0; i_ < 2; ++i_) { const bf16* vb_ = A.V + (rowc_ + 32 * i_) * BW; \
            pv[i_] = (u32x4){0u, 0u, 0u, 0u}; if (tv + 32 * i_ < nval_) pv[i_] = *(const u32x4*)(vb_ + voff); } \
        } while (0)
#define LA_LOAD_G(rowc_, nval_) do { _Pragma("unroll") for (int i_ = 0; i_ < TPT; ++i_) { const int t_ = part * TPT + i_; const float* gb_ = A.G + ((rowc_) + t_) * A.ldg; pg[i_] = (t_ < (nval_)) ? gb_[d] : 0.f; } } while (0)
#define LA_PREFETCH_G(cc) do { int t0_ = (cc) * 64; asm volatile("" : "+s"(t0_)); const size_t rowc_ = (size_t)A.row0 + t0_; const int nval_ = (A.T - t0_) < 64 ? (A.T - t0_) : 64; \
        if constexpr (GLA) { _Pragma("unroll") for (int i_ = 0; i_ < NQ; ++i_) { const bf16* kb_ = A.K + (rowc_ + RPI * i_) * 1024; pk[i_] = (u32x4){0u, 0u, 0u, 0u}; if (tq + RPI * i_ < nval_) pk[i_] = *(const u32x4*)(kb_ + koff); } } \
        if constexpr (!GLA) { LA_LOAD_G(rowc_, nval_); } } while (0)
    LA_PREFETCH(0); LA_PREFETCH_G(0);
    for (int c = 0; c < nchunk; ++c) {
        const int t0 = c * 64; const size_t rowc = (size_t)A.row0 + t0; const int nval = (A.T - t0) < 64 ? (A.T - t0) : 64;
        if constexpr (GLA) { LA_LOAD_G(rowc, nval); }
#pragma unroll
        for (int i = 0; i < NQ; ++i) { *(LAS u32x4*)(lds + L::QT + (tq + RPI * i) * L::QS + cq * 16) = pq[i];
            if constexpr (GLA) *(LAS u32x4*)(lds + L::KT + (tq + RPI * i) * L::QS + cq * 16) = pk[i]; }
#pragma unroll
        for (int i = 0; i < 2; ++i) *(LAS u32x4*)(lds + L::VT + (tv + 32 * i) * L::VS + cv * 16) = pv[i];
        float g[TPT];
        { float run = 0.f;
#pragma unroll
            for (int i = 0; i < TPT; ++i) { g[i] = pg[i]; run += g[i]; }
            *(LAS float*)(lds + L::PTOT + (part * DK + d) * 4) = run; }
        __syncthreads();
        float pre = 0.f, tot = 0.f, rr = 0.f;
#pragma unroll
        for (int p = 0; p < NPART; ++p) { const float v = *(const LAS float*)(lds + L::PTOT + (p * DK + d) * 4); pre += (p < part) ? v : 0.f; tot += v; rr += (p < NPART / 2) ? v : 0.f; }
        {
            float bb = pre; const float etr = __expf(tot - rr);
#pragma unroll
            for (int i8 = 0; i8 < TPT / 8; ++i8) { float kh[8];
#pragma unroll
                for (int ii = 0; ii < 8; ++ii) { const int i = 8 * i8 + ii; const int t = part * TPT + i; bb += g[i];
                    LAS bf16* qp = (LAS bf16*)(lds + L::QT + t * L::QS + d * 2); LAS bf16* kp = (LAS bf16*)(lds + L::KT + t * L::QS + d * 2);
                    const float qr = bf2f(*qp); float kr;
                    if constexpr (GLA) kr = bf2f(*kp); else kr = 1.0f - __expf(g[i]);
                    const float e1 = __expf(bb - rr), e2 = __expf(rr - bb);
                    *qp = f2bf(qr * e1); const float kt = kr * e2; *kp = f2bf(kt); kh[ii] = kt * etr; }
                u32x4 o; o.x = pk2(kh[0], kh[1]); o.y = pk2(kh[2], kh[3]); o.z = pk2(kh[4], kh[5]); o.w = pk2(kh[6], kh[7]);
                *(LAS u32x4*)(lds + L::KH + d * L::KHS + (part * TPT + 8 * i8) * 2) = o;
                asm volatile("" ::: "memory"); }
            if (part == 0) { *(LAS float*)(lds + L::ER + d * 4) = __expf(rr); *(LAS float*)(lds + L::EBL + d * 4) = __expf(tot); }
        }
        __syncthreads();
        if (c + 1 < nchunk) LA_PREFETCH(c + 1);
        bf16x8 Vf[2];
#pragma unroll
        for (int ks = 0; ks < 2; ++ks) {
            const bf16x4 lo = __builtin_amdgcn_ds_read_tr16_b64_v4i16((LAS bf16x4*)(lds + L::VT + (32 * ks + 8 * fq + (fr >> 2)) * L::VS + (16 * w + 4 * (fr & 3)) * 2));
            const bf16x4 hi = __builtin_amdgcn_ds_read_tr16_b64_v4i16((LAS bf16x4*)(lds + L::VT + (32 * ks + 8 * fq + 4 + (fr >> 2)) * L::VS + (16 * w + 4 * (fr & 3)) * 2));
            Vf[ks] = (bf16x8){lo[0], lo[1], lo[2], lo[3], hi[0], hi[1], hi[2], hi[3]}; }
        { const int ti = w >> 1; const int pk_base = b_k + ((w & 1) * 2) * 16 * L::QS, pq_base = b_q + ti * 16 * L::QS;
#pragma unroll
            for (int sj = 0; sj < 2; ++sj) { const int si = (w & 1) * 2 + sj; f32x4 acc = (f32x4){0.f, 0.f, 0.f, 0.f};
                if (si <= ti) {
#pragma unroll
                    for (int ks = 0; ks < NKS; ++ks) { const bf16x8 a = *(const LAS bf16x8*)(lds + pk_base + sj * 16 * L::QS + ks * 64);
                        const bf16x8 bq = *(const LAS bf16x8*)(lds + pq_base + ks * 64); acc = MFMA16(a, bq, acc); } }
                const int t = 16 * ti + fr, s0 = 16 * si + 4 * fq;
#pragma unroll
                for (int j = 0; j < 4; ++j) if (s0 + j > t) acc[j] = 0.f;
                u32x2 pw; pw.x = pk2(acc[0], acc[1]); pw.y = pk2(acc[2], acc[3]);
                *(LAS u32x2*)(lds + L::PP + t * L::KHS + s0 * 2) = pw; } }
        f32x4 O[4];
#pragma unroll
        for (int ti = 0; ti < 4; ++ti) O[ti] = (f32x4){0.f, 0.f, 0.f, 0.f};
#pragma unroll
        for (int p = 0; p < NKS; ++p) { const f32x4 ea = *(const LAS f32x4*)(lds + b_e + L::ER + 128 * p), eb = *(const LAS f32x4*)(lds + b_e + L::ER + 128 * p + 64);
            u32x4 o; o.x = pk2(S[2 * p][0] * ea[0], S[2 * p][1] * ea[1]); o.y = pk2(S[2 * p][2] * ea[2], S[2 * p][3] * ea[3]);
            o.z = pk2(S[2 * p + 1][0] * eb[0], S[2 * p + 1][1] * eb[1]); o.w = pk2(S[2 * p + 1][2] * eb[2], S[2 * p + 1][3] * eb[3]); const bf16x8 Sf = __builtin_bit_cast(bf16x8, o);
#pragma unroll
            for (int ti = 0; ti < 4; ++ti) { const u32x2 q0 = *(const LAS u32x2*)(lds + b_q4 + ti * 16 * L::QS + 64 * p), q1 = *(const LAS u32x2*)(lds + b_q4 + ti * 16 * L::QS + 64 * p + 32);
                u32x4 qq; qq.x = q0.x; qq.y = q0.y; qq.z = q1.x; qq.w = q1.y; O[ti] = MFMA16(Sf, __builtin_bit_cast(bf16x8, qq), O[ti]); }
            }
        __syncthreads();
        u32x2 gt[4];
#pragma unroll
        for (int ti = 0; ti < 4; ++ti) { f32x4 acc = O[ti];
#pragma unroll
            for (int ks = 0; ks < 2; ++ks) { const bf16x8 bp = *(const LAS bf16x8*)(lds + b_p + ti * 16 * L::KHS + ks * 64); acc = MFMA16(Vf[ks], bp, acc); }
            O[ti] = acc;
            const int t = 16 * ti + fr;
            gt[ti] = (u32x2){0u, 0u}; if (t < nval) gt[ti] = *(const u32x2*)(A.gate + (rowc + t) * BW + 16 * w + 4 * fq);
            float s = (acc[0] * acc[0] + acc[1] * acc[1]) + (acc[2] * acc[2] + acc[3] * acc[3]); s += __shfl_xor(s, 16); s += __shfl_xor(s, 32);
            if (fq == 0) *(LAS float*)(lds + L::SSQ + (t * 8 + w) * 4) = s; }
        if (c + 1 < nchunk) LA_PREFETCH_G(c + 1);
#pragma unroll
        for (int k = 0; k < NDKT; ++k) { const f32x4 e = *(const LAS f32x4*)(lds + b_e + L::EBL + 64 * k); f32x4 acc = S[k] * e;
#pragma unroll
            for (int ks = 0; ks < 2; ++ks) { const bf16x8 a = *(const LAS bf16x8*)(lds + b_kh + k * 16 * L::KHS + ks * 64); acc = MFMA16(a, Vf[ks], acc); }
            S[k] = acc; }
        __syncthreads();
#pragma unroll
        for (int ti = 0; ti < 4; ++ti) { const int t = 16 * ti + fr;
            const f32x4 sa = *(const LAS f32x4*)(lds + L::SSQ + t * 32), sb = *(const LAS f32x4*)(lds + L::SSQ + t * 32 + 16);
            const float r = 1.0f / sqrtf((((sa.x + sa.y) + (sa.z + sa.w)) + ((sb.x + sb.y) + (sb.z + sb.w))) * (1.0f / 128.0f) + EPS);
            const f32x4 o = O[ti]; u32x2 y; y.x = pk2(o[0] * r * nw4[0] * bflo(gt[ti].x), o[1] * r * nw4[1] * bfhi(gt[ti].x)); y.y = pk2(o[2] * r * nw4[2] * bflo(gt[ti].y), o[3] * r * nw4[3] * bfhi(gt[ti].y));
            if (t < nval) *(u32x2*)(A.Y + (rowc + t) * KBR + 16 * w + 4 * fq) = y; }
    }
#undef LA_PREFETCH
#undef LA_PREFETCH_G
#undef LA_LOAD_G
#pragma unroll
    for (int k = 0; k < NDKT; ++k)
#pragma unroll
        for (int j = 0; j < 4; ++j) A.S1[(size_t)(16 * k + 4 * fq + j) * A.lds + 16 * w + fr] = S[k][j];
}

struct GPrep { const bf16* CQ; const bf16* CK; const float* CLR; const float* w2; const float* b2; bf16* QT; bf16* KT; bf16* KH; float* ER; float* EB; };
DI void gla_prep(LAS unsigned char* lds, const int tid_in, const GPrep& P, const int ci, const int hh) {
    int tid = tid_in; asm volatile("" : "+v"(tid));
    const int d = tid & 255, part = __builtin_amdgcn_readfirstlane(tid >> 8);
    const int row0 = ci < 128 ? ci * 64 : MP + (ci - 128) * 32, nval = ci < 128 ? 64 : 32;
    const int ch = hh * 256 + d;
    LAS float* ptot = (LAS float*)lds; LAS float* clrs = (LAS float*)(lds + 4096);
    if (tid < 256) { const int t = tid >> 2, q4 = tid & 3; f32x4 v = (f32x4){0.f, 0.f, 0.f, 0.f}; if (t < nval) v = *(const f32x4*)(P.CLR + ((size_t)row0 + t) * 16 + q4 * 4);
        *(LAS f32x4*)(clrs + t * 16 + q4 * 4) = v; }
    float w2r[16];
#pragma unroll
    for (int r = 0; r < 16; ++r) w2r[r] = P.w2[r * 1024 + ch];
    const float b2v = P.b2[ch];
    unsigned qk[32];
    { const bf16* qi = P.CQ + (size_t)row0 * 1024 + ch; const bf16* ki = P.CK + (size_t)row0 * 1024 + ch;
#pragma unroll
      for (int i = 0; i < 32; ++i) { const int t = part * 32 + i; const int tc = t < nval ? t : 0; const unsigned qv = qi[(size_t)tc * 1024], kv = ki[(size_t)tc * 1024]; qk[i] = (t < nval) ? (qv | (kv << 16)) : 0u; } }
    __syncthreads();
    float g[32]; float run = 0.f;
#pragma unroll
    for (int i = 0; i < 32; ++i) { const int t = part * 32 + i; const LAS f32x4* cp = (const LAS f32x4*)(clrs + t * 16);
        float x = b2v;
#pragma unroll
        for (int q = 0; q < 4; ++q) { const f32x4 cv = cp[q]; x += cv.x * w2r[4 * q] + cv.y * w2r[4 * q + 1] + cv.z * w2r[4 * q + 2] + cv.w * w2r[4 * q + 3]; }
        const float ls = -(fmaxf(-x, 0.f) + __logf(1.0f + __expf(-fabsf(x))));
        g[i] = (t < nval) ? ls * 0.0625f : 0.f; run += g[i]; }
    ptot[part * 256 + d] = run;
    __syncthreads();
    const float p0 = ptot[d], p1 = ptot[256 + d];
    const float rr = p0, tot = p0 + p1, etr = __expf(tot - rr);
    float bb = part ? p0 : 0.f;
    bf16* qo = P.QT + (size_t)row0 * 1024 + ch; bf16* ko = P.KT + (size_t)row0 * 1024 + ch;
    u32x4* kho = (u32x4*)(P.KH + ((size_t)ci * 1024 + ch) * 64 + part * 32);
#pragma unroll
    for (int i8 = 0; i8 < 4; ++i8) { float kh[8];
#pragma unroll
        for (int ii = 0; ii < 8; ++ii) { const int i = 8 * i8 + ii; const int t = part * 32 + i; bb += g[i];
            const float qr = bflo(qk[i]), kr = bfhi(qk[i]);
            const float e1 = __expf(bb - rr), e2 = __expf(rr - bb); const float kt = kr * e2;
            if (t < nval) { qo[(size_t)t * 1024] = f2bf(qr * e1); ko[(size_t)t * 1024] = f2bf(kt); }
            kh[ii] = kt * etr; }
        u32x4 o; o.x = pk2(kh[0], kh[1]); o.y = pk2(kh[2], kh[3]); o.z = pk2(kh[4], kh[5]); o.w = pk2(kh[6], kh[7]); kho[i8] = o; }
    if (part == 0) { P.ER[(size_t)ci * 1024 + ch] = __expf(rr); P.EB[(size_t)ci * 1024 + ch] = __expf(tot); }
    __syncthreads();
}
struct GArgs { const bf16* QT; const bf16* KT; const bf16* KH; const float* ER; const float* EB; const bf16* V; int ci0, row0, T; const float* S0; float* S1; int lds; bf16* OA; float* SSQ; };
DI void gla_job(LAS unsigned char* lds, const int tid_in, const GArgs& A) {
    int tid = tid_in; asm volatile("" : "+v"(tid));
    typedef SL<256> L;
    constexpr int NDKT = 16, NKS = 8;
    const int lane = tid & 63, w = __builtin_amdgcn_readfirstlane(tid >> 6), fr = lane & 15, fq = lane >> 4;
    f32x4 S[NDKT];
#pragma unroll
    for (int k = 0; k < NDKT; ++k) {
        if (A.S0) {
#pragma unroll
            for (int j = 0; j < 4; ++j) S[k][j] = A.S0[(size_t)(16 * k + 4 * fq + j) * A.lds + 16 * w + fr];
        } else S[k] = (f32x4){0.f, 0.f, 0.f, 0.f};
    }
    const int nchunk = (A.T + 63) >> 6;
    u32x4 pq[4], pk[4], ph[4], pv[2]; f32x4 pe = (f32x4){0.f, 0.f, 0.f, 0.f};
    int b_q = L::QT + fr * L::QS + 16 * fq, b_q4 = L::QT + fr * L::QS + 8 * fq, b_k = L::KT + fr * L::QS + 16 * fq, b_kh = L::KH + fr * L::KHS + 16 * fq, b_p = L::PP + fr * L::KHS + 16 * fq, b_e = 16 * fq;
    asm volatile("" : "+v"(b_q), "+v"(b_q4), "+v"(b_k), "+v"(b_kh), "+v"(b_p), "+v"(b_e));
#define G_IDX() int t_ = tid; asm volatile("" : "+v"(t_)); const int tq = t_ >> 5, cq = t_ & 31, tv = t_ >> 4, cv = t_ & 15, th = t_ >> 3, chh = t_ & 7; \
        const unsigned qoff = (unsigned)(tq * 1024 + cq * 8), voff = (unsigned)(tv * BW + cv * 8), hoff = (unsigned)(th * 64 + chh * 8); (void)tq; (void)cq; (void)tv; (void)cv; (void)th; (void)chh; (void)qoff; (void)voff; (void)hoff
#define G_LOAD_QK(cc) do { G_IDX(); int c_ = (cc); asm volatile("" : "+s"(c_)); const size_t rowc_ = (size_t)A.row0 + c_ * 64; const int nval_ = (A.T - c_ * 64) < 64 ? (A.T - c_ * 64) : 64; \
        _Pragma("unroll") for (int i_ = 0; i_ < 4; ++i_) { const bf16* qb_ = A.QT + (rowc_ + 16 * i_) * 1024; const bf16* kb_ = A.KT + (rowc_ + 16 * i_) * 1024; \
            pq[i_] = (u32x4){0u, 0u, 0u, 0u}; pk[i_] = (u32x4){0u, 0u, 0u, 0u}; if (tq + 16 * i_ < nval_) { pq[i_] = *(const u32x4*)(qb_ + qoff); pk[i_] = *(const u32x4*)(kb_ + qoff); } } } while (0)
#define G_LOAD_HV(cc) do { G_IDX(); int c_ = (cc); asm volatile("" : "+s"(c_)); const size_t rowc_ = (size_t)A.row0 + c_ * 64; const int nval_ = (A.T - c_ * 64) < 64 ? (A.T - c_ * 64) : 64; \
        _Pragma("unroll") for (int i_ = 0; i_ < 4; ++i_) { const bf16* hb_ = A.KH + ((size_t)(A.ci0 + c_) * 1024 + 64 * i_) * 64; ph[i_] = *(const u32x4*)(hb_ + hoff); } \
        _Pragma("unroll") for (int i_ = 0; i_ < 2; ++i_) { const bf16* vb_ = A.V + (rowc_ + 32 * i_) * BW; pv[i_] = (u32x4){0u, 0u, 0u, 0u}; if (tv + 32 * i_ < nval_) pv[i_] = *(const u32x4*)(vb_ + voff); } \
        if (tid < 128) { const float* eb_ = (tid < 64 ? A.ER : A.EB) + (size_t)(A.ci0 + c_) * 1024; pe = *(const f32x4*)(eb_ + 4 * (tid & 63)); } } while (0)
#define G_LAND_QK() do { G_IDX(); _Pragma("unroll") for (int i_ = 0; i_ < 4; ++i_) { *(LAS u32x4*)(lds + L::QT + (tq + 16 * i_) * L::QS + cq * 16) = pq[i_]; *(LAS u32x4*)(lds + L::KT + (tq + 16 * i_) * L::QS + cq * 16) = pk[i_]; } } while (0)
#define G_LAND_HV() do { G_IDX(); _Pragma("unroll") for (int i_ = 0; i_ < 4; ++i_) *(LAS u32x4*)(lds + L::KH + (th + 64 * i_) * L::KHS + chh * 16) = ph[i_]; \
        _Pragma("unroll") for (int i_ = 0; i_ < 2; ++i_) *(LAS u32x4*)(lds + L::VT + (tv + 32 * i_) * L::VS + cv * 16) = pv[i_]; \
        if (tid < 128) *(LAS f32x4*)(lds + L::ER + 16 * tid) = pe; } while (0)
    G_LOAD_QK(0); G_LOAD_HV(0); G_LAND_QK();
    for (int c = 0; c < nchunk; ++c) {
        const int t0 = c * 64; const size_t rowc = (size_t)A.row0 + t0; const int nval = (A.T - t0) < 64 ? (A.T - t0) : 64;
        G_LAND_HV();
        __syncthreads();
        if (c + 1 < nchunk) G_LOAD_QK(c + 1);
        bf16x8 Vf[2];
#pragma unroll
        for (int ks = 0; ks < 2; ++ks) {
            const bf16x4 lo = __builtin_amdgcn_ds_read_tr16_b64_v4i16((LAS bf16x4*)(lds + L::VT + (32 * ks + 8 * fq + (fr >> 2)) * L::VS + (16 * w + 4 * (fr & 3)) * 2));
            const bf16x4 hi = __builtin_amdgcn_ds_read_tr16_b64_v4i16((LAS bf16x4*)(lds + L::VT + (32 * ks + 8 * fq + 4 + (fr >> 2)) * L::VS + (16 * w + 4 * (fr & 3)) * 2));
            Vf[ks] = (bf16x8){lo[0], lo[1], lo[2], lo[3], hi[0], hi[1], hi[2], hi[3]}; }
        { const int ti = w >> 1; const int pk_base = b_k + ((w & 1) * 2) * 16 * L::QS, pq_base = b_q + ti * 16 * L::QS;
#pragma unroll
            for (int sj = 0; sj < 2; ++sj) { const int si = (w & 1) * 2 + sj; f32x4 acc = (f32x4){0.f, 0.f, 0.f, 0.f};
                if (si <= ti) {
#pragma unroll
                    for (int ks = 0; ks < NKS; ++ks) { const bf16x8 a = *(const LAS bf16x8*)(lds + pk_base + sj * 16 * L::QS + ks * 64);
                        const bf16x8 bq = *(const LAS bf16x8*)(lds + pq_base + ks * 64); acc = MFMA16(a, bq, acc); } }
                const int t = 16 * ti + fr, s0 = 16 * si + 4 * fq;
#pragma unroll
                for (int j = 0; j < 4; ++j) if (s0 + j > t) acc[j] = 0.f;
                u32x2 pw; pw.x = pk2(acc[0], acc[1]); pw.y = pk2(acc[2], acc[3]);
                *(LAS u32x2*)(lds + L::PP + t * L::KHS + s0 * 2) = pw; } }
        f32x4 O[4];
#pragma unroll
        for (int ti = 0; ti < 4; ++ti) O[ti] = (f32x4){0.f, 0.f, 0.f, 0.f};
#pragma unroll
        for (int p = 0; p < NKS; ++p) { const f32x4 ea = *(const LAS f32x4*)(lds + b_e + L::ER + 128 * p), eb = *(const LAS f32x4*)(lds + b_e + L::ER + 128 * p + 64);
            u32x4 o; o.x = pk2(S[2 * p][0] * ea[0], S[2 * p][1] * ea[1]); o.y = pk2(S[2 * p][2] * ea[2], S[2 * p][3] * ea[3]);
            o.z = pk2(S[2 * p + 1][0] * eb[0], S[2 * p + 1][1] * eb[1]); o.w = pk2(S[2 * p + 1][2] * eb[2], S[2 * p + 1][3] * eb[3]); const bf16x8 Sf = __builtin_bit_cast(bf16x8, o);
#pragma unroll
            for (int ti = 0; ti < 4; ++ti) { const u32x2 q0 = *(const LAS u32x2*)(lds + b_q4 + ti * 16 * L::QS + 64 * p), q1 = *(const LAS u32x2*)(lds + b_q4 + ti * 16 * L::QS + 64 * p + 32);
                u32x4 qq; qq.x = q0.x; qq.y = q0.y; qq.z = q1.x; qq.w = q1.y; O[ti] = MFMA16(Sf, __builtin_bit_cast(bf16x8, qq), O[ti]); }
            }
        __syncthreads();
        if (c + 1 < nchunk) { G_LAND_QK(); G_LOAD_HV(c + 1); }
#pragma unroll
        for (int ti = 0; ti < 4; ++ti) { f32x4 acc = O[ti];
#pragma unroll
            for (int ks = 0; ks < 2; ++ks) { const bf16x8 bp = *(const LAS bf16x8*)(lds + b_p + ti * 16 * L::KHS + ks * 64); acc = MFMA16(Vf[ks], bp, acc); }
            const int t = 16 * ti + fr;
            if (t < nval) { u32x2 ob; ob.x = pk2(acc[0], acc[1]); ob.y = pk2(acc[2], acc[3]); *(u32x2*)(A.OA + (rowc + t) * (2 * BW) + 16 * w + 4 * fq) = ob; }
            float s = (acc[0] * acc[0] + acc[1] * acc[1]) + (acc[2] * acc[2] + acc[3] * acc[3]); s += __shfl_xor(s, 16); s += __shfl_xor(s, 32);
            if (fq == 0) *(LAS float*)(lds + L::SSQ + (t * 8 + w) * 4) = s; }
#pragma unroll
        for (int k = 0; k < NDKT; ++k) { const f32x4 e = *(const LAS f32x4*)(lds + b_e + L::EBL + 64 * k); f32x4 acc = S[k] * e;
#pragma unroll
            for (int ks = 0; ks < 2; ++ks) { const bf16x8 a = *(const LAS bf16x8*)(lds + b_kh + k * 16 * L::KHS + ks * 64); acc = MFMA16(a, Vf[ks], acc); }
            S[k] = acc; }
        __syncthreads();
        if (tid < 64 && tid < nval) { const f32x4 sa = *(const LAS f32x4*)(lds + L::SSQ + tid * 32), sb = *(const LAS f32x4*)(lds + L::SSQ + tid * 32 + 16);
            A.SSQ[(rowc + tid) * 32] = ((sa.x + sa.y) + (sa.z + sa.w)) + ((sb.x + sb.y) + (sb.z + sb.w)); }
    }
#undef G_IDX
#undef G_LOAD_QK
#undef G_LOAD_HV
#undef G_LAND_QK
#undef G_LAND_HV
#pragma unroll
    for (int k = 0; k < NDKT; ++k)
#pragma unroll
        for (int j = 0; j < 4; ++j) A.S1[(size_t)(16 * k + 4 * fq + j) * A.lds + 16 * w + fr] = S[k][j];
}

struct LruArgs { const float* LX; int row0, T; const float* cst; const float* h0; const float* cw; const float* cb; const float* wa; const float* ba;
                 const float* wx; const float* bx; const float* lam; const bf16* lgate; bf16* Y; float* newh; float* newconv; };
constexpr int LR_XB = 0, LR_XF = 17408, LR_AA = LR_XF + 32768, LR_UU = LR_AA + 32768, LR_END = LR_UU + 32768;
static_assert(LR_END <= MISC_OFF, "lru LDS map");
DI void lru_job(LAS unsigned char* lds, const int tid_in, const LruArgs& A) {
    int tid = tid_in; asm volatile("" : "+v"(tid));
    const int lane = tid & 63, w = __builtin_amdgcn_readfirstlane(tid >> 6), fr = lane & 15, fq = lane >> 4;
    const int c = tid & 127, part = __builtin_amdgcn_readfirstlane(tid >> 7), cc = 16 * w + fr;
    bf16x8 Wf[2][4];
#pragma unroll
    for (int ks = 0; ks < 4; ++ks) { float a[8], x[8];
#pragma unroll
        for (int j = 0; j < 8; ++j) { const int i = 32 * ks + 8 * fq + j; a[j] = A.wa[i * 128 + cc]; x[j] = A.wx[i * 128 + cc]; }
        u32x4 oa, ox; oa.x = pk2(a[0], a[1]); oa.y = pk2(a[2], a[3]); oa.z = pk2(a[4], a[5]); oa.w = pk2(a[6], a[7]);
        ox.x = pk2(x[0], x[1]); ox.y = pk2(x[2], x[3]); ox.z = pk2(x[4], x[5]); ox.w = pk2(x[6], x[7]);
        Wf[0][ks] = __builtin_bit_cast(bf16x8, oa); Wf[1][ks] = __builtin_bit_cast(bf16x8, ox); }
    const float bav = A.ba[cc], bxv = A.bx[cc]; const float lamv = A.lam[cc];
    const float sp8 = -8.0f * (fmaxf(-lamv, 0.f) + log1pf(expf(-fabsf(lamv))));
    const float cw0 = A.cw[c], cw1 = A.cw[BW + c], cw2 = A.cw[2 * BW + c], cw3 = A.cw[3 * BW + c], cbv = A.cb[c];
    float hc = (tid < 128 && A.h0) ? A.h0[c] : 0.f;
    const int nchunk = (A.T + 63) >> 6;
    float xv[19]; unsigned lgn[16];
#define LRU_PREFETCH(chn) do { int t0_ = (chn) * 64; asm volatile("" : "+s"(t0_)); const int nval_ = (A.T - t0_) < 64 ? (A.T - t0_) : 64; \
        _Pragma("unroll") for (int i_ = 0; i_ < 19; ++i_) { const int ta_ = t0_ + 16 * part - 3 + i_; float v_ = 0.f; \
            if (ta_ < 0) { if (A.cst) v_ = A.cst[(3 + ta_) * BW + c]; } else if (ta_ < A.T) { const float* xb_ = A.LX + (size_t)(A.row0 + ta_) * BW; v_ = xb_[c]; } \
            xv[i_] = v_; } \
        _Pragma("unroll") for (int i_ = 0; i_ < 16; ++i_) { const int t_ = 16 * part + i_; const bf16* gb_ = A.lgate + ((size_t)A.row0 + t0_ + t_) * BW; lgn[i_] = (t_ < nval_) ? (unsigned)gb_[c] : 0u; } } while (0)
    LRU_PREFETCH(0);
    for (int ch = 0; ch < nchunk; ++ch) {
        const int t0 = ch * 64; const size_t rowc = (size_t)A.row0 + t0; const int nval = (A.T - t0) < 64 ? (A.T - t0) : 64;
        unsigned lg[16];
#pragma unroll
        for (int i = 0; i < 16; ++i) lg[i] = lgn[i];
#pragma unroll
        for (int i = 0; i < 16; ++i) { const int t = 16 * part + i; const float xc = cbv + xv[i] * cw0 + xv[i + 1] * cw1 + xv[i + 2] * cw2 + xv[i + 3] * cw3;
            *(LAS float*)(lds + LR_XF + (t * 128 + c) * 4) = xc; *(LAS bf16*)(lds + LR_XB + t * 272 + c * 2) = f2bf(xc); }
        __syncthreads();
        if (ch + 1 < nchunk) LRU_PREFETCH(ch + 1);
#pragma unroll
        for (int ti = 0; ti < 4; ++ti) { f32x4 ar = (f32x4){0.f, 0.f, 0.f, 0.f}, ai = (f32x4){0.f, 0.f, 0.f, 0.f};
#pragma unroll
            for (int ks = 0; ks < 4; ++ks) { const bf16x8 a = *(const LAS bf16x8*)(lds + LR_XB + (16 * ti + fr) * 272 + (32 * ks + 8 * fq) * 2); ar = MFMA16(a, Wf[0][ks], ar); ai = MFMA16(a, Wf[1][ks], ai); }
#pragma unroll
            for (int j = 0; j < 4; ++j) { const int t = 16 * ti + 4 * fq + j;
                const float r = sigmoidf_(ar[j] + bav), ig = sigmoidf_(ai[j] + bxv); const float la = r * sp8;
                float a_ = __expf(la); const float t2 = 2.0f * la;
                const float om = (t2 > -0.03f) ? -t2 * (1.0f + t2 * (0.5f + t2 * (0.16666667f + t2 * 0.041666668f))) : 1.0f - a_ * a_;
                float u = __builtin_amdgcn_sqrtf(fmaxf(om, 0.f)) * ig * *(const LAS float*)(lds + LR_XF + (t * 128 + cc) * 4);
                if (t >= nval) { a_ = 1.0f; u = 0.f; }
                *(LAS float*)(lds + LR_AA + (t * 128 + cc) * 4) = a_; *(LAS float*)(lds + LR_UU + (t * 128 + cc) * 4) = u; } }
        __syncthreads();
        if (tid < 128) {
#pragma unroll 16
            for (int t = 0; t < 64; ++t) { const float a_ = *(const LAS float*)(lds + LR_AA + (t * 128 + c) * 4); LAS float* up = (LAS float*)(lds + LR_UU + (t * 128 + c) * 4);
                hc = a_ * hc + *up; *up = hc; }
        }
        __syncthreads();
#pragma unroll
        for (int i = 0; i < 16; ++i) { const int t = 16 * part + i; const float ht = *(const LAS float*)(lds + LR_UU + (t * 128 + c) * 4);
            if (t < nval) { bf16* yb = A.Y + (rowc + t) * KBR; yb[c] = f2bf(ht * bf2f(lg[i])); } }
    }
#undef LRU_PREFETCH
    if (tid < 128) { A.newh[c] = hc;
#pragma unroll
        for (int j = 0; j < 3; ++j) A.newconv[j * BW + c] = A.LX[(size_t)(A.row0 + A.T - 3 + j) * BW + c]; }
    __syncthreads();
}

struct Args { const float* in[23]; float* out; unsigned char* ws; int ph_lo, ph_hi, use_bar, pad; };
enum { I_XP = 0, I_XS, I_SHG, I_SLH, I_SLC, I_SGL, I_NPRE, I_NPOST, I_WIN, I_LBL, I_HGN, I_CW, I_CB, I_WA, I_BA, I_WX, I_BX, I_LAM, I_W2, I_B2, I_GLN, I_WBR, I_WOU };
constexpr int NPHASE = 15;


#define WSZ() unsigned char* wsz = ws; asm volatile("" : "+s"(wsz))
#define wHQ ((bf16*)(wsz + WS_HQ))
#define wHG ((float*)(wsz + WS_HG))
#define wHV ((bf16*)(wsz + WS_HV))
#define wHGATE ((bf16*)(wsz + WS_HGATE))
#define wLX ((float*)(wsz + WS_LX))
#define wLGATE ((bf16*)(wsz + WS_LGATE))
#define wCQ ((bf16*)(wsz + WS_CQ))
#define wCK ((bf16*)(wsz + WS_CK))
#define wCV ((bf16*)(wsz + WS_CV))
#define wCGATE ((bf16*)(wsz + WS_CGATE))
#define wMG ((unsigned char*)(wsz + WS_MG))
#define wCLR ((float*)(wsz + WS_CLR))
#define wY ((bf16*)(wsz + WS_Y))
#define wOC ((bf16*)(wsz + WS_OC))
#define wSSQ ((float*)(wsz + WS_SSQ))
#define wGL ((float*)(wsz + WS_MERGED))
#define wMB ((bf16*)(wsz + WS_MB))
#define wOUT ((bf16*)(wsz + WS_OUT))
__global__ void __launch_bounds__(NTHR, 2) mega(Args args) {
    extern __shared__ __attribute__((aligned(16))) unsigned char lds_raw[];
    LAS unsigned char* lds = (LAS unsigned char*)lds_raw;
    const int wave = __builtin_amdgcn_readfirstlane((int)threadIdx.x >> 6);
#define tid ((int)threadIdx.x)
#define lane ((int)(threadIdx.x & 63u))
    const int G = gridDim.x, bx = blockIdx.x;
    const int gw = bx * NWAVES + wave, NGW = G * NWAVES;
#define chain (gridDim.x == 256u)
#define MM (chain ? MP : MT)
    unsigned char* ws = args.ws;
    volatile LAS unsigned* MISC = (volatile LAS unsigned*)(lds + MISC_OFF);
    if (tid < 64) MISC[tid] = 0u;
    __syncthreads();
    XcdBarrier bar; bar.bar = (unsigned*)(ws + WS_CTL) + CW_BAR; bar.x = 0; bar.st = nullptr;
    if (args.use_bar) bar = xcd_barrier_post((unsigned*)(ws + WS_CTL) + CW_BAR, MISC);
    const int lo = args.ph_lo, hi = args.ph_hi;
#define IN(k) (lo <= (k) && (k) < hi)
#define SEAM(k) do { if (IN(k) && IN((k) + 1)) xcd_barrier(bar); } while (0)
    const float* xp = args.in[I_XP]; const float* xs = args.in[I_XS];
    bf16* Z = (bf16*)(ws + WS_Z);
    bf16* X1 = (bf16*)(ws + WS_X1);

    for (int rep_ = 0; rep_ < REP_P0; ++rep_) if (IN(0) && (PHM & 64)) {
        { int lz = lane, gz = gw; asm volatile("" : "+v"(lz), "+s"(gz));
          convert_items(lds, args.in[I_WIN], args.in[I_WBR], args.in[I_WOU], ws, 0, 0, CV_IN, gz, NGW, lz); }
        norm_rows(xp, xs, args.in[I_NPRE], Z, ws + WS_Z8, gw, NGW, lane);
        __syncthreads();
    }
    SEAM(0);
    for (int l = 0; l < 2; ++l) {
        const int pb = 1 + 7 * l;
        for (int rp_ = 0; rp_ < REP_IN; ++rp_) if (IN(pb) && (PHM & 1)) { WSZ();
            const NoDrain<EpiInProj> E{{wHQ, wHV, wHGATE, wLGATE, wCQ, wCK, wCV, wCGATE, wMG, wHG, wLX, wCLR, args.in[I_LBL], l, 0.015625f}};
            { pg8::Gemm g{Z, (const bf16*)(ws + WS_WIN + l * SZ_WIN), MT, NIN, DM, DM, DM}; int bz = bx; asm volatile("" : "+s"(bz)); InOrderA SA; SA.S.init(MT, 73 * 256, G, bz);
              af4 acc[2][2][4][2]; zero_acc(acc); pg8::gemm_phase<NoDrain<EpiInProj>, InOrderA, GEMM_ALIGN, GEMM_SP2, false>(lds, g, SA, E, acc); }
            { pg8::Gemm g{(const bf16*)(ws + WS_Z8), (const bf16*)(ws + WS_W8 + l * SZ_W8) - (size_t)72 * 256 * 2048, MT, 12288, 2048, 2048, 2048}; InOrder8 S8; int bz = bx; asm volatile("" : "+s"(bz)); S8.S.init(MT, 48 * 256, G, G == 256 ? ((bz + 48) & 255) : bz);
              af4 acc[2][2][4][2]; zero_acc(acc); pg8::gemm_phase<NoDrain<EpiInProj>, InOrder8, GEMM_ALIGN, GEMM_SP2, true>(lds, g, S8, E, acc); }
            if (G == 256) { if (bx >= 105 && bx < 208) { int lz = lane; asm volatile("" : "+v"(lz)); convert_items(lds, args.in[I_WIN], args.in[I_WBR], args.in[I_WOU], ws, l, CV_IN, CV_L, (bx - 105) * NWAVES + wave, 103 * NWAVES, lz); } }
            else { int lz = lane; asm volatile("" : "+v"(lz)); convert_items(lds, args.in[I_WIN], args.in[I_WBR], args.in[I_WOU], ws, l, CV_IN, CV_L, bx * NWAVES + wave, G * NWAVES, lz); }
        }
        SEAM(pb);
        if (!chain) {
            if (IN(pb + 1)) { WSZ();
                const GPrep P{wCQ, wCK, wCLR, args.in[I_W2] + (size_t)l * 16 * 1024, args.in[I_B2] + l * 1024, (bf16*)(wsz + WS_GQT), (bf16*)(wsz + WS_GKT), (bf16*)(wsz + WS_GKH), (float*)(wsz + WS_GER), (float*)(wsz + WS_GEB)};
                for (int it = bx; it < NCHK * 4; it += G) gla_prep(lds, tid, P, it >> 2, it & 3);
            }
            SEAM(pb + 1);
        }
        for (int rep_ = 0; rep_ < REP_SCAN; ++rep_) if (IN(pb + 2) && (PHM & 2)) { WSZ();
            constexpr int NLONG = 192;
            const bool split = G > NLONG;
            const int mytype = split ? (bx < NLONG ? bx / 64 : -1) : -2;
            const int sw = bx - NLONG, nsw = G - NLONG;
            if (chain && mytype != 2) {
                const GPrep P{wCQ, wCK, wCLR, args.in[I_W2] + (size_t)l * 16 * 1024, args.in[I_B2] + l * 1024, (bf16*)(wsz + WS_GQT), (bf16*)(wsz + WS_GKT), (bf16*)(wsz + WS_GKH), (float*)(wsz + WS_GER), (float*)(wsz + WS_GEB)};
                for (int it = (bx < 128 ? bx : bx - 64); it < NCHK * 4; it += 192) gla_prep(lds, tid, P, it >> 2, it & 3);
                if (mytype == 1) team_arrive((unsigned*)(ws + WS_CTL) + CW_TEAM + 2048 + l * 64 + rep_ * 16);
                else team_barrier((unsigned*)(ws + WS_CTL) + CW_TEAM + 2048 + l * 64 + rep_ * 16, 192u);
            }
#define JOB_RANGE(TYPE, j0, j1, js) int j0, j1, js; \
            if (mytype == -2) { j0 = bx; j1 = 192; js = G; } else if (mytype == (TYPE)) { j0 = bx - 64 * (TYPE); j1 = j0 + 1; js = 1; } else if (mytype == -1) { j0 = 64 + sw; j1 = 192; js = nsw; } else { j0 = 0; j1 = 0; js = 1; }
#define JOB_DECODE(idx) const int seq = (idx) < 64 ? (idx) / 16 : 4 + ((idx) - 64) / 16; const int sub = (idx) % 16; const bool smp = seq >= 4; const int sb = smp ? seq - 4 : seq; \
            const int row0 = smp ? MP + sb * 32 : sb * 2048, T = smp ? 32 : 2048;
            for (int rj_ = 0; rj_ < REP_J0; ++rj_) if (JOBM & 1) { JOB_RANGE(0, j0, j1, js)
                for (int idx = j0; idx < j1; idx += js) { JOB_DECODE(idx)
                    const int hd = sub >> 2, sl = sub & 3;
                    GArgs A; A.QT = (const bf16*)(wsz + WS_GQT) + hd * 256; A.KT = (const bf16*)(wsz + WS_GKT) + hd * 256; A.KH = (const bf16*)(wsz + WS_GKH) + (size_t)hd * 256 * 64;
                    A.ER = (const float*)(wsz + WS_GER) + hd * 256; A.EB = (const float*)(wsz + WS_GEB) + hd * 256; A.ci0 = smp ? 128 + sb : sb * 32;
                    A.V = wCV + hd * 512 + sl * 128; A.row0 = row0; A.T = T;
                    const size_t so = ((size_t)hd * 256) * 512 + sl * 128;
                    A.S0 = smp ? args.in[I_SGL] + ((size_t)l * 8 + sb) * 4 * 256 * 512 + so : nullptr;
                    A.S1 = args.out + (smp ? O_GLS + ((size_t)l * 8 + sb) * 4 * 256 * 512 : O_GLP + ((size_t)l * 4 + sb) * 4 * 256 * 512) + so; A.lds = 512;
                    A.OA = wOC + BW + hd * 512 + sl * 128; A.SSQ = wSSQ + 16 + hd * 4 + sl;
                    gla_job(lds, tid, A);
                    __syncthreads(); } }
            for (int rj_ = 0; rj_ < REP_J1; ++rj_) if (JOBM & 2) { JOB_RANGE(1, j0, j1, js)
                for (int idx = j0; idx < j1; idx += js) { JOB_DECODE(idx)
                    const int h = sub;
                    LaArgs A; A.Q = wHQ + h * 128; A.ldq = BW; A.G = wHG + h * 128; A.ldg = BW; A.K = nullptr;
                    A.V = wHV + h * 128; A.row0 = row0; A.T = T;
                    A.S0 = smp ? args.in[I_SHG] + (((size_t)l * 8 + sb) * 16 + h) * 16384 : nullptr;
                    A.S1 = args.out + (smp ? O_HGS + (((size_t)l * 8 + sb) * 16 + h) * 16384 : O_HGP + (((size_t)l * 4 + sb) * 16 + h) * 16384); A.lds = 128;
                    A.nw = args.in[I_HGN] + l * BW + h * 128; A.gate = wHGATE + h * 128; A.Y = wY + h * 128;
                    la_job<128, false>(lds, tid, A);
                    __syncthreads(); } }
            for (int rj_ = 0; rj_ < REP_J2; ++rj_) if (JOBM & 4) { JOB_RANGE(2, j0, j1, js)
                for (int idx = j0; idx < j1; idx += js) { JOB_DECODE(idx)
                    const int hb = sub;
                    LruArgs A; A.LX = wLX + hb * 128; A.row0 = row0; A.T = T;
                    A.cst = smp ? args.in[I_SLC] + ((size_t)l * 8 + sb) * 3 * BW + hb * 128 : nullptr;
                    A.h0 = smp ? args.in[I_SLH] + ((size_t)l * 8 + sb) * BW + hb * 128 : nullptr;
                    A.cw = args.in[I_CW] + (size_t)l * 4 * BW + hb * 128; A.cb = args.in[I_CB] + l * BW + hb * 128;
                    A.wa = args.in[I_WA] + ((size_t)l * 16 + hb) * 16384; A.ba = args.in[I_BA] + l * BW + hb * 128;
                    A.wx = args.in[I_WX] + ((size_t)l * 16 + hb) * 16384; A.bx = args.in[I_BX] + l * BW + hb * 128;
                    A.lam = args.in[I_LAM] + l * BW + hb * 128; A.lgate = wLGATE + hb * 128; A.Y = wY + BW + hb * 128;
                    A.newh = args.out + (smp ? O_LHS + ((size_t)l * 8 + sb) * BW : O_LHP + ((size_t)l * 4 + sb) * BW) + hb * 128;
                    A.newconv = args.out + (smp ? O_LCS + ((size_t)l * 8 + sb) * 3 * BW : O_LCP + ((size_t)l * 4 + sb) * 3 * BW) + hb * 128;
                    lru_job(lds, tid, A);
                    __syncthreads(); } }
            if (chain && bx >= 192) {
                const int sw = bx - 192;
                unsigned* tb = (unsigned*)(ws + WS_CTL) + CW_TEAM + (l * 4) * 64 + rep_ * 16;
                team_barrier(tb, 64u);
                mix_fix_rows(wOC, wSSQ, args.in[I_HGN] + l * BW, wHGATE, args.in[I_GLN] + l * BW, wCGATE, wY, MP, MT, sw * NWAVES + wave, 64 * NWAVES, lane);
                team_barrier(tb + 64, 64u);
                if (sw < 48) {
                    const int pn = sw / 3, seg = sw - 3 * pn;
                    const FixedUnit FU{pg8::Unit{MP / 256, pn}};
                    af4 acc[2][2][4][2]; zero_acc(acc); const bf16* WB = (const bf16*)(ws + WS_WBR + l * SZ_WBR);
                    pg8::Gemm g{wY + seg * BW, WB + seg * BW, MT, DM, BW, KBR, KBR}; EpiGateSlab E{wMG, (float*)(wsz + WS_PB), seg};
                    pg8::gemm_phase<EpiGateSlab, FixedUnit, false, GEMM_SP2>(lds, g, FU, E, acc);
                }
                team_barrier(tb + 128, 64u);
                sum_slabs_rows((const float*)(wsz + WS_PB), wMB, sw * NWAVES + wave, 64 * NWAVES, lane);
                team_barrier(tb + 192, 64u);
                {
                    const int pn = sw >> 2, kq = sw & 3;
                    const FixedUnit FU{pg8::Unit{MP / 256, pn}};
                    af4 acc[2][2][4][2]; zero_acc(acc);
                    pg8::Gemm g{wMB + kq * 1024, (const bf16*)(ws + WS_WOU + l * SZ_WOU) + kq * 1024, MT, DM, 1024, DM, DM};
                    EpiF32 E{(float*)(wsz + WS_PO) + (size_t)kq * 256 * DM - (size_t)MP * DM, DM};
                    pg8::gemm_phase<EpiF32, FixedUnit, false, GEMM_SP2>(lds, g, FU, E, acc);
                }
                if (l == 0) {
                    int lz = lane; asm volatile("" : "+v"(lz));
                    convert_items(lds, args.in[I_WIN], args.in[I_WBR], args.in[I_WOU], ws, 1, 0, CVX, sw * NWAVES + wave, 64 * NWAVES, lz);
                }
            }
        }
        SEAM(pb + 2);
        for (int rp_ = 0; rp_ < REP_FIN; ++rp_) if (IN(pb + 3) && (PHM & 4)) { WSZ(); mix_fix_rows(wOC, wSSQ, args.in[I_HGN] + l * BW, wHGATE, args.in[I_GLN] + l * BW, wCGATE, wY, 0, MM, gw, NGW, lane); }
        SEAM(pb + 3);
        for (int rp_ = 0; rp_ < REP_BR; ++rp_) if (IN(pb + 4) && (PHM & 8)) { WSZ();
            const bf16* WB = (const bf16*)(ws + WS_WBR + l * SZ_WBR);
            BranchOrder BO; BO.S.init(MM, DM, G, bx);
            { af4 acc[2][2][4][2]; zero_acc(acc); pg8::Gemm g{wY, WB, MT, DM, BW, KBR, KBR}; const NoDrain<EpiBranchSeg> E{{wMG, wMB, 0}};
              pg8::gemm_phase<NoDrain<EpiBranchSeg>, BranchOrder, GEMM_ALIGN, GEMM_SP2>(lds, g, BO, E, acc); }
            if (l == 0) tail_convert(lds, args.in[I_WIN], args.in[I_WBR], args.in[I_WOU], ws, 1, chain ? CVX : 0, CV_IN, (MM / 256) * (DM / 256), G, bx, wave, lane);
        }
        SEAM(pb + 4);
        for (int rp_ = 0; rp_ < REP_OUT; ++rp_) if (IN(pb + 5) && (PHM & 16)) { WSZ();
            pg8::Gemm g{wMB, (const bf16*)(ws + WS_WOU + l * SZ_WOU), MT, DM, DM, DM, DM}; pg8::StaticOrder S; S.init(MM, DM, G, bx);
            EpiBf E{wOUT, DM}; if (GEMM_STREAM & 2) gemm_stream<EpiBf>(lds, g, S, E); else gemm_units<EpiBf>(lds, g, S, E);
        }
        SEAM(pb + 5);
        for (int rp_ = 0; rp_ < REP_FIN; ++rp_) if (IN(pb + 6) && (PHM & 32)) { WSZ();
            if (l == 0) final_rows<false, true>(xp, xs, wOUT, chain ? (const float*)(wsz + WS_PO) : nullptr, args.in[I_NPOST], X1, args.in[I_NPRE] + DM, Z, ws + WS_Z8, gw, NGW, lane);
            else        final_rows<true, false>(X1, X1 + (size_t)MP * DM, wOUT, chain ? (const float*)(wsz + WS_PO) : nullptr, args.in[I_NPOST] + DM, args.out, nullptr, nullptr, nullptr, gw, NGW, lane);
        }
        if (l == 0) SEAM(pb + 6);
    }
}

#undef tid
#undef lane
#undef chain
#undef MM
#ifndef PHM
#define PHM 127
#endif
#ifndef N_LAUNCH_MODE
#define N_LAUNCH_MODE 0
#endif
extern "C" void kernel_launch(void* const* d_in, const int* in_sizes, int n_in, void* d_out, int out_size, void* d_ws, size_t ws_size, hipStream_t stream) {
    static int grid = 0;
    if (grid == 0) {
        if (n_in != 23 || (size_t)out_size != O_END || ws_size < WS_END) { fprintf(stderr, "kernel_launch: unexpected shapes (n_in %d out %d ws %zu need %zu)\n", n_in, out_size, ws_size, (size_t)WS_END); grid = -1; return; }
        int dev = 0, cus = 0, per_cu = 0;
        if (hipGetDevice(&dev) != hipSuccess || hipDeviceGetAttribute(&cus, hipDeviceAttributeMultiprocessorCount, dev) != hipSuccess) { grid = -1; return; }
        if (hipFuncSetAttribute((const void*)mega, hipFuncAttributeMaxDynamicSharedMemorySize, LDS_BYTES) != hipSuccess) { fprintf(stderr, "kernel_launch: hipFuncSetAttribute failed\n"); grid = -1; return; }
        if (hipOccupancyMaxActiveBlocksPerMultiprocessor(&per_cu, (const void*)mega, NTHR, LDS_BYTES) != hipSuccess || per_cu < 1) { fprintf(stderr, "kernel_launch: occupancy query says %d\n", per_cu); grid = -1; return; }
        grid = cus;
    }
    if (grid < 0) return;
    hipMemsetAsync((char*)d_ws + WS_CTL, 0, CTL_ZERO_BYTES, stream);
    Args a{};
    for (int i = 0; i < 23; ++i) a.in[i] = (const float*)d_in[i];
    a.out = (float*)d_out; a.ws = (unsigned char*)d_ws; a.pad = 0;
#if N_LAUNCH_MODE == 1
    a.ph_lo = 0; a.ph_hi = NPHASE; a.use_bar = 1;
    hipLaunchKernelGGL(mega, dim3(grid), dim3(NTHR), LDS_BYTES, stream, a);
#else
    for (int p = 0; p < NPHASE; ++p) { a.ph_lo = p; a.ph_hi = p + 1; a.use_bar = 0; hipLaunchKernelGGL(mega, dim3(grid), dim3(NTHR), LDS_BYTES, stream, a); }
#endif
}
```

```cpp
#include <hip/hip_runtime.h>
#include <cstdio>
#include <cstdint>
#define N_LAUNCH_MODE 1
#ifndef PG8_WGM
#define PG8_WGM 8
#endif
namespace pg8 {
#define PG8_LAS __attribute__((address_space(3)))
typedef unsigned short bf16_t;
typedef short bf16x8 __attribute__((ext_vector_type(8)));
typedef float f32x4 __attribute__((ext_vector_type(4)));
typedef unsigned u32x4 __attribute__((ext_vector_type(4)));
typedef int i32x4 __attribute__((ext_vector_type(4)));
typedef int i32x8 __attribute__((ext_vector_type(8)));
constexpr int BM = 256, BK = 64, HALF = 128, HTB = HALF * BK * 2  , STAGE_BYTES = 8 * HTB, NXCD = 8, WGM = PG8_WGM;

__host__ __device__ __forceinline__ int lds_byte(int r, int c) { const int st = (r >> 4) * 2 + (c >> 5), rr = r & 15, cc = c & 31, ob = rr * 64 + cc * 2; return st * 1024 + (ob ^ (((ob >> 9) & 1) << 5)); }
__host__ __device__ __forceinline__ void stage_rc(int b, int& R, int& C) { const int st = b / 1024, sb = b % 1024, swz = sb ^ (((sb >> 9) & 1) << 5); R = (st >> 1) * 16 + swz / 64; C = (st & 1) * 32 + (swz % 64) / 2; }
__host__ __device__ __forceinline__ int perm32(int rho) { const int n = rho >> 4, i = rho & 15; return 8 * (i >> 2) + 4 * n + (i & 3); }

struct Unit { int pm, pn, ko; };
struct Gemm { const bf16_t* A; const bf16_t* Bt; int M, N, K, lda, ldb; };

struct StaticOrder {
    int nM, nN, nwg, G, c;
    __host__ __device__ __forceinline__ void init(int M, int N, int G_, int c_) { nM = M / BM; nN = N / BM; nwg = nM * nN; G = G_; c = c_; }
    __host__ __device__ __forceinline__ bool next(int i, Unit& u) const {
        const long L = (long)i * G + c; if (L >= nwg) return false;
        int wgid = (int)L; { const int q = nwg / NXCD, r = nwg % NXCD, xcd = wgid % NXCD, off = wgid / NXCD; wgid = (xcd < r ? xcd * (q + 1) : r * (q + 1) + (xcd - r) * q) + off; }
        const int nig = WGM * nN, gid = wgid / nig, fm = gid * WGM, w_ = wgid - gid * nig, rem = (nM % WGM) ? (nM % WGM) : 1;
        if ((nM - fm) < WGM) { u.pm = fm + (w_ % rem); u.pn = w_ / rem; } else { u.pm = fm + (w_ % WGM); u.pn = w_ / WGM; }
        u.ko = 0; return true;
    }
    __device__ __forceinline__ void a_ready(const Unit&) const {}
    __device__ __forceinline__ void done(const Unit&) const {}
    __device__ __forceinline__ bool zero_after(const Unit&) const { return true; }
};

template <class Epi, class Sched, bool ALIGN_EPI = false, bool SP2 = false, bool F8 = false>
__device__ __forceinline__ void gemm_phase(PG8_LAS unsigned char* lds, const Gemm g, const Sched& S, const Epi& E, f32x4 (&acc)[2][2][4][2]) {
    int tid_ = threadIdx.x; asm volatile("" : "+v"(tid_));
    const int tid = tid_, wid = __builtin_amdgcn_readfirstlane(tid >> 6), lane = tid & 63, wr = wid >> 2, wc = wid & 3, fr = lane & 15, fq = lane >> 4;
    const int K = g.K, nt = K / BK;
    unsigned voffA[2], voffB[2];
#pragma unroll
    for (int i = 0; i < 2; ++i) { int R, C; stage_rc(tid * 16 + i * 8192, R, C); const int Rb = Epi::PERM ? ((R & ~31) + perm32(R & 31)) : R;
        voffA[i] = (unsigned)(R * g.lda + C) * 2u; voffB[i] = (unsigned)(Rb * g.ldb + C) * 2u; }
    const size_t kstep = (size_t)(BK * 2);
    const size_t hstepA = (size_t)HALF * g.lda * 2, hstepB = (size_t)HALF * g.ldb * 2;
    const size_t tstepA = 2 * hstepA, tstepB = 2 * hstepB;
    const unsigned ldsw = (unsigned)wid * 1024u;
    const int aoff = lds_byte(wr * 64 + fr, fq * 8), boff = lds_byte(wc * 32 + fr, fq * 8);
#define PG8_SA(b, h) (((b) * 2 + (h)) * HTB)
#define PG8_SB(b, h) ((4 + (b) * 2 + (h)) * HTB)
#define PG8_STAGE(bufoff, gbase, voff) do { _Pragma("unroll") for (int _i = 0; _i < 2; ++_i) \
        __builtin_amdgcn_global_load_lds((const unsigned*)((const char*)(gbase) + (voff)[_i]), (PG8_LAS unsigned*)(lds + (bufoff) + ldsw + _i * 8192), 16, 0, 0); } while (0)
#define PG8_LDA(dst, b, h) do { if constexpr (F8) { _Pragma("unroll") for (int m = 0; m < 4; ++m) dst##8[m] = __builtin_shufflevector(*(const PG8_LAS i32x4*)(lds + PG8_SA(b, h) + aoff + m * 2048), *(const PG8_LAS i32x4*)(lds + PG8_SA(b, h) + aoff + m * 2048 + 1024), 0, 1, 2, 3, 4, 5, 6, 7); } \
        else { _Pragma("unroll") for (int m = 0; m < 4; ++m) _Pragma("unroll") for (int k = 0; k < 2; ++k) dst[m][k] = *(const PG8_LAS bf16x8*)(lds + PG8_SA(b, h) + aoff + m * 2048 + k * 1024); } } while (0)
#define PG8_LDB(dst, b, h) do { if constexpr (F8) { _Pragma("unroll") for (int n = 0; n < 2; ++n) dst##8[n] = __builtin_shufflevector(*(const PG8_LAS i32x4*)(lds + PG8_SB(b, h) + boff + n * 2048), *(const PG8_LAS i32x4*)(lds + PG8_SB(b, h) + boff + n * 2048 + 1024), 0, 1, 2, 3, 4, 5, 6, 7); } \
        else { _Pragma("unroll") for (int n = 0; n < 2; ++n) _Pragma("unroll") for (int k = 0; k < 2; ++k) dst[n][k] = *(const PG8_LAS bf16x8*)(lds + PG8_SB(b, h) + boff + n * 2048 + k * 1024); } } while (0)
#define PG8_CAT8(x0, x1) __builtin_shufflevector(__builtin_bit_cast(i32x4, (x0)), __builtin_bit_cast(i32x4, (x1)), 0, 1, 2, 3, 4, 5, 6, 7)
#define PG8_MMA(ai, bj, At, Bt) do { __builtin_amdgcn_s_setprio(1); \
        if constexpr (F8) { _Pragma("unroll") for (int m = 0; m < 4; ++m) _Pragma("unroll") for (int n = 0; n < 2; ++n) \
            asm volatile("v_mfma_f32_16x16x128_f8f6f4 %0, %1, %2, %0" : "+v"(acc[ai][bj][m][n]) : "v"(Bt##8[n]), "v"(At##8[m])); }   \
        else { _Pragma("unroll") for (int m = 0; m < 4; ++m) _Pragma("unroll") for (int n = 0; n < 2; ++n) _Pragma("unroll") for (int k = 0; k < 2; ++k) \
            acc[ai][bj][m][n] = __builtin_amdgcn_mfma_f32_16x16x32_bf16(Bt[n][k], At[m][k], acc[ai][bj][m][n], 0, 0, 0); } \
        __builtin_amdgcn_s_setprio(0); } while (0)
#define PG8_WAIT_V(n) asm volatile("s_waitcnt vmcnt(" #n ")" ::: "memory")
#define PG8_WAIT_L(n) asm volatile("s_waitcnt lgkmcnt(" #n ")" ::: "memory")
#define PG8_BAR __builtin_amdgcn_s_barrier()
#define PG8_SCHED __builtin_amdgcn_sched_barrier(0)
    Unit cur, nxt; int ui = 0;
    if (!S.next(0, cur)) return;
    bf16x8 At[4][2], B0[2][2], B1[2][2];
    i32x8 At8[4], B08[2], B18[2];
    const char* cA = (const char*)g.A + (size_t)cur.pm * tstepA + (size_t)cur.ko * 2; const char* cB = (const char*)g.Bt + (size_t)cur.pn * tstepB + (size_t)cur.ko * 2;
    S.a_ready(cur);
    if constexpr (SP2) {
        PG8_STAGE(PG8_SB(0, 0), cB, voffB); PG8_STAGE(PG8_SB(0, 1), cB + hstepB, voffB); PG8_STAGE(PG8_SA(0, 0), cA, voffA); PG8_STAGE(PG8_SA(0, 1), cA + hstepA, voffA);
        if (wr == 1) PG8_BAR;
        PG8_WAIT_V(2); PG8_BAR;
        PG8_STAGE(PG8_SB(1, 0), cB + kstep, voffB); PG8_STAGE(PG8_SA(1, 0), cA + kstep, voffA); PG8_STAGE(PG8_SB(1, 1), cB + hstepB + kstep, voffB);
        PG8_WAIT_V(6); PG8_BAR;
    } else {
        PG8_STAGE(PG8_SB(0, 0), cB, voffB); PG8_STAGE(PG8_SA(0, 0), cA, voffA); PG8_STAGE(PG8_SB(0, 1), cB + hstepB, voffB); PG8_STAGE(PG8_SA(0, 1), cA + hstepA, voffA);
        if (wr == 1) PG8_BAR;
        PG8_WAIT_V(4); PG8_BAR;
        PG8_STAGE(PG8_SB(1, 0), cB + kstep, voffB); PG8_STAGE(PG8_SA(1, 0), cA + kstep, voffA); PG8_STAGE(PG8_SB(1, 1), cB + hstepB + kstep, voffB);
        PG8_WAIT_V(6); PG8_BAR;
    }
    for (;;) {
        const bool has_next = S.next(ui + 1, nxt);
        const char* nA = has_next ? (const char*)g.A + (size_t)nxt.pm * tstepA + (size_t)nxt.ko * 2 : cA; const char* nB = has_next ? (const char*)g.Bt + (size_t)nxt.pn * tstepB + (size_t)nxt.ko * 2 : cB;
        for (int t = 0; t < nt; t += 2) {
            const bool last = (t == nt - 2);
            const char* a1 = cA + (size_t)(t + 1) * kstep;
            const char* a2 = last ? nA : cA + (size_t)(t + 2) * kstep; const char* b2 = last ? nB : cB + (size_t)(t + 2) * kstep;
            const char* a3 = a2 + kstep; const char* b3 = b2 + kstep;
            if (last && has_next) S.a_ready(nxt);
            if constexpr (SP2) {
            PG8_LDB(B0, 0, 0); PG8_LDB(B1, 0, 1); PG8_SCHED; PG8_LDA(At, 0, 0); PG8_STAGE(PG8_SA(1, 1), a1 + hstepA, voffA);
            PG8_WAIT_V(8); PG8_WAIT_L(0); PG8_BAR; PG8_MMA(0, 0, At, B0); PG8_MMA(0, 1, At, B1); PG8_BAR; PG8_SCHED;
            PG8_LDA(At, 0, 1); PG8_STAGE(PG8_SB(0, 0), b2, voffB); PG8_STAGE(PG8_SB(0, 1), b2 + hstepB, voffB); PG8_STAGE(PG8_SA(0, 0), a2, voffA);
            PG8_WAIT_V(8); PG8_WAIT_L(0); PG8_BAR; PG8_MMA(1, 0, At, B0); PG8_MMA(1, 1, At, B1); PG8_BAR; PG8_SCHED;
            PG8_LDB(B0, 1, 0); PG8_LDB(B1, 1, 1); PG8_SCHED; PG8_LDA(At, 1, 0); PG8_STAGE(PG8_SA(0, 1), a2 + hstepA, voffA);
            PG8_WAIT_V(8); PG8_WAIT_L(0); PG8_BAR; PG8_MMA(0, 0, At, B0); PG8_MMA(0, 1, At, B1); PG8_BAR; PG8_SCHED;
            PG8_LDA(At, 1, 1); PG8_STAGE(PG8_SB(1, 0), b3, voffB); PG8_STAGE(PG8_SB(1, 1), b3 + hstepB, voffB); PG8_STAGE(PG8_SA(1, 0), a3, voffA);
            PG8_WAIT_V(8); PG8_WAIT_L(0); PG8_BAR; PG8_MMA(1, 0, At, B0); PG8_MMA(1, 1, At, B1); PG8_BAR; PG8_SCHED;
            } else {
            PG8_LDB(B0, 0, 0); PG8_SCHED; PG8_LDA(At, 0, 0); PG8_STAGE(PG8_SA(1, 1), a1 + hstepA, voffA);
            PG8_WAIT_L(8); PG8_BAR; PG8_WAIT_L(0); PG8_MMA(0, 0, At, B0); PG8_BAR; PG8_SCHED;
            PG8_LDB(B1, 0, 1); PG8_STAGE(PG8_SB(0, 0), b2, voffB);
            PG8_BAR; PG8_WAIT_L(0); PG8_MMA(0, 1, At, B1); PG8_BAR;
            PG8_LDA(At, 0, 1); PG8_STAGE(PG8_SA(0, 0), a2, voffA);
            PG8_BAR; PG8_WAIT_L(0); PG8_MMA(1, 0, At, B0); PG8_BAR; PG8_SCHED;
            PG8_STAGE(PG8_SB(0, 1), b2 + hstepB, voffB);
            PG8_WAIT_V(6); PG8_BAR; PG8_MMA(1, 1, At, B1); PG8_BAR;
            PG8_LDB(B0, 1, 0); PG8_SCHED; PG8_LDA(At, 1, 0); PG8_STAGE(PG8_SA(0, 1), a2 + hstepA, voffA);
            PG8_WAIT_L(8); PG8_BAR; PG8_WAIT_L(0); PG8_MMA(0, 0, At, B0); PG8_BAR; PG8_SCHED;
            PG8_LDB(B1, 1, 1); PG8_STAGE(PG8_SB(1, 0), b3, voffB);
            PG8_BAR; PG8_WAIT_L(0); PG8_MMA(0, 1, At, B1); PG8_BAR;
            PG8_LDA(At, 1, 1); PG8_STAGE(PG8_SA(1, 0), a3, voffA);
            PG8_BAR; PG8_WAIT_L(0); PG8_MMA(1, 0, At, B0); PG8_BAR; PG8_SCHED;
            PG8_STAGE(PG8_SB(1, 1), b3 + hstepB, voffB);
            PG8_WAIT_V(6); PG8_BAR; PG8_MMA(1, 1, At, B1); PG8_BAR;
            }
        }
        if constexpr (ALIGN_EPI) { if (wr == 0) PG8_BAR; }
        if constexpr (F8) {
            asm volatile("s_nop 15\n\ts_nop 15\n\ts_nop 7" : "+v"(acc[0][0][0][0]), "+v"(acc[0][0][0][1]), "+v"(acc[0][0][1][0]), "+v"(acc[0][0][1][1]), "+v"(acc[0][0][2][0]), "+v"(acc[0][0][2][1]), "+v"(acc[0][0][3][0]), "+v"(acc[0][0][3][1]), "+v"(acc[0][1][0][0]), "+v"(acc[0][1][0][1]), "+v"(acc[0][1][1][0]), "+v"(acc[0][1][1][1]), "+v"(acc[0][1][2][0]), "+v"(acc[0][1][2][1]), "+v"(acc[0][1][3][0]), "+v"(acc[0][1][3][1]));
            asm volatile("" : "+v"(acc[1][0][0][0]), "+v"(acc[1][0][0][1]), "+v"(acc[1][0][1][0]), "+v"(acc[1][0][1][1]), "+v"(acc[1][0][2][0]), "+v"(acc[1][0][2][1]), "+v"(acc[1][0][3][0]), "+v"(acc[1][0][3][1]), "+v"(acc[1][1][0][0]), "+v"(acc[1][1][0][1]), "+v"(acc[1][1][1][0]), "+v"(acc[1][1][1][1]), "+v"(acc[1][1][2][0]), "+v"(acc[1][1][2][1]), "+v"(acc[1][1][3][0]), "+v"(acc[1][1][3][1])); }
        if constexpr (!Epi::AFTER_DRAIN) { E(acc, cur, wr, wc, fr, fq); S.done(cur); }
        if (!has_next) break;
        if (S.zero_after(cur)) {
#pragma unroll
        for (int a = 0; a < 2; ++a)
#pragma unroll
            for (int b = 0; b < 2; ++b)
#pragma unroll
                for (int m = 0; m < 4; ++m)
#pragma unroll
                    for (int n = 0; n < 2; ++n) acc[a][b][m][n] = (f32x4){0.f, 0.f, 0.f, 0.f};
        }
        cur = nxt; cA = nA; cB = nB; ++ui;
        if constexpr (ALIGN_EPI) { if (wr == 1) PG8_BAR; }
    }
    PG8_WAIT_V(0);
    if constexpr (!ALIGN_EPI) { if (wr == 0) PG8_BAR; }
    PG8_BAR;
    if constexpr (Epi::AFTER_DRAIN) { E.fused(acc, cur, wr, wc, fr, fq, lds, wid, lane); S.done(cur); }
#undef PG8_SA
#undef PG8_SB
#undef PG8_STAGE
#undef PG8_LDA
#undef PG8_LDB
#undef PG8_MMA
#undef PG8_CAT8
#undef PG8_WAIT_V
#undef PG8_WAIT_L
#undef PG8_BAR
#undef PG8_SCHED
}
}
#ifndef REP_IN
#define REP_IN 1
#endif
#ifndef REP_BR
#define REP_BR 1
#endif
#ifndef REP_OUT
#define REP_OUT 1
#endif
#ifndef REP_FIN
#define REP_FIN 1
#endif
#ifndef GEMM_STREAM
#define GEMM_STREAM 3
#endif
#ifndef REP_J0
#define REP_J0 1
#endif
#ifndef REP_J1
#define REP_J1 1
#endif
#ifndef REP_J2
#define REP_J2 1
#endif
#ifndef REP_SCAN
#define REP_SCAN 1
#endif
#ifndef REP_P0
#define REP_P0 1
#endif
#ifndef SEG0
#define SEG0 0
#endif
#ifndef GATELESS
#define GATELESS 1
#endif
#ifndef GEMM_ONEUNIT
#define GEMM_ONEUNIT 1
#endif
#ifndef DIAGSEL
#define DIAGSEL 4095
#endif
#ifndef NO_T4
#define NO_T4 0
#endif
#ifndef NO_T5
#define NO_T5 0
#endif
#ifndef NO_T6
#define NO_T6 0
#endif
#ifndef DIAG_SIMPLE
#define DIAG_SIMPLE 0
#endif
#ifndef GEMM_ALIGN
#define GEMM_ALIGN true
#endif
#ifndef GEMM_SP2
#define GEMM_SP2 true
#endif
#ifndef PHM
#define PHM 127
#endif
#ifndef JOBM
#define JOBM 7
#endif

#define GAS __attribute__((address_space(1)))
#define LAS __attribute__((address_space(3)))
typedef unsigned short bf16;
typedef short bf16x8 __attribute__((ext_vector_type(8)));
typedef short bf16x4 __attribute__((ext_vector_type(4)));
typedef float f32x4 __attribute__((ext_vector_type(4)));
typedef unsigned u32x4 __attribute__((ext_vector_type(4)));
typedef unsigned u32x2 __attribute__((ext_vector_type(2)));
#define DI __device__ __forceinline__
#define LDS_WAIT() asm volatile("s_waitcnt lgkmcnt(0)" ::: "memory")
typedef float f32x2_t __attribute__((ext_vector_type(2)));
typedef __bf16 bf16x2_t __attribute__((ext_vector_type(2)));
DI unsigned pk2(float lo, float hi) { const f32x2_t v = {lo, hi}; const bf16x2_t b = __builtin_convertvector(v, bf16x2_t); return __builtin_bit_cast(unsigned, b); }
DI unsigned pk4f8(float a, float b, float c, float d) { int w = 0; w = __builtin_amdgcn_cvt_pk_fp8_f32(a, b, w, false); w = __builtin_amdgcn_cvt_pk_fp8_f32(c, d, w, true); return (unsigned)w; }
DI unsigned pk4u8(float a, float b, float c, float d) { unsigned w = 0u; w = __builtin_amdgcn_cvt_pk_u8_f32(a, 0, w); w = __builtin_amdgcn_cvt_pk_u8_f32(b, 1, w); w = __builtin_amdgcn_cvt_pk_u8_f32(c, 2, w); w = __builtin_amdgcn_cvt_pk_u8_f32(d, 3, w); return w; }
DI float ub0(unsigned w) { return (float)(w & 0xffu); }
DI float ub1(unsigned w) { return (float)((w >> 8) & 0xffu); }
DI float ub2(unsigned w) { return (float)((w >> 16) & 0xffu); }
DI float ub3(unsigned w) { return (float)(w >> 24); }
DI bf16 f2bf(float f) { return (bf16)(pk2(f, 0.f) & 0xffffu); }
DI float bf2f(unsigned b) { return __uint_as_float(b << 16); }
DI float bflo(unsigned w) { return __uint_as_float(w << 16); }
DI float bfhi(unsigned w) { return __uint_as_float(w & 0xffff0000u); }
DI float sigmoidf_(float x) { return __builtin_amdgcn_rcpf(1.0f + __expf(-x)); }
DI float siluf_(float x) { return x * sigmoidf_(x); }
DI float wave_sum(float v) {
#pragma unroll
    for (int o = 1; o < 64; o <<= 1) v += __shfl_xor(v, o);
    return v;
}
#define MFMA16(a, b, c) __builtin_amdgcn_mfma_f32_16x16x32_bf16((a), (b), (c), 0, 0, 0)

constexpr int DM = 4096, MP = 8192, MS_ = 256, MT = 8448;
constexpr int BW = 2048;
constexpr int NIN = 30976;
constexpr int KBR = 6144;
constexpr float EPS = 1e-6f;
constexpr int NWAVES = 8, NTHR = 512;
constexpr int LDS_BYTES = 147456;
constexpr int MISC_OFF = LDS_BYTES - 256;

constexpr size_t O_YP = 0, O_YS = 33554432, O_HGP = 34603008, O_HGS = 36700160, O_LHP = 40894464, O_LHS = 40910848,
                 O_LCP = 40943616, O_LCS = 40992768, O_GLP = 41091072, O_GLS = 45285376, O_END = 53673984;

constexpr size_t MiB = 1u << 20;
constexpr size_t alup(size_t x) { return (x + MiB - 1) / MiB * MiB; }
constexpr size_t WS_CTL = 0, CTL_ZERO_BYTES = MiB;
constexpr size_t SZ_WIN = alup((size_t)NIN * DM * 2), SZ_WBR = alup((size_t)DM * KBR * 2), SZ_WOU = alup((size_t)DM * DM * 2);
constexpr size_t WS_WIN = MiB, WS_WBR = WS_WIN + 2 * SZ_WIN, WS_WOU = WS_WBR + 2 * SZ_WBR;
constexpr size_t WS_Z = WS_WOU + 2 * SZ_WOU;
constexpr size_t WS_HQ = WS_Z + alup((size_t)MT * DM * 2);
constexpr size_t WS_HG = WS_HQ + alup((size_t)MT * BW * 2);
constexpr size_t WS_HV = WS_HG + alup((size_t)MT * BW * 4);
constexpr size_t WS_HGATE = WS_HV + alup((size_t)MT * BW * 2);
constexpr size_t WS_LX = WS_HGATE + alup((size_t)MT * BW * 2);
constexpr size_t WS_LGATE = WS_LX + alup((size_t)MT * BW * 4);
constexpr size_t WS_CQ = WS_LGATE + alup((size_t)MT * BW * 2);
constexpr size_t WS_CK = WS_CQ + alup((size_t)MT * 1024 * 2);
constexpr size_t WS_CV = WS_CK + alup((size_t)MT * 1024 * 2);
constexpr size_t WS_CGATE = WS_CV + alup((size_t)MT * BW * 2);
constexpr size_t WS_MG = WS_CGATE + alup((size_t)MT * BW * 2);
constexpr size_t WS_CLR = WS_MG + alup((size_t)MT * 12288 * 2);
constexpr size_t WS_Y = WS_CLR + alup((size_t)MT * 16 * 4);
constexpr size_t WS_OC = WS_Y + alup((size_t)MT * KBR * 2);
constexpr size_t WS_SSQ = WS_OC + alup((size_t)MT * 2 * BW * 4);
constexpr size_t WS_MERGED = WS_SSQ + alup((size_t)MT * 32 * 4);
constexpr size_t WS_MB = WS_MERGED + alup((size_t)MT * DM * 4);
constexpr size_t WS_OUT = WS_MB + alup((size_t)MT * DM * 2);
constexpr size_t WS_X1 = WS_OUT + alup((size_t)MT * DM * 4);
constexpr size_t WS_PB = WS_X1 + alup((size_t)MT * DM * 4);
constexpr size_t WS_PO = WS_PB + alup((size_t)3 * 256 * DM * 4);
constexpr int NCHK = 136;
constexpr size_t WS_GQT = WS_PO + alup((size_t)4 * 256 * DM * 4);
constexpr size_t WS_GKT = WS_GQT + alup((size_t)MT * 1024 * 2);
constexpr size_t WS_GKH = WS_GKT + alup((size_t)MT * 1024 * 2);
constexpr size_t WS_GER = WS_GKH + alup((size_t)NCHK * 1024 * 64 * 2);
constexpr size_t WS_GEB = WS_GER + alup((size_t)NCHK * 1024 * 4);
constexpr size_t WS_Z8 = WS_GEB + alup((size_t)NCHK * 1024 * 4);
constexpr size_t SZ_W8 = alup((size_t)12288 * DM);
constexpr size_t WS_W8 = WS_Z8 + alup((size_t)MT * DM);
constexpr size_t WS_END = WS_W8 + 2 * SZ_W8;
constexpr int CW_BAR = 4096;
constexpr int CW_TEAM = 16384;

#define XB_TMO      128
#define XB_XCNT(j)  (256  + 64 * (j))
#define XB_XSUB(j)  (1280 + 64 * (j))
#define XB_XGEN(j)  (2304 + 64 * (j))
#define XB_TOP      3328
#define XB_TOPGEN   3392
#define XCD_BAR_WORDS 3456
#define XB_SPIN_CAP (1u << 18)
__device__ __forceinline__ unsigned xb_ld(unsigned* p)              { return __hip_atomic_load(p, __ATOMIC_RELAXED, __HIP_MEMORY_SCOPE_AGENT); }
__device__ __forceinline__ unsigned xb_add(unsigned* p, unsigned v) { return __hip_atomic_fetch_add(p, v, __ATOMIC_RELAXED, __HIP_MEMORY_SCOPE_AGENT); }
__device__ __forceinline__ unsigned xb_xcc_id() { return (unsigned)__builtin_amdgcn_s_getreg((3 << 11) | 20) & 0xFu; }
#define XB_SPIN(cond, bar) do { unsigned _sp = 0; while (cond) { __builtin_amdgcn_s_sleep(1); \
    if ((++_sp & 255u) == 0u) { if (xb_ld(&(bar)[XB_TMO])) break; if (_sp > XB_SPIN_CAP) { atomicAdd(&(bar)[XB_TMO], 1u); break; } } } } while (0)
struct XcdBarrier { unsigned* bar; unsigned x; volatile LAS unsigned* st; };
__device__ __forceinline__ XcdBarrier xcd_barrier_post(unsigned* bar, volatile LAS unsigned* st) {
    XcdBarrier b; b.bar = bar; b.x = xb_xcc_id(); b.st = st;
    if (threadIdx.x == 0) (void)xb_add(&bar[XB_XCNT(b.x)], 1u);
    return b;
}
__device__ __forceinline__ void xcd_barrier_complete(unsigned* bar, unsigned x, unsigned& nloc, unsigned& nx) {
    const unsigned G = gridDim.x * gridDim.y * gridDim.z;
    unsigned sum, cnt, mine, sp = 0u;
    for (;;) {
        sum = 0u; cnt = 0u; mine = 0u;
#pragma unroll
        for (unsigned j = 0; j < 16; ++j) { const unsigned c = xb_ld(&bar[XB_XCNT(j)]); sum += c; cnt += (c > 0u) ? 1u : 0u; mine = (j == x) ? c : mine; }
        if (sum == G) break;
        __builtin_amdgcn_s_sleep(1);
        if ((++sp & 255u) == 0u) { if (xb_ld(&bar[XB_TMO])) break; if (sp > XB_SPIN_CAP) { atomicAdd(&bar[XB_TMO], 1u); break; } }
    }
    nloc = mine > 0u ? mine : 1u; nx = cnt > 0u ? cnt : 1u;
}
__device__ __forceinline__ void xcd_barrier(const XcdBarrier& b) {
    asm volatile("s_waitcnt vmcnt(0)" ::: "memory");
    __syncthreads();
    if (threadIdx.x == 0) {
        unsigned* bar = b.bar;
        __builtin_amdgcn_s_waitcnt(0);
        unsigned nloc = b.st[0], nx = b.st[1];
        if (nloc == 0u) { xcd_barrier_complete(bar, b.x, nloc, nx); b.st[0] = nloc; b.st[1] = nx; }
        const unsigned old = xb_add(&bar[XB_XSUB(b.x)], 1u);
        const unsigned gen = old / nloc;
        if (old + 1u == (gen + 1u) * nloc) {
            __builtin_amdgcn_fence(__ATOMIC_RELEASE, "agent");
            asm volatile("s_waitcnt vmcnt(0)" ::: "memory");
            const unsigned og = xb_add(&bar[XB_TOP], 1u);
            const unsigned tg = og / nx;
            if (og + 1u == (tg + 1u) * nx) xb_add(&bar[XB_TOPGEN], 1u);
            else XB_SPIN(xb_ld(&bar[XB_TOPGEN]) == tg, bar);
            __builtin_amdgcn_fence(__ATOMIC_ACQUIRE, "agent");
            xb_add(&bar[XB_XGEN(b.x)], 1u);
            asm volatile("s_waitcnt vmcnt(0)" ::: "memory");
        } else {
            XB_SPIN(xb_ld(&bar[XB_XGEN(b.x)]) == gen, bar);
            __builtin_amdgcn_fence(__ATOMIC_ACQUIRE, "agent");
            asm volatile("s_waitcnt vmcnt(0)" ::: "memory");
        }
    }
    __syncthreads();
}

typedef pg8::f32x4 af4;
struct EpiInProj {
    static constexpr bool PERM = true, AFTER_DRAIN = true;
    DI void fused(af4 (&acc)[2][2][4][2], const pg8::Unit& u, int wr, int wc, int fr, int fq, LAS unsigned char*, int, int) const { (*this)(acc, u, wr, wc, fr, fq); }
    bf16 *HQ, *HV, *HGATE, *LGATE, *CQ, *CK, *CV, *CGATE; unsigned char* MG; float *HG, *LX, *CLR; const float* lbl; int layer; float mgs;
    template <int T> DI void body(const af4 (&acc)[2][2][4][2], void* base, const int ld, const int row0, const int col0) const {
        af4 lbv[2][2];
        if (T == 5) {
#pragma unroll
            for (int bj = 0; bj < 2; ++bj)
#pragma unroll
                for (int hh = 0; hh < 2; ++hh) { const af4 a0 = *(const af4*)(lbl + col0 + bj * 128 + 4 * hh), a1 = *(const af4*)(lbl + BW + col0 + bj * 128 + 4 * hh);
#pragma unroll
                    for (int j = 0; j < 4; ++j) { const float mx = fmaxf(a0[j], a1[j]); const float e0 = __expf(a0[j] - mx), e1 = __expf(a1[j] - mx); lbv[bj][hh][j] = layer ? e1 / (e0 + e1) : 0.f; } }
        }
        if (T == 2) {
            int c0 = col0; asm volatile("" : "+v"(c0)); const int odd = (c0 >> 3) & 1;
#pragma unroll
            for (int ai = 0; ai < 2; ++ai)
#pragma unroll
                for (int mp = 0; mp < 2; ++mp)
#pragma unroll
                    for (int bj = 0; bj < 2; ++bj) {
                        unsigned px[2], py[2];
#pragma unroll
                        for (int h = 0; h < 2; ++h) { af4 v0 = acc[ai][bj][2 * mp + h][0], v1 = acc[ai][bj][2 * mp + h][1];
#pragma unroll
                            for (int j = 0; j < 4; ++j) { v0[j] = fmaxf(sigmoidf_(v0[j] * mgs) * 255.0f + 0.5f, 1.0f); v1[j] = fmaxf(sigmoidf_(v1[j] * mgs) * 255.0f + 0.5f, 1.0f); }
                            px[h] = pk4u8(v0[0], v0[1], v0[2], v0[3]); py[h] = pk4u8(v1[0], v1[1], v1[2], v1[3]); __builtin_amdgcn_sched_barrier(0); }
                        const auto rx = __builtin_amdgcn_permlane16_swap(px[0], px[1], false, false); const auto ry = __builtin_amdgcn_permlane16_swap(py[0], py[1], false, false);
                        u32x4 o; o.x = rx[0]; o.y = ry[0]; o.z = rx[1]; o.w = ry[1];
                        *(u32x4*)((unsigned char*)base + (size_t)(row0 + ai * 128 + (2 * mp + odd) * 16) * ld + (c0 - 8 * odd) + bj * 128) = o;
                    }
            return;
        }
#pragma unroll
        for (int ai = 0; ai < 2; ++ai)
#pragma unroll
            for (int m = 0; m < 4; ++m) {
                const size_t rowoff = (size_t)(row0 + ai * 128 + m * 16) * ld;
#pragma unroll
                for (int bj = 0; bj < 2; ++bj) {
                    af4 v0 = acc[ai][bj][m][0], v1 = acc[ai][bj][m][1];
                    const int col = col0 + bj * 128;
                    if (T <= 3) {
#pragma unroll
                        for (int j = 0; j < 4; ++j) {
                            if (T == 1) { v0[j] = siluf_(v0[j]); v1[j] = siluf_(v1[j]); }
                            if (T == 2) { v0[j] = sigmoidf_(v0[j] * mgs); v1[j] = sigmoidf_(v1[j] * mgs); }
                            if (T == 3) { v0[j] *= 0.0625f; v1[j] *= 0.0625f; }
                        }
                        if (T == 2) {
#pragma unroll
                            for (int j = 0; j < 4; ++j) { v0[j] = fmaxf(v0[j] * 255.0f + 0.5f, 1.0f); v1[j] = fmaxf(v1[j] * 255.0f + 0.5f, 1.0f); }
                            u32x2 o; o.x = pk4u8(v0[0], v0[1], v0[2], v0[3]); o.y = pk4u8(v1[0], v1[1], v1[2], v1[3]);
                            *(u32x2*)((unsigned char*)base + rowoff + col) = o;
                        } else {
                        u32x4 o; o.x = pk2(v0[0], v0[1]); o.y = pk2(v0[2], v0[3]); o.z = pk2(v1[0], v1[1]); o.w = pk2(v1[2], v1[3]);
                        *(u32x4*)((bf16*)base + rowoff + col) = o; }
                    } else if (T == 4) {
                        float* p = (float*)base + rowoff + col; *(af4*)p = v0; *(af4*)(p + 4) = v1;
                    } else if (T == 5) {
#pragma unroll
                        for (int j = 0; j < 4; ++j) {
                            const float l0 = lbv[bj][0][j], l1 = lbv[bj][1][j];
                            v0[j] = __logf(fmaxf(l0 + (1.0f - l0) * sigmoidf_(v0[j]), 1e-6f));
                            v1[j] = __logf(fmaxf(l1 + (1.0f - l1) * sigmoidf_(v1[j]), 1e-6f));
                        }
                        float* p = (float*)base + rowoff + col; *(af4*)p = v0; *(af4*)(p + 4) = v1;
                    } else {
                        if (col < 16) { float* p = (float*)base + rowoff + col; *(af4*)p = v0; *(af4*)(p + 4) = v1; }
                    }
                }
            }
    }
    DI void operator()(const af4 (&acc)[2][2][4][2], const pg8::Unit& u, int wr, int wc, int fr, int fq) const {
        const int row0 = u.pm * 256 + wr * 64 + fr, cl = wc * 32 + 8 * fq, pn = u.pn;
        if (pn < 8)        body<1>(acc, HQ, BW, row0, pn * 256 + cl);
        else if (pn < 16)  body<(NO_T5 ? (NO_T4 ? 0 : 4) : 5)>(acc, HG, BW, row0, (pn - 8) * 256 + cl);
        else if (pn < 24)  body<0>(acc, HV, BW, row0, (pn - 16) * 256 + cl);
        else if (pn < 32)  body<1>(acc, HGATE, BW, row0, (pn - 24) * 256 + cl);
        else if (pn < 40)  body<(NO_T4 ? 0 : 4)>(acc, LX, BW, row0, (pn - 32) * 256 + cl);
        else if (pn < 48)  body<1>(acc, LGATE, BW, row0, (pn - 40) * 256 + cl);
        else if (pn < 52)  body<3>(acc, CQ, 1024, row0, (pn - 48) * 256 + cl);
        else if (pn < 56)  body<0>(acc, CK, 1024, row0, (pn - 52) * 256 + cl);
        else if (pn < 64)  body<0>(acc, CV, BW, row0, (pn - 56) * 256 + cl);
        else if (pn < 72)  body<1>(acc, CGATE, BW, row0, (pn - 64) * 256 + cl);
        else if (pn < 120) body<2>(acc, MG, 12288, row0, (pn - 72) * 256 + cl);
        else               { if (!NO_T6) body<6>(acc, CLR, 16, row0, cl); }
    }
};
struct EpiBranchSeg {
    static constexpr bool PERM = true, AFTER_DRAIN = true;
    const unsigned char* MG; bf16* MB; int seg;
    DI void operator()(af4 (&acc)[2][2][4][2], const pg8::Unit& u, int wr, int wc, int fr, int fq) const { const EpiBranchSeg E2{MG, MB, u.ko / BW}; E2.fused(acc, u, wr, wc, fr, fq, nullptr, 0, 0); }
    DI void fused(af4 (&acc)[2][2][4][2], const pg8::Unit& u, int wr, int wc, int fr, int fq, LAS unsigned char*, int, int) const {
        int fqz = fq; asm volatile("" : "+v"(fqz));
        const int odd = fqz & 1;
        const size_t row0 = (size_t)(u.pm * 256 + wr * 64 + fr); const int col0 = u.pn * 256 + wc * 32 + 8 * fqz;
        const unsigned char* gp = MG + (row0 + 16 * odd) * 12288 + (size_t)seg * DM + (col0 - 8 * odd);
#define EB_PTR(p_) (gp + (size_t)((((p_) >> 2) & 1) * 128 + (((p_) >> 1) & 1) * 32) * 12288 + ((p_) & 1) * 128)
#define EB_SPLIT(L_, G0_, G1_) do { const auto rx_ = __builtin_amdgcn_permlane16_swap((L_).x, (L_).z, false, false); const auto ry_ = __builtin_amdgcn_permlane16_swap((L_).y, (L_).w, false, false); \
            G0_.x = rx_[0]; G0_.y = ry_[0]; G1_.x = rx_[1]; G1_.y = ry_[1]; } while (0)
        if (seg < 2) {
            u32x4 a0 = *(const u32x4*)EB_PTR(0), b0 = *(const u32x4*)(EB_PTR(0) + DM), a1 = *(const u32x4*)EB_PTR(1), b1 = *(const u32x4*)(EB_PTR(1) + DM);
#pragma unroll
            for (int p = 0; p < 8; ++p) {
                u32x4 a2 = a1, b2 = b1;
                if (p + 2 < 8) { a2 = *(const u32x4*)EB_PTR(p + 2); b2 = *(const u32x4*)(EB_PTR(p + 2) + DM); }
                u32x2 ga[2], gb[2]; EB_SPLIT(a0, ga[0], ga[1]); EB_SPLIT(b0, gb[0], gb[1]);
#pragma unroll
                for (int h = 0; h < 2; ++h) {
                    af4& v0 = acc[(p >> 2) & 1][p & 1][((p >> 1) & 1) * 2 + h][0]; af4& v1 = acc[(p >> 2) & 1][p & 1][((p >> 1) & 1) * 2 + h][1];
                    v0[0] *= ub0(ga[h].x) * __builtin_amdgcn_rcpf(ub0(gb[h].x)); v0[1] *= ub1(ga[h].x) * __builtin_amdgcn_rcpf(ub1(gb[h].x));
                    v0[2] *= ub2(ga[h].x) * __builtin_amdgcn_rcpf(ub2(gb[h].x)); v0[3] *= ub3(ga[h].x) * __builtin_amdgcn_rcpf(ub3(gb[h].x));
                    v1[0] *= ub0(ga[h].y) * __builtin_amdgcn_rcpf(ub0(gb[h].y)); v1[1] *= ub1(ga[h].y) * __builtin_amdgcn_rcpf(ub1(gb[h].y));
                    v1[2] *= ub2(ga[h].y) * __builtin_amdgcn_rcpf(ub2(gb[h].y)); v1[3] *= ub3(ga[h].y) * __builtin_amdgcn_rcpf(ub3(gb[h].y));
                    asm volatile("" : "+v"(v0), "+v"(v1) :: "memory");
                }
                asm volatile("" : "+v"(a1), "+v"(b1), "+v"(a2), "+v"(b2) :: "memory");
                a0 = a1; b0 = b1; a1 = a2; b1 = b2;
            }
        } else {
            constexpr float Q = 1.0f / 255.0f;
            u32x4 a0 = *(const u32x4*)EB_PTR(0), a1 = *(const u32x4*)EB_PTR(1);
#pragma unroll
            for (int p = 0; p < 8; ++p) {
                u32x4 a2 = a1;
                if (p + 2 < 8) a2 = *(const u32x4*)EB_PTR(p + 2);
                u32x2 gw[2]; EB_SPLIT(a0, gw[0], gw[1]);
#pragma unroll
                for (int h = 0; h < 2; ++h) {
                    const int m = ((p >> 1) & 1) * 2 + h; const size_t ro = (size_t)(((p >> 2) & 1) * 128 + m * 16);
                    af4 v0 = acc[(p >> 2) & 1][p & 1][m][0], v1 = acc[(p >> 2) & 1][p & 1][m][1];
                    v0[0] *= ub0(gw[h].x) * Q; v0[1] *= ub1(gw[h].x) * Q; v0[2] *= ub2(gw[h].x) * Q; v0[3] *= ub3(gw[h].x) * Q;
                    v1[0] *= ub0(gw[h].y) * Q; v1[1] *= ub1(gw[h].y) * Q; v1[2] *= ub2(gw[h].y) * Q; v1[3] *= ub3(gw[h].y) * Q;
                    u32x4 o; o.x = pk2(v0[0], v0[1]); o.y = pk2(v0[2], v0[3]); o.z = pk2(v1[0], v1[1]); o.w = pk2(v1[2], v1[3]);
                    *(u32x4*)(MB + (row0 + ro) * DM + col0 + (p & 1) * 128) = o;
                }
                asm volatile("" : "+v"(a1), "+v"(a2) :: "memory");
                a0 = a1; a1 = a2;
            }
        }
#undef EB_SPLIT
#undef EB_PTR
    }
};
struct EpiGateSlab {
    static constexpr bool PERM = true, AFTER_DRAIN = true;
    const unsigned char* MG; float* PB; int seg;
    DI void fused(af4 (&acc)[2][2][4][2], const pg8::Unit& u, int wr, int wc, int fr, int fq, LAS unsigned char*, int, int) const {
        const size_t row0 = (size_t)(u.pm * 256 + wr * 64 + fr); const int col0 = u.pn * 256 + wc * 32 + 8 * fq;
        const unsigned char* gp = MG + row0 * 12288 + (size_t)seg * DM + col0;
        float* pb = PB + ((size_t)seg * 256 + (size_t)(wr * 64 + fr)) * DM + col0;
        u32x2 gall[2][4][2];
#pragma unroll
        for (int ai = 0; ai < 2; ++ai)
#pragma unroll
            for (int m = 0; m < 4; ++m)
#pragma unroll
                for (int bj = 0; bj < 2; ++bj) gall[ai][m][bj] = *(const u32x2*)(gp + (size_t)(ai * 128 + m * 16) * 12288 + bj * 128);
#pragma unroll
        for (int ai = 0; ai < 2; ++ai)
#pragma unroll
            for (int m = 0; m < 4; ++m) {
#pragma unroll
                for (int bj = 0; bj < 2; ++bj) {
                    const size_t ro = (size_t)(ai * 128 + m * 16);
                    const u32x2 gw = gall[ai][m][bj]; constexpr float Q = 1.0f / 255.0f;
                    af4 v0 = acc[ai][bj][m][0], v1 = acc[ai][bj][m][1];
                    v0[0] *= ub0(gw.x) * Q; v0[1] *= ub1(gw.x) * Q; v0[2] *= ub2(gw.x) * Q; v0[3] *= ub3(gw.x) * Q;
                    v1[0] *= ub0(gw.y) * Q; v1[1] *= ub1(gw.y) * Q; v1[2] *= ub2(gw.y) * Q; v1[3] *= ub3(gw.y) * Q;
                    float* q = pb + ro * DM + bj * 128; *(af4*)q = v0; *(af4*)(q + 4) = v1;
                    asm volatile("" ::: "memory");
                }
            }
    }
};
struct EpiSimple {
    static constexpr bool PERM = true, AFTER_DRAIN = true;
    DI void fused(af4 (&acc)[2][2][4][2], const pg8::Unit& u, int wr, int wc, int fr, int fq, LAS unsigned char*, int, int) const { (*this)(acc, u, wr, wc, fr, fq); }
    bf16* O; int ldc;
    DI void operator()(const af4 (&acc)[2][2][4][2], const pg8::Unit& u, int wr, int wc, int fr, int fq) const {
        const int row0 = u.pm * 256 + wr * 64 + fr, col0 = u.pn * 256 + wc * 32 + 8 * fq;
#pragma unroll
        for (int ai = 0; ai < 2; ++ai)
#pragma unroll
            for (int m = 0; m < 4; ++m) {
                bf16* rp = O + (size_t)(row0 + ai * 128 + m * 16) * ldc + col0;
#pragma unroll
                for (int bj = 0; bj < 2; ++bj) { af4 v0 = acc[ai][bj][m][0], v1 = acc[ai][bj][m][1];
#pragma unroll
                    for (int j = 0; j < 4; ++j) { v0[j] = siluf_(v0[j]); v1[j] = siluf_(v1[j]); }
                    u32x4 o; o.x = pk2(v0[0], v0[1]); o.y = pk2(v0[2], v0[3]); o.z = pk2(v1[0], v1[1]); o.w = pk2(v1[2], v1[3]); *(u32x4*)(rp + bj * 128) = o; }
            }
    }
};
struct EpiBf {
    static constexpr bool PERM = true, AFTER_DRAIN = true;
    DI void fused(af4 (&acc)[2][2][4][2], const pg8::Unit& u, int wr, int wc, int fr, int fq, LAS unsigned char*, int, int) const { (*this)(acc, u, wr, wc, fr, fq); }
    bf16* O; int ldc;
    DI void operator()(const af4 (&acc)[2][2][4][2], const pg8::Unit& u, int wr, int wc, int fr, int fq) const {
        const int row0 = u.pm * 256 + wr * 64 + fr, col0 = u.pn * 256 + wc * 32 + 8 * fq;
#pragma unroll
        for (int ai = 0; ai < 2; ++ai)
#pragma unroll
            for (int m = 0; m < 4; ++m) {
                bf16* rp = O + (size_t)(row0 + ai * 128 + m * 16) * ldc + col0;
#pragma unroll
                for (int bj = 0; bj < 2; ++bj) { const af4 v0 = acc[ai][bj][m][0], v1 = acc[ai][bj][m][1];
                    u32x4 o; o.x = pk2(v0[0], v0[1]); o.y = pk2(v0[2], v0[3]); o.z = pk2(v1[0], v1[1]); o.w = pk2(v1[2], v1[3]); *(u32x4*)(rp + bj * 128) = o; }
            }
    }
};
struct EpiF32 {
    static constexpr bool PERM = true, AFTER_DRAIN = true;
    DI void fused(af4 (&acc)[2][2][4][2], const pg8::Unit& u, int wr, int wc, int fr, int fq, LAS unsigned char*, int, int) const { (*this)(acc, u, wr, wc, fr, fq); }
    float* C; int ldc;
    DI void operator()(const af4 (&acc)[2][2][4][2], const pg8::Unit& u, int wr, int wc, int fr, int fq) const {
        const int row0 = u.pm * 256 + wr * 64 + fr, col0 = u.pn * 256 + wc * 32 + 8 * fq;
#pragma unroll
        for (int ai = 0; ai < 2; ++ai)
#pragma unroll
            for (int m = 0; m < 4; ++m) {
                float* rp = C + (size_t)(row0 + ai * 128 + m * 16) * ldc + col0;
#pragma unroll
                for (int bj = 0; bj < 2; ++bj) { *(af4*)(rp + bj * 128) = acc[ai][bj][m][0]; *(af4*)(rp + bj * 128 + 4) = acc[ai][bj][m][1]; }
            }
    }
};

struct OneUnit {
    pg8::StaticOrder S; int i;
    DI bool next(int k, pg8::Unit& u) const { return k == 0 ? S.next(i, u) : false; }
    DI void a_ready(const pg8::Unit&) const {}
    DI void done(const pg8::Unit&) const {}
    DI bool zero_after(const pg8::Unit&) const { return true; }
};
struct InOrderA {
    pg8::StaticOrder S;
    DI bool next(int i, pg8::Unit& u) const { if (!S.next(i, u)) return false; if (u.pn == 72) u.pn = 120; return true; }
    DI void a_ready(const pg8::Unit&) const {}
    DI void done(const pg8::Unit&) const {}
    DI bool zero_after(const pg8::Unit&) const { return true; }
};
struct InOrder8 {
    pg8::StaticOrder S;
    DI bool next(int i, pg8::Unit& u) const { if (!S.next(i, u)) return false; u.pn += 72; return true; }
    DI void a_ready(const pg8::Unit&) const {}
    DI void done(const pg8::Unit&) const {}
    DI bool zero_after(const pg8::Unit&) const { return true; }
};
struct BranchOrder {
    pg8::StaticOrder S;
    DI bool next(int i, pg8::Unit& u) const { const int t = i / 3; if (!S.next(t, u)) return false; u.ko = (i - 3 * t) * BW; return true; }
    DI void a_ready(const pg8::Unit&) const {}
    DI void done(const pg8::Unit&) const {}
    DI bool zero_after(const pg8::Unit& u) const { return u.ko == 2 * BW; }
};
struct FixedUnit {
    pg8::Unit u0;
    DI bool next(int k, pg8::Unit& u) const { u = u0; return k == 0; }
    DI void a_ready(const pg8::Unit&) const {}
    DI void done(const pg8::Unit&) const {}
    DI bool zero_after(const pg8::Unit&) const { return true; }
};
DI void team_barrier(unsigned* cnt, unsigned n) {
    asm volatile("s_waitcnt vmcnt(0)" ::: "memory");
    __syncthreads();
    if (threadIdx.x == 0) {
        __builtin_amdgcn_fence(__ATOMIC_RELEASE, "agent");
        asm volatile("s_waitcnt vmcnt(0)" ::: "memory");
        (void)xb_add(cnt, 1u);
        unsigned sp = 0u;
        while (xb_ld(cnt) < n) { __builtin_amdgcn_s_sleep(2); if (++sp > (1u << 20)) break; }
        __builtin_amdgcn_fence(__ATOMIC_ACQUIRE, "agent");
        asm volatile("s_waitcnt vmcnt(0)" ::: "memory");
    }
    __syncthreads();
}
DI void team_arrive(unsigned* cnt) {
    asm volatile("s_waitcnt vmcnt(0)" ::: "memory");
    __syncthreads();
    if (threadIdx.x == 0) { __builtin_amdgcn_fence(__ATOMIC_RELEASE, "agent"); asm volatile("s_waitcnt vmcnt(0)" ::: "memory"); (void)xb_add(cnt, 1u); }
}
DI void zero_acc(af4 (&acc)[2][2][4][2]) {
#pragma unroll
    for (int a = 0; a < 2; ++a)
#pragma unroll
        for (int b = 0; b < 2; ++b)
#pragma unroll
            for (int mm = 0; mm < 4; ++mm)
#pragma unroll
                for (int n = 0; n < 2; ++n) acc[a][b][mm][n] = (af4){0.f, 0.f, 0.f, 0.f};
}
template <class E> struct NoDrain : E { static constexpr bool AFTER_DRAIN = false; };
template <class Epi> DI void gemm_stream(LAS unsigned char* lds, const pg8::Gemm& g, const pg8::StaticOrder& S, const Epi& E) {
    af4 acc[2][2][4][2]; zero_acc(acc); const NoDrain<Epi> E2{E};
    pg8::gemm_phase<NoDrain<Epi>, pg8::StaticOrder, GEMM_ALIGN, GEMM_SP2>(lds, g, S, E2, acc);
}
template <class Epi> DI void gemm_units(LAS unsigned char* lds, const pg8::Gemm& g, const pg8::StaticOrder& S, const Epi& E) {
    pg8::Unit u;
    for (int i = 0; S.next(i, u); ++i) { af4 acc[2][2][4][2]; zero_acc(acc); OneUnit O{S, i}; pg8::gemm_phase<Epi, OneUnit, false, GEMM_SP2>(lds, g, O, E, acc); }
}
DI int win_src_col(int n) { return n < 16384 ? n : (n < 30720 ? n + 16 : (n < 30736 ? n - 30720 + 16384 : -1)); }
template <bool WIN> DI void tr_item(LAS unsigned char* lds, const float* W, int ldsrc, bf16* WT, size_t ldd, int k0, int n0, int dcol0, int lane) {
    const int n = n0 + 2 * lane;
    const int sc = WIN ? win_src_col(n) : n;
    const unsigned so = (unsigned)(sc >= 0 ? sc : 0);
    f32x2_t v[64];
#pragma unroll
    for (int i = 0; i < 64; ++i) { const float* rowp = W + (size_t)(k0 + i) * ldsrc; v[i] = *(const f32x2_t*)(rowp + so); }
    if (sc < 0) {
#pragma unroll
        for (int i = 0; i < 64; ++i) v[i] = (f32x2_t){0.f, 0.f};
    }
    LAS unsigned char* slab = lds + __builtin_amdgcn_readfirstlane((int)(threadIdx.x >> 6)) * 16384;
    LAS u32x4* w0 = (LAS u32x4*)(slab + lane * 256);
#pragma unroll
    for (int j = 0; j < 8; ++j) { u32x4 o; o.x = pk2(v[8 * j].x, v[8 * j + 1].x); o.y = pk2(v[8 * j + 2].x, v[8 * j + 3].x); o.z = pk2(v[8 * j + 4].x, v[8 * j + 5].x); o.w = pk2(v[8 * j + 6].x, v[8 * j + 7].x); w0[j] = o; }
#pragma unroll
    for (int j = 0; j < 8; ++j) { u32x4 o; o.x = pk2(v[8 * j].y, v[8 * j + 1].y); o.y = pk2(v[8 * j + 2].y, v[8 * j + 3].y); o.z = pk2(v[8 * j + 4].y, v[8 * j + 5].y); o.w = pk2(v[8 * j + 6].y, v[8 * j + 7].y); w0[8 + j] = o; }
    bf16* dst = WT + (size_t)(n0 + (lane >> 3)) * ldd + dcol0 + k0 + (lane & 7) * 8;
#pragma unroll
    for (int s_ = 0; s_ < 16; ++s_) { const u32x4 o = *(const LAS u32x4*)(slab + s_ * 1024 + lane * 16); *(u32x4*)(dst + (size_t)(8 * s_) * ldd) = o; }
}
DI void tr_item8(LAS unsigned char* lds, const float* W, int ldsrc, unsigned char* W8, int k0, int nl0, int lane) {
    const unsigned so = (unsigned)(18448 + nl0 + lane);
    float v[128];
#pragma unroll
    for (int i = 0; i < 128; ++i) { const float* rowp = W + (size_t)(k0 + i) * ldsrc; v[i] = rowp[so]; }
    LAS unsigned char* slab = lds + __builtin_amdgcn_readfirstlane((int)(threadIdx.x >> 6)) * 16384;
    LAS u32x4* w0 = (LAS u32x4*)(slab + lane * 128);
#pragma unroll
    for (int j = 0; j < 8; ++j) { u32x4 o; o.x = pk4f8(v[16 * j] * 64.f, v[16 * j + 1] * 64.f, v[16 * j + 2] * 64.f, v[16 * j + 3] * 64.f); o.y = pk4f8(v[16 * j + 4] * 64.f, v[16 * j + 5] * 64.f, v[16 * j + 6] * 64.f, v[16 * j + 7] * 64.f);
        o.z = pk4f8(v[16 * j + 8] * 64.f, v[16 * j + 9] * 64.f, v[16 * j + 10] * 64.f, v[16 * j + 11] * 64.f); o.w = pk4f8(v[16 * j + 12] * 64.f, v[16 * j + 13] * 64.f, v[16 * j + 14] * 64.f, v[16 * j + 15] * 64.f); w0[j] = o; }
    unsigned char* dst = W8 + (size_t)(nl0 + (lane >> 3)) * DM + k0 + (lane & 7) * 16;
#pragma unroll
    for (int s_ = 0; s_ < 8; ++s_) { const u32x4 o = *(const LAS u32x4*)(slab + s_ * 1024 + lane * 16); *(u32x4*)(dst + (size_t)(8 * s_) * DM) = o; }
}
constexpr int CV_INB = 64 * 146, CV_IN8 = 32 * 192, CV_IN = CV_INB + CV_IN8, CV_BR = 3 * 32 * 32, CV_OU = 64 * 32, CV_L = CV_IN + CV_BR + CV_OU;
#ifndef CVX_ITEMS
#define CVX_ITEMS 5000
#endif
constexpr int CVX = CVX_ITEMS;
DI void convert_items(LAS unsigned char* lds, const float* w_in, const float* w_branch, const float* w_out, unsigned char* ws, int l, int it0, int it1, int gw, int NGW, int lane) {
    for (int it = it0 + gw; it < it1; it += NGW) {
        int r = it;
        if (r < CV_INB) { const int kb = r / 146, nb = r % 146; const int n0 = nb < 144 ? nb * 128 : 30720 + (nb - 144) * 128;
            tr_item<true>(lds, w_in + (size_t)l * DM * 30736, 30736, (bf16*)(ws + WS_WIN + l * SZ_WIN), DM, kb * 64, n0, 0, lane); continue; }
        r -= CV_INB;
        if (r < CV_IN8) { const int kb = r / 192, nb = r % 192;
            tr_item8(lds, w_in + (size_t)l * DM * 30736, 30736, ws + WS_W8 + l * SZ_W8, kb * 128, nb * 64, lane); continue; }
        r -= CV_IN8;
        if (r < CV_BR) { const int n = r / (32 * 32), rr = r % (32 * 32), kb = rr / 32, nb = rr % 32;
            tr_item<false>(lds, w_branch + ((size_t)l * 3 + n) * BW * DM, DM, (bf16*)(ws + WS_WBR + l * SZ_WBR), KBR, kb * 64, nb * 128, n * BW, lane); continue; }
        r -= CV_BR;
        { const int kb = r / 32, nb = r % 32;
            tr_item<false>(lds, w_out + (size_t)l * DM * DM, DM, (bf16*)(ws + WS_WOU + l * SZ_WOU), DM, kb * 64, nb * 128, 0, lane); }
    }
}
DI void tail_convert(LAS unsigned char* lds, const float* w_in, const float* w_branch, const float* w_out, unsigned char* ws, int l, int it0, int it1, int nunits, int G, int bx, int wave, int lane_in) {
    int lane = lane_in; asm volatile("" : "+v"(lane));
    const int rounds = (nunits + G - 1) / G, busy = nunits - (rounds - 1) * G, idle = G - busy;
    if (idle > 0) { if (bx >= busy) convert_items(lds, w_in, w_branch, w_out, ws, l, it0, it1, (bx - busy) * NWAVES + wave, idle * NWAVES, lane); }
    else convert_items(lds, w_in, w_branch, w_out, ws, l, it0, it1, bx * NWAVES + wave, G * NWAVES, lane);
}
DI void norm_rows(const float* xp, const float* xs, const float* nw, bf16* Z, unsigned char* Z8, int gw, int NGW, int lane) {
    asm volatile("" : "+v"(lane), "+s"(gw));
    for (int m = gw; m < MT; m += NGW) {
        const f32x4* xr = (const f32x4*)(m < MP ? xp + (size_t)m * DM : xs + (size_t)(m - MP) * DM) + lane;
        f32x4 v[16]; float s = 0.f;
#pragma unroll
        for (int j = 0; j < 16; ++j) { v[j] = xr[64 * j]; s += (v[j].x * v[j].x + v[j].y * v[j].y) + (v[j].z * v[j].z + v[j].w * v[j].w); }
        f32x4 wq[16];
#pragma unroll
        for (int j = 0; j < 16; ++j) wq[j] = ((const f32x4*)nw)[lane + 64 * j];
        const float rstd = 1.0f / sqrtf(wave_sum(s) * (1.0f / DM) + EPS);
        u32x2* o8 = (u32x2*)(Z + (size_t)m * DM) + lane; unsigned* q8 = (unsigned*)(Z8 + (size_t)m * DM) + lane;
#pragma unroll
        for (int j = 0; j < 16; ++j) { const f32x4 w4 = wq[j]; const float z0 = v[j].x * rstd * w4.x, z1 = v[j].y * rstd * w4.y, z2 = v[j].z * rstd * w4.z, z3 = v[j].w * rstd * w4.w;
            u32x2 o; o.x = pk2(z0, z1); o.y = pk2(z2, z3); o8[64 * j] = o; q8[64 * j] = pk4f8(z0, z1, z2, z3); }
    }
}
DI void sum_slabs_rows(const float* PB, bf16* MB, int gw, int NGW, int lane) {
    asm volatile("" : "+v"(lane), "+s"(gw));
    for (int h = gw; h < 512; h += NGW) {
        const int r = h >> 1, j0 = (h & 1) * 8;
        const f32x4* a = (const f32x4*)(PB + (size_t)r * DM) + lane + 64 * j0; const f32x4* b = a + (size_t)256 * DM / 4; const f32x4* c = b + (size_t)256 * DM / 4;
        u32x2* o8 = (u32x2*)(MB + (size_t)(MP + r) * DM) + lane + 64 * j0;
        f32x4 va[8], vb[8], vc[8];
#pragma unroll
        for (int j = 0; j < 8; ++j) { va[j] = a[64 * j]; vb[j] = b[64 * j]; vc[j] = c[64 * j]; }
#pragma unroll
        for (int j = 0; j < 8; ++j) { const f32x4 v = (va[j] + vb[j]) + vc[j]; u32x2 o; o.x = pk2(v.x, v.y); o.y = pk2(v.z, v.w); o8[64 * j] = o; }
    }
}
template <bool XB, bool YB> DI void final_rows(const void* xp_, const void* xs_, const bf16* OUT, const float* PO, const float* npost, void* ydst_, const float* npre_next, bf16* Z, unsigned char* Z8, int gw, int NGW, int lane) {
    asm volatile("" : "+v"(lane), "+s"(gw));
    for (int m = gw; m < MT; m += NGW) {
        const f32x4* xr = (const f32x4*)(m < MP ? (const float*)xp_ + (size_t)m * DM : (const float*)xs_ + (size_t)(m - MP) * DM) + lane;
        const u32x2* xrb = (const u32x2*)(m < MP ? (const bf16*)xp_ + (size_t)m * DM : (const bf16*)xs_ + (size_t)(m - MP) * DM) + lane;
        f32x4 v[16]; float s = 0.f;
        if (PO && m >= MP) { typedef const __attribute__((address_space(1))) f32x4* gp4;
            gp4 p0 = (gp4)(PO + (size_t)(m - MP) * DM) + lane; gp4 p1 = p0 + (size_t)256 * DM / 4; gp4 p2 = p1 + (size_t)256 * DM / 4; gp4 p3 = p2 + (size_t)256 * DM / 4;
#pragma unroll
            for (int jb = 0; jb < 16; jb += 4) { f32x4 t0[4], t1[4], t2[4], t3[4];
#pragma unroll
                for (int jj = 0; jj < 4; ++jj) { t0[jj] = p0[64 * (jb + jj)]; t1[jj] = p1[64 * (jb + jj)]; t2[jj] = p2[64 * (jb + jj)]; t3[jj] = p3[64 * (jb + jj)]; }
#pragma unroll
                for (int jj = 0; jj < 4; ++jj) v[jb + jj] = (t0[jj] + t1[jj]) + (t2[jj] + t3[jj]); } }
        else { const u32x2* orow = (const u32x2*)(OUT + (size_t)m * DM) + lane;
#pragma unroll
            for (int j = 0; j < 16; ++j) { const u32x2 ov = orow[64 * j]; v[j] = (f32x4){bflo(ov.x), bfhi(ov.x), bflo(ov.y), bfhi(ov.y)}; } }
        f32x4 xq[XB ? 1 : 16]; u32x2 xqb[XB ? 16 : 1];
#pragma unroll
        for (int j = 0; j < 16; ++j) { if constexpr (XB) xqb[j] = xrb[64 * j]; else xq[j] = xr[64 * j]; }
#pragma unroll
        for (int j = 0; j < 16; ++j) s += (v[j].x * v[j].x + v[j].y * v[j].y) + (v[j].z * v[j].z + v[j].w * v[j].w);
        const float rstd = 1.0f / sqrtf(wave_sum(s) * (1.0f / DM) + EPS);
        f32x4* yo = (f32x4*)((float*)ydst_ + (size_t)m * DM) + lane; u32x2* yob = (u32x2*)((bf16*)ydst_ + (size_t)m * DM) + lane; float s2 = 0.f;
        f32x4 wq[4];
#pragma unroll
        for (int j = 0; j < 16; ++j) {
            if ((j & 3) == 0) { _Pragma("unroll") for (int jj = 0; jj < 4; ++jj) wq[jj] = ((const f32x4*)npost)[lane + 64 * (j + jj)]; }
            const f32x4 w4 = wq[j & 3]; f32x4 x4;
            if constexpr (XB) { const u32x2 xb = xqb[j]; x4 = (f32x4){bflo(xb.x), bfhi(xb.x), bflo(xb.y), bfhi(xb.y)}; } else x4 = xq[j];
            v[j] = x4 + v[j] * rstd * w4;
            if constexpr (YB) { u32x2 yb; yb.x = pk2(v[j].x, v[j].y); yb.y = pk2(v[j].z, v[j].w); yob[64 * j] = yb; } else yo[64 * j] = v[j];
            s2 += (v[j].x * v[j].x + v[j].y * v[j].y) + (v[j].z * v[j].z + v[j].w * v[j].w); }
        if (Z) {
            const float r2 = 1.0f / sqrtf(wave_sum(s2) * (1.0f / DM) + EPS);
            u32x2* o8 = (u32x2*)(Z + (size_t)m * DM) + lane; unsigned* q8 = (unsigned*)(Z8 + (size_t)m * DM) + lane;
#pragma unroll
            for (int j = 0; j < 16; ++j) {
                if ((j & 3) == 0) { _Pragma("unroll") for (int jj = 0; jj < 4; ++jj) wq[jj] = ((const f32x4*)npre_next)[lane + 64 * (j + jj)]; }
                const f32x4 w4 = wq[j & 3]; const float z0 = v[j].x * r2 * w4.x, z1 = v[j].y * r2 * w4.y, z2 = v[j].z * r2 * w4.z, z3 = v[j].w * r2 * w4.w;
                u32x2 o; o.x = pk2(z0, z1); o.y = pk2(z2, z3); o8[64 * j] = o; q8[64 * j] = pk4f8(z0, z1, z2, z3); }
        }
    }
}
DI void mix_fix_rows(const bf16* OA, const float* SSQ, const float* hnw, const bf16* HGATE, const float* gnw, const bf16* CGATE, bf16* Y, int m0, int m1, int gw, int NGW, int lane) {
    asm volatile("" : "+v"(lane), "+s"(gw));
    for (int m = m0 + gw; m < m1; m += NGW) {
        const f32x4* sq = (const f32x4*)(SSQ + (size_t)m * 32);
        float rs[4];
#pragma unroll
        for (int h = 0; h < 4; ++h) { const f32x4 s = sq[4 + h]; rs[h] = 1.0f / sqrtf(((s.x + s.y) + (s.z + s.w)) * (1.0f / 512.0f) + EPS); }
        u32x2 obq[8], gq[8]; f32x4 wq[8];
#pragma unroll
        for (int j = 0; j < 8; ++j) { const int col = 4 * (lane + 64 * j); obq[j] = *(const u32x2*)(OA + (size_t)m * (2 * BW) + BW + col); gq[j] = *(const u32x2*)(CGATE + (size_t)m * BW + col); wq[j] = *(const f32x4*)(gnw + col); }
#pragma unroll
        for (int j = 0; j < 8; ++j) { const int col = 4 * (lane + 64 * j);
            const u32x2 ob = obq[j]; const f32x4 o = (f32x4){bflo(ob.x), bfhi(ob.x), bflo(ob.y), bfhi(ob.y)}, w4 = wq[j]; const u32x2 g = gq[j];
            const float r = rs[j >> 1]; u32x2 y; y.x = pk2(o.x * r * w4.x * bflo(g.x), o.y * r * w4.y * bfhi(g.x)); y.y = pk2(o.z * r * w4.z * bflo(g.y), o.w * r * w4.w * bfhi(g.y));
            *(u32x2*)(Y + (size_t)m * KBR + 2 * BW + col) = y; }
    }
}
DI void gl_rows(const float* CLR, const float* w2, const float* b2, float* GL, int bx, int G, int tid_in) {
    int tid = tid_in; asm volatile("" : "+v"(tid));
    float wa[16], wb[16];
#pragma unroll
    for (int r = 0; r < 16; ++r) { wa[r] = w2[r * 1024 + tid]; wb[r] = w2[r * 1024 + 512 + tid]; }
    const float ba = b2[tid], bb = b2[512 + tid];
    for (int m = bx; m < MT; m += G) {
        const f32x4* cp = (const f32x4*)(CLR + (size_t)m * 16); float xa = ba, xb = bb;
#pragma unroll
        for (int q = 0; q < 4; ++q) { const f32x4 cv = cp[q];
            xa += cv.x * wa[4 * q] + cv.y * wa[4 * q + 1] + cv.z * wa[4 * q + 2] + cv.w * wa[4 * q + 3];
            xb += cv.x * wb[4 * q] + cv.y * wb[4 * q + 1] + cv.z * wb[4 * q + 2] + cv.w * wb[4 * q + 3]; }
        GL[(size_t)m * 1024 + tid] = -(fmaxf(-xa, 0.f) + __logf(1.0f + __expf(-fabsf(xa)))) * 0.0625f;
        GL[(size_t)m * 1024 + 512 + tid] = -(fmaxf(-xb, 0.f) + __logf(1.0f + __expf(-fabsf(xb)))) * 0.0625f;
    }
}

template <int DK> struct SL {
    static constexpr int QS = (DK + 8) * 2;
    static constexpr int KHS = 72 * 2;
    static constexpr int VS = 136 * 2;
    static constexpr int QT = 0, KT = QT + 64 * QS, KH = KT + 64 * QS, VT = KH + DK * KHS, PP = VT + 64 * VS;
    static constexpr int PTOT = PP + 64 * KHS, ER = PTOT + 2048, EBL = ER + DK * 4, SSQ = EBL + DK * 4, END = SSQ + 2048;
};
static_assert(SL<256>::END <= MISC_OFF, "scan LDS map");
struct LaArgs {
    const bf16* Q; int ldq;
    const float* G; int ldg;
    const bf16* K;
    const bf16* V;
    int row0, T;
    const float* S0; float* S1; int lds;
    const float* nw; const bf16* gate; bf16* Y;
};
template <int DK, bool GLA>
DI void la_job(LAS unsigned char* lds, const int tid_in, const LaArgs& A) {
    int tid = tid_in; asm volatile("" : "+v"(tid));
    typedef SL<DK> L;
    constexpr int NPART = 512 / DK, TPT = 64 / NPART, NDKT = DK / 16, NKS = DK / 32, NQ = DK / 64;
    const int lane = tid & 63, w = __builtin_amdgcn_readfirstlane(tid >> 6), fr = lane & 15, fq = lane >> 4;
    const int d = tid % DK, part = __builtin_amdgcn_readfirstlane(tid / DK);
    f32x4 S[NDKT];
#pragma unroll
    for (int k = 0; k < NDKT; ++k) {
        if (A.S0) {
#pragma unroll
            for (int j = 0; j < 4; ++j) S[k][j] = A.S0[(size_t)(16 * k + 4 * fq + j) * A.lds + 16 * w + fr];
        } else S[k] = (f32x4){0.f, 0.f, 0.f, 0.f};
    }
    const int nchunk = (A.T + 63) >> 6;
    const f32x4 nw4 = *(const f32x4*)(A.nw + 16 * w + 4 * fq);
    u32x4 pq[NQ], pk[NQ], pv[2]; float pg[TPT];
    constexpr int RPI = 512 / (DK / 8);
    const int tq = tid / (DK / 8), cq = tid % (DK / 8), tv = tid >> 4, cv = tid & 15;
    int b_q = L::QT + fr * L::QS + 16 * fq, b_q4 = L::QT + fr * L::QS + 8 * fq, b_k = L::KT + fr * L::QS + 16 * fq, b_kh = L::KH + fr * L::KHS + 16 * fq, b_p = L::PP + fr * L::KHS + 16 * fq, b_e = 16 * fq;
    asm volatile("" : "+v"(b_q), "+v"(b_q4), "+v"(b_k), "+v"(b_kh), "+v"(b_p), "+v"(b_e));
    const unsigned qoff = (unsigned)(tq * A.ldq + cq * 8), koff = (unsigned)(tq * 1024 + cq * 8), voff = (unsigned)(tv * BW + cv * 8);
#define LA_PREFETCH(cc) do { int t0_ = (cc) * 64; asm volatile("" : "+s"(t0_)); const size_t rowc_ = (size_t)A.row0 + t0_; const int nval_ = (A.T - t0_) < 64 ? (A.T - t0_) : 64; \
        _Pragma("unroll") for (int i_ = 0; i_ < NQ; ++i_) { const bf16* qb_ = A.Q + (rowc_ + RPI * i_) * A.ldq; \
            pq[i_] = (u32x4){0u, 0u, 0u, 0u}; if (tq + RPI * i_ < nval_) pq[i_] = *(const u32x4*)(qb_ + qoff); \
            } \
        _Pragma("unroll") for (int i_ = 0; i_ < 2; ++i_) { const bf16* vb_ = A.V + (rowc_ + 32 * i_) * BW; \
            pv[i_] = (u32x4){0u, 0u, 0u, 0u}; if (tv + 32 * i_ < nval_) pv[i_] = *(const u32x4*)(vb_ + voff); } \
        } while (0)
#define LA_LOAD_G(rowc_, nval_) do { _Pragma("unroll") for (int i_ = 0; i_ < TPT; ++i_) { const int t_ = part * TPT + i_; const float* gb_ = A.G + ((rowc_) + t_) * A.ldg; pg[i_] = (t_ < (nval_)) ? gb_[d] : 0.f; } } while (0)
#define LA_PREFETCH_G(cc) do { int t0_ = (cc) * 64; asm volatile("" : "+s"(t0_)); const size_t rowc_ = (size_t)A.row0 + t0_; const int nval_ = (A.T - t0_) < 64 ? (A.T - t0_) : 64; \
        if constexpr (GLA) { _Pragma("unroll") for (int i_ = 0; i_ < NQ; ++i_) { const bf16* kb_ = A.K + (rowc_ + RPI * i_) * 1024; pk[i_] = (u32x4){0u, 0u, 0u, 0u}; if (tq + RPI * i_ < nval_) pk[i_] = *(const u32x4*)(kb_ + koff); } } \
        if constexpr (!GLA) { LA_LOAD_G(rowc_, nval_); } } while (0)
    LA_PREFETCH(0); LA_PREFETCH_G(0);
    for (int c = 0; c < nchunk; ++c) {
        const int t0 = c * 64; const size_t rowc = (size_t)A.row0 + t0; const int nval = (A.T - t0) < 64 ? (A.T - t0) : 64;
        if constexpr (GLA) { LA_LOAD_G(rowc, nval); }
#pragma unroll
        for (int i = 0; i < NQ; ++i) { *(LAS u32x4*)(lds + L::QT + (tq + RPI * i) * L::QS + cq * 16) = pq[i];
            if constexpr (GLA) *(LAS u32x4*)(lds + L::KT + (tq + RPI * i) * L::QS + cq * 16) = pk[i]; }
#pragma unroll
        for (int i = 0; i < 2; ++i) *(LAS u32x4*)(lds + L::VT + (tv + 32 * i) * L::VS + cv * 16) = pv[i];
        float g[TPT];
        { float run = 0.f;
#pragma unroll
            for (int i = 0; i < TPT; ++i) { g[i] = pg[i]; run += g[i]; }
            *(LAS float*)(lds + L::PTOT + (part * DK + d) * 4) = run; }
        __syncthreads();
        float pre = 0.f, tot = 0.f, rr = 0.f;
#pragma unroll
        for (int p = 0; p < NPART; ++p) { const float v = *(const LAS float*)(lds + L::PTOT + (p * DK + d) * 4); pre += (p < part) ? v : 0.f; tot += v; rr += (p < NPART / 2) ? v : 0.f; }
        {
            float bb = pre; const float etr = __expf(tot - rr);
#pragma unroll
            for (int i8 = 0; i8 < TPT / 8; ++i8) { float kh[8];
#pragma unroll
                for (int ii = 0; ii < 8; ++ii) { const int i = 8 * i8 + ii; const int t = part * TPT + i; bb += g[i];
                    LAS bf16* qp = (LAS bf16*)(lds + L::QT + t * L::QS + d * 2); LAS bf16* kp = (LAS bf16*)(lds + L::KT + t * L::QS + d * 2);
                    const float qr = bf2f(*qp); float kr;
                    if constexpr (GLA) kr = bf2f(*kp); else kr = 1.0f - __expf(g[i]);
                    const float e1 = __expf(bb - rr), e2 = __expf(rr - bb);
                    *qp = f2bf(qr * e1); const float kt = kr * e2; *kp = f2bf(kt); kh[ii] = kt * etr; }
                u32x4 o; o.x = pk2(kh[0], kh[1]); o.y = pk2(kh[2], kh[3]); o.z = pk2(kh[4], kh[5]); o.w = pk2(kh[6], kh[7]);
                *(LAS u32x4*)(lds + L::KH + d * L::KHS + (part * TPT + 8 * i8) * 2) = o;
                asm volatile("" ::: "memory"); }
            if (part == 0) { *(LAS float*)(lds + L::ER + d * 4) = __expf(rr); *(LAS float*)(lds + L::EBL + d * 4) = __expf(tot); }
        }
        __syncthreads();
        if (c + 1 < nchunk) LA_PREFETCH(c + 1);
        bf16x8 Vf[2];
#pragma unroll
        for (int ks = 0; ks < 2; ++ks) {
            const bf16x4 lo = __builtin_amdgcn_ds_read_tr16_b64_v4i16((LAS bf16x4*)(lds + L::VT + (32 * ks + 8 * fq + (fr >> 2)) * L::VS + (16 * w + 4 * (fr & 3)) * 2));
            const bf16x4 hi = __builtin_amdgcn_ds_read_tr16_b64_v4i16((LAS bf16x4*)(lds + L::VT + (32 * ks + 8 * fq + 4 + (fr >> 2)) * L::VS + (16 * w + 4 * (fr & 3)) * 2));
            Vf[ks] = (bf16x8){lo[0], lo[1], lo[2], lo[3], hi[0], hi[1], hi[2], hi[3]}; }
        { const int ti = w >> 1; const int pk_base = b_k + ((w & 1) * 2) * 16 * L::QS, pq_base = b_q + ti * 16 * L::QS;
#pragma unroll
            for (int sj = 0; sj < 2; ++sj) { const int si = (w & 1) * 2 + sj; f32x4 acc = (f32x4){0.f, 0.f, 0.f, 0.f};
                if (si <= ti) {
#pragma unroll
                    for (int ks = 0; ks < NKS; ++ks) { const bf16x8 a = *(const LAS bf16x8*)(lds + pk_base + sj * 16 * L::QS + ks * 64);
                        const bf16x8 bq = *(const LAS bf16x8*)(lds + pq_base + ks * 64); acc = MFMA16(a, bq, acc); } }
                const int t = 16 * ti + fr, s0 = 16 * si + 4 * fq;
#pragma unroll
                for (int j = 0; j < 4; ++j) if (s0 + j > t) acc[j] = 0.f;
                u32x2 pw; pw.x = pk2(acc[0], acc[1]); pw.y = pk2(acc[2], acc[3]);
                *(LAS u32x2*)(lds + L::PP + t * L::KHS + s0 * 2) = pw; } }
        f32x4 O[4];
#pragma unroll
        for (int ti = 0; ti < 4; ++ti) O[ti] = (f32x4){0.f, 0.f, 0.f, 0.f};
#pragma unroll
        for (int p = 0; p < NKS; ++p) { const f32x4 ea = *(const LAS f32x4*)(lds + b_e + L::ER + 128 * p), eb = *(const LAS f32x4*)(lds + b_e + L::ER + 128 * p + 64);
            u32x4 o; o.x = pk2(S[2 * p][0] * ea[0], S[2 * p][1] * ea[1]); o.y = pk2(S[2 * p][2] * ea[2], S[2 * p][3] * ea[3]);
            o.z = pk2(S[2 * p + 1][0] * eb[0], S[2 * p + 1][1] * eb[1]); o.w = pk2(S[2 * p + 1][2] * eb[2], S[2 * p + 1][3] * eb[3]); const bf16x8 Sf = __builtin_bit_cast(bf16x8, o);
#pragma unroll
            for (int ti = 0; ti < 4; ++ti) { const u32x2 q0 = *(const LAS u32x2*)(lds + b_q4 + ti * 16 * L::QS + 64 * p), q1 = *(const LAS u32x2*)(lds + b_q4 + ti * 16 * L::QS + 64 * p + 32);
                u32x4 qq; qq.x = q0.x; qq.y = q0.y; qq.z = q1.x; qq.w = q1.y; O[ti] = MFMA16(Sf, __builtin_bit_cast(bf16x8, qq), O[ti]); }
            }
        __syncthreads();
        u32x2 gt[4];
#pragma unroll
        for (int ti = 0; ti < 4; ++ti) { f32x4 acc = O[ti];
#pragma unroll
            for (int ks = 0; ks < 2; ++ks) { const bf16x8 bp = *(const LAS bf16x8*)(lds + b_p + ti * 16 * L::KHS + ks * 64); acc = MFMA16(Vf[ks], bp, acc); }
            O[ti] = acc;
            const int t = 16 * ti + fr;
            gt[ti] = (u32x2){0u, 0u}; if (t < nval) gt[ti] = *(const u32x2*)(A.gate + (rowc + t) * BW + 16 * w + 4 * fq);
            float s = (acc[0] * acc[0] + acc[1] * acc[1]) + (acc[2] * acc[2] + acc[3] * acc[3]); s += __shfl_xor(s, 16); s += __shfl_xor(s, 32);
            if (fq == 0) *(LAS float*)(lds + L::SSQ + (t * 8 + w) * 4) = s; }
        if (c + 1 < nchunk) LA_PREFETCH_G(c + 1);
#pragma unroll
        for (int k = 0; k < NDKT; ++k) { const f32x4 e = *(const LAS f32x4*)(lds + b_e + L::EBL + 64 * k); f32x4 acc = S[k] * e;
#pragma unroll
            for (int ks = 0; ks < 2; ++ks) { const bf16x8 a = *(const LAS bf16x8*)(lds + b_kh + k * 16 * L::KHS + ks * 64); acc = MFMA16(a, Vf[ks], acc); }
            S[k] = acc; }
        __syncthreads();
#pragma unroll
        for (int ti = 0; ti < 4; ++ti) { const int t = 16 * ti + fr;
            const f32x4 sa = *(const LAS f32x4*)(lds + L::SSQ + t * 32), sb = *(const LAS f32x4*)(lds + L::SSQ + t * 32 + 16);
            const float r = 1.0f / sqrtf((((sa.x + sa.y) + (sa.z + sa.w)) + ((sb.x + sb.y) + (sb.z + sb.w))) * (1.0f / 128.0f) + EPS);
            const f32x4 o = O[ti]; u32x2 y; y.x = pk2(o[0] * r * nw4[0] * bflo(gt[ti].x), o[1] * r * nw4[1] * bfhi(gt[ti].x)); y.y = pk2(o[2] * r * nw4[2] * bflo(gt[ti].y), o[3] * r * nw4[3] * bfhi(gt[ti].y));
            if (t < nval) *(u32x2*)(A.Y + (rowc + t) * KBR + 16 * w + 4 * fq) = y; }
    }
#undef LA_PREFETCH
#undef LA_PREFETCH_G
#undef LA_LOAD_G
#pragma unroll
    for (int k = 0; k < NDKT; ++k)
#pragma unroll
        for (int j = 0; j < 4; ++j) A.S1[(size_t)(16 * k + 4 * fq + j) * A.lds + 16 * w + fr] = S[k][j];
}

struct GPrep { const bf16* CQ; const bf16* CK; const float* CLR; const float* w2; const float* b2; bf16* QT; bf16* KT; bf16* KH; float* ER; float* EB; };
DI void gla_prep(LAS unsigned char* lds, const int tid_in, const GPrep& P, const int ci, const int hh) {
    int tid = tid_in; asm volatile("" : "+v"(tid));
    const int d = tid & 255, part = __builtin_amdgcn_readfirstlane(tid >> 8);
    const int row0 = ci < 128 ? ci * 64 : MP + (ci - 128) * 32, nval = ci < 128 ? 64 : 32;
    const int ch = hh * 256 + d;
    LAS float* ptot = (LAS float*)lds; LAS float* clrs = (LAS float*)(lds + 4096);
    if (tid < 256) { const int t = tid >> 2, q4 = tid & 3; f32x4 v = (f32x4){0.f, 0.f, 0.f, 0.f}; if (t < nval) v = *(const f32x4*)(P.CLR + ((size_t)row0 + t) * 16 + q4 * 4);
        *(LAS f32x4*)(clrs + t * 16 + q4 * 4) = v; }
    float w2r[16];
#pragma unroll
    for (int r = 0; r < 16; ++r) w2r[r] = P.w2[r * 1024 + ch];
    const float b2v = P.b2[ch];
    unsigned qk[32];
    { const bf16* qi = P.CQ + (size_t)row0 * 1024 + ch; const bf16* ki = P.CK + (size_t)row0 * 1024 + ch;
#pragma unroll
      for (int i = 0; i < 32; ++i) { const int t = part * 32 + i; const int tc = t < nval ? t : 0; const unsigned qv = qi[(size_t)tc * 1024], kv = ki[(size_t)tc * 1024]; qk[i] = (t < nval) ? (qv | (kv << 16)) : 0u; } }
    __syncthreads();
    float g[32]; float run = 0.f;
#pragma unroll
    for (int i = 0; i < 32; ++i) { const int t = part * 32 + i; const LAS f32x4* cp = (const LAS f32x4*)(clrs + t * 16);
        float x = b2v;
#pragma unroll
        for (int q = 0; q < 4; ++q) { const f32x4 cv = cp[q]; x += cv.x * w2r[4 * q] + cv.y * w2r[4 * q + 1] + cv.z * w2r[4 * q + 2] + cv.w * w2r[4 * q + 3]; }
        const float ls = -(fmaxf(-x, 0.f) + __logf(1.0f + __expf(-fabsf(x))));
        g[i] = (t < nval) ? ls * 0.0625f : 0.f; run += g[i]; }
    ptot[part * 256 + d] = run;
    __syncthreads();
    const float p0 = ptot[d], p1 = ptot[256 + d];
    const float rr = p0, tot = p0 + p1, etr = __expf(tot - rr);
    float bb = part ? p0 : 0.f;
    bf16* qo = P.QT + (size_t)row0 * 1024 + ch; bf16* ko = P.KT + (size_t)row0 * 1024 + ch;
    u32x4* kho = (u32x4*)(P.KH + ((size_t)ci * 1024 + ch) * 64 + part * 32);
#pragma unroll
    for (int i8 = 0; i8 < 4; ++i8) { float kh[8];
#pragma unroll
        for (int ii = 0; ii < 8; ++ii) { const int i = 8 * i8 + ii; const int t = part * 32 + i; bb += g[i];
            const float qr = bflo(qk[i]), kr = bfhi(qk[i]);
            const float e1 = __expf(bb - rr), e2 = __expf(rr - bb); const float kt = kr * e2;
            if (t < nval) { qo[(size_t)t * 1024] = f2bf(qr * e1); ko[(size_t)t * 1024] = f2bf(kt); }
            kh[ii] = kt * etr; }
        u32x4 o; o.x = pk2(kh[0], kh[1]); o.y = pk2(kh[2], kh[3]); o.z = pk2(kh[4], kh[5]); o.w = pk2(kh[6], kh[7]); kho[i8] = o; }
    if (part == 0) { P.ER[(size_t)ci * 1024 + ch] = __expf(rr); P.EB[(size_t)ci * 1024 + ch] = __expf(tot); }
    __syncthreads();
}
struct GArgs { const bf16* QT; const bf16* KT; const bf16* KH; const float* ER; const float* EB; const bf16* V; int ci0, row0, T; const float* S0; float* S1; int lds; bf16* OA; float* SSQ; };
DI void gla_job(LAS unsigned char* lds, const int tid_in, const GArgs& A) {
    int tid = tid_in; asm volatile("" : "+v"(tid));
    typedef SL<256> L;
    constexpr int NDKT = 16, NKS = 8;
    const int lane = tid & 63, w = __builtin_amdgcn_readfirstlane(tid >> 6), fr = lane & 15, fq = lane >> 4;
    f32x4 S[NDKT];
#pragma unroll
    for (int k = 0; k < NDKT; ++k) {
        if (A.S0) {
#pragma unroll
            for (int j = 0; j < 4; ++j) S[k][j] = A.S0[(size_t)(16 * k + 4 * fq + j) * A.lds + 16 * w + fr];
        } else S[k] = (f32x4){0.f, 0.f, 0.f, 0.f};
    }
    const int nchunk = (A.T + 63) >> 6;
    u32x4 pq[4], pk[4], ph[4], pv[2]; f32x4 pe = (f32x4){0.f, 0.f, 0.f, 0.f};
    int b_q = L::QT + fr * L::QS + 16 * fq, b_q4 = L::QT + fr * L::QS + 8 * fq, b_k = L::KT + fr * L::QS + 16 * fq, b_kh = L::KH + fr * L::KHS + 16 * fq, b_p = L::PP + fr * L::KHS + 16 * fq, b_e = 16 * fq;
    asm volatile("" : "+v"(b_q), "+v"(b_q4), "+v"(b_k), "+v"(b_kh), "+v"(b_p), "+v"(b_e));
#define G_IDX() int t_ = tid; asm volatile("" : "+v"(t_)); const int tq = t_ >> 5, cq = t_ & 31, tv = t_ >> 4, cv = t_ & 15, th = t_ >> 3, chh = t_ & 7; \
        const unsigned qoff = (unsigned)(tq * 1024 + cq * 8), voff = (unsigned)(tv * BW + cv * 8), hoff = (unsigned)(th * 64 + chh * 8); (void)tq; (void)cq; (void)tv; (void)cv; (void)th; (void)chh; (void)qoff; (void)voff; (void)hoff
#define G_LOAD_QK(cc) do { G_IDX(); int c_ = (cc); asm volatile("" : "+s"(c_)); const size_t rowc_ = (size_t)A.row0 + c_ * 64; const int nval_ = (A.T - c_ * 64) < 64 ? (A.T - c_ * 64) : 64; \
        _Pragma("unroll") for (int i_ = 0; i_ < 4; ++i_) { const bf16* qb_ = A.QT + (rowc_ + 16 * i_) * 1024; const bf16* kb_ = A.KT + (rowc_ + 16 * i_) * 1024; \
            pq[i_] = (u32x4){0u, 0u, 0u, 0u}; pk[i_] = (u32x4){0u, 0u, 0u, 0u}; if (tq + 16 * i_ < nval_) { pq[i_] = *(const u32x4*)(qb_ + qoff); pk[i_] = *(const u32x4*)(kb_ + qoff); } } } while (0)
#define G_LOAD_HV(cc) do { G_IDX(); int c_ = (cc); asm volatile("" : "+s"(c_)); const size_t rowc_ = (size_t)A.row0 + c_ * 64; const int nval_ = (A.T - c_ * 64) < 64 ? (A.T - c_ * 64) : 64; \
        _Pragma("unroll") for (int i_ = 0; i_ < 4; ++i_) { const bf16* hb_ = A.KH + ((size_t)(A.ci0 + c_) * 1024 + 64 * i_) * 64; ph[i_] = *(const u32x4*)(hb_ + hoff); } \
        _Pragma("unroll") for (int i_ = 0; i_ < 2; ++i_) { const bf16* vb_ = A.V + (rowc_ + 32 * i_) * BW; pv[i_] = (u32x4){0u, 0u, 0u, 0u}; if (tv + 32 * i_ < nval_) pv[i_] = *(const u32x4*)(vb_ + voff); } \
        if (tid < 128) { const float* eb_ = (tid < 64 ? A.ER : A.EB) + (size_t)(A.ci0 + c_) * 1024; pe = *(const f32x4*)(eb_ + 4 * (tid & 63)); } } while (0)
#define G_LAND_QK() do { G_IDX(); _Pragma("unroll") for (int i_ = 0; i_ < 4; ++i_) { *(LAS u32x4*)(lds + L::QT + (tq + 16 * i_) * L::QS + cq * 16) = pq[i_]; *(LAS u32x4*)(lds + L::KT + (tq + 16 * i_) * L::QS + cq * 16) = pk[i_]; } } while (0)
#define G_LAND_HV() do { G_IDX(); _Pragma("unroll") for (int i_ = 0; i_ < 4; ++i_) *(LAS u32x4*)(lds + L::KH + (th + 64 * i_) * L::KHS + chh * 16) = ph[i_]; \
        _Pragma("unroll") for (int i_ = 0; i_ < 2; ++i_) *(LAS u32x4*)(lds + L::VT + (tv + 32 * i_) * L::VS + cv * 16) = pv[i_]; \
        if (tid < 128) *(LAS f32x4*)(lds + L::ER + 16 * tid) = pe; } while (0)
    G_LOAD_QK(0); G_LOAD_HV(0); G_LAND_QK();
    for (int c = 0; c < nchunk; ++c) {
        const int t0 = c * 64; const size_t rowc = (size_t)A.row0 + t0; const int nval = (A.T - t0) < 64 ? (A.T - t0) : 64;
        G_LAND_HV();
        __syncthreads();
        if (c + 1 < nchunk) G_LOAD_QK(c + 1);
        bf16x8 Vf[2];
#pragma unroll
        for (int ks = 0; ks < 2; ++ks) {
            const bf16x4 lo = __builtin_amdgcn_ds_read_tr16_b64_v4i16((LAS bf16x4*)(lds + L::VT + (32 * ks + 8 * fq + (fr >> 2)) * L::VS + (16 * w + 4 * (fr & 3)) * 2));
            const bf16x4 hi = __builtin_amdgcn_ds_read_tr16_b64_v4i16((LAS bf16x4*)(lds + L::VT + (32 * ks + 8 * fq + 4 + (fr >> 2)) * L::VS + (16 * w + 4 * (fr & 3)) * 2));
            Vf[ks] = (bf16x8){lo[0], lo[1], lo[2], lo[3], hi[0], hi[1], hi[2], hi[3]}; }
        { const int ti = w >> 1; const int pk_base = b_k + ((w & 1) * 2) * 16 * L::QS, pq_base = b_q + ti * 16 * L::QS;
#pragma unroll
            for (int sj = 0; sj < 2; ++sj) { const int si = (w & 1) * 2 + sj; f32x4 acc = (f32x4){0.f, 0.f, 0.f, 0.f};
                if (si <= ti) {
#pragma unroll
                    for (int ks = 0; ks < NKS; ++ks) { const bf16x8 a = *(const LAS bf16x8*)(lds + pk_base + sj * 16 * L::QS + ks * 64);
                        const bf16x8 bq = *(const LAS bf16x8*)(lds + pq_base + ks * 64); acc = MFMA16(a, bq, acc); } }
                const int t = 16 * ti + fr, s0 = 16 * si + 4 * fq;
#pragma unroll
                for (int j = 0; j < 4; ++j) if (s0 + j > t) acc[j] = 0.f;
                u32x2 pw; pw.x = pk2(acc[0], acc[1]); pw.y = pk2(acc[2], acc[3]);
                *(LAS u32x2*)(lds + L::PP + t * L::KHS + s0 * 2) = pw; } }
        f32x4 O[4];
#pragma unroll
        for (int ti = 0; ti < 4; ++ti) O[ti] = (f32x4){0.f, 0.f, 0.f, 0.f};
#pragma unroll
        for (int p = 0; p < NKS; ++p) { const f32x4 ea = *(const LAS f32x4*)(lds + b_e + L::ER + 128 * p), eb = *(const LAS f32x4*)(lds + b_e + L::ER + 128 * p + 64);
            u32x4 o; o.x = pk2(S[2 * p][0] * ea[0], S[2 * p][1] * ea[1]); o.y = pk2(S[2 * p][2] * ea[2], S[2 * p][3] * ea[3]);
            o.z = pk2(S[2 * p + 1][0] * eb[0], S[2 * p + 1][1] * eb[1]); o.w = pk2(S[2 * p + 1][2] * eb[2], S[2 * p + 1][3] * eb[3]); const bf16x8 Sf = __builtin_bit_cast(bf16x8, o);
#pragma unroll
            for (int ti = 0; ti < 4; ++ti) { const u32x2 q0 = *(const LAS u32x2*)(lds + b_q4 + ti * 16 * L::QS + 64 * p), q1 = *(const LAS u32x2*)(lds + b_q4 + ti * 16 * L::QS + 64 * p + 32);
                u32x4 qq; qq.x = q0.x; qq.y = q0.y; qq.z = q1.x; qq.w = q1.y; O[ti] = MFMA16(Sf, __builtin_bit_cast(bf16x8, qq), O[ti]); }
            }
        __syncthreads();
        if (c + 1 < nchunk) { G_LAND_QK(); G_LOAD_HV(c + 1); }
#pragma unroll
        for (int ti = 0; ti < 4; ++ti) { f32x4 acc = O[ti];
#pragma unroll
            for (int ks = 0; ks < 2; ++ks) { const bf16x8 bp = *(const LAS bf16x8*)(lds + b_p + ti * 16 * L::KHS + ks * 64); acc = MFMA16(Vf[ks], bp, acc); }
            const int t = 16 * ti + fr;
            if (t < nval) { u32x2 ob; ob.x = pk2(acc[0], acc[1]); ob.y = pk2(acc[2], acc[3]); *(u32x2*)(A.OA + (rowc + t) * (2 * BW) + 16 * w + 4 * fq) = ob; }
            float s = (acc[0] * acc[0] + acc[1] * acc[1]) + (acc[2] * acc[2] + acc[3] * acc[3]); s += __shfl_xor(s, 16); s += __shfl_xor(s, 32);
            if (fq == 0) *(LAS float*)(lds + L::SSQ + (t * 8 + w) * 4) = s; }
#pragma unroll
        for (int k = 0; k < NDKT; ++k) { const f32x4 e = *(const LAS f32x4*)(lds + b_e + L::EBL + 64 * k); f32x4 acc = S[k] * e;
#pragma unroll
            for (int ks = 0; ks < 2; ++ks) { const bf16x8 a = *(const LAS bf16x8*)(lds + b_kh + k * 16 * L::KHS + ks * 64); acc = MFMA16(a, Vf[ks], acc); }
            S[k] = acc; }
        __syncthreads();
        if (tid < 64 && tid < nval) { const f32x4 sa = *(const LAS f32x4*)(lds + L::SSQ + tid * 32), sb = *(const LAS f32x4*)(lds + L::SSQ + tid * 32 + 16);
            A.SSQ[(rowc + tid) * 32] = ((sa.x + sa.y) + (sa.z + sa.w)) + ((sb.x + sb.y) + (sb.z + sb.w)); }
    }
#undef G_IDX
#undef G_LOAD_QK
#undef G_LOAD_HV
#undef G_LAND_QK
#undef G_LAND_HV
#pragma unroll
    for (int k = 0; k < NDKT; ++k)
#pragma unroll
        for (int j = 0; j < 4; ++j) A.S1[(size_t)(16 * k + 4 * fq + j) * A.lds + 16 * w + fr] = S[k][j];
}

struct LruArgs { const float* LX; int row0, T; const float* cst; const float* h0; const float* cw; const float* cb; const float* wa; const float* ba;
                 const float* wx; const float* bx; const float* lam; const bf16* lgate; bf16* Y; float* newh; float* newconv; };
constexpr int LR_XB = 0, LR_XF = 17408, LR_AA = LR_XF + 32768, LR_UU = LR_AA + 32768, LR_END = LR_UU + 32768;
static_assert(LR_END <= MISC_OFF, "lru LDS map");
DI void lru_job(LAS unsigned char* lds, const int tid_in, const LruArgs& A) {
    int tid = tid_in; asm volatile("" : "+v"(tid));
    const int lane = tid & 63, w = __builtin_amdgcn_readfirstlane(tid >> 6), fr = lane & 15, fq = lane >> 4;
    const int c = tid & 127, part = __builtin_amdgcn_readfirstlane(tid >> 7), cc = 16 * w + fr;
    bf16x8 Wf[2][4];
#pragma unroll
    for (int ks = 0; ks < 4; ++ks) { float a[8], x[8];
#pragma unroll
        for (int j = 0; j < 8; ++j) { const int i = 32 * ks + 8 * fq + j; a[j] = A.wa[i * 128 + cc]; x[j] = A.wx[i * 128 + cc]; }
        u32x4 oa, ox; oa.x = pk2(a[0], a[1]); oa.y = pk2(a[2], a[3]); oa.z = pk2(a[4], a[5]); oa.w = pk2(a[6], a[7]);
        ox.x = pk2(x[0], x[1]); ox.y = pk2(x[2], x[3]); ox.z = pk2(x[4], x[5]); ox.w = pk2(x[6], x[7]);
        Wf[0][ks] = __builtin_bit_cast(bf16x8, oa); Wf[1][ks] = __builtin_bit_cast(bf16x8, ox); }
    const float bav = A.ba[cc], bxv = A.bx[cc]; const float lamv = A.lam[cc];
    const float sp8 = -8.0f * (fmaxf(-lamv, 0.f) + log1pf(expf(-fabsf(lamv))));
    const float cw0 = A.cw[c], cw1 = A.cw[BW + c], cw2 = A.cw[2 * BW + c], cw3 = A.cw[3 * BW + c], cbv = A.cb[c];
    float hc = (tid < 128 && A.h0) ? A.h0[c] : 0.f;
    const int nchunk = (A.T + 63) >> 6;
    float xv[19]; unsigned lgn[16];
#define LRU_PREFETCH(chn) do { int t0_ = (chn) * 64; asm volatile("" : "+s"(t0_)); const int nval_ = (A.T - t0_) < 64 ? (A.T - t0_) : 64; \
        _Pragma("unroll") for (int i_ = 0; i_ < 19; ++i_) { const int ta_ = t0_ + 16 * part - 3 + i_; float v_ = 0.f; \
            if (ta_ < 0) { if (A.cst) v_ = A.cst[(3 + ta_) * BW + c]; } else if (ta_ < A.T) { const float* xb_ = A.LX + (size_t)(A.row0 + ta_) * BW; v_ = xb_[c]; } \
            xv[i_] = v_; } \
        _Pragma("unroll") for (int i_ = 0; i_ < 16; ++i_) { const int t_ = 16 * part + i_; const bf16* gb_ = A.lgate + ((size_t)A.row0 + t0_ + t_) * BW; lgn[i_] = (t_ < nval_) ? (unsigned)gb_[c] : 0u; } } while (0)
    LRU_PREFETCH(0);
    for (int ch = 0; ch < nchunk; ++ch) {
        const int t0 = ch * 64; const size_t rowc = (size_t)A.row0 + t0; const int nval = (A.T - t0) < 64 ? (A.T - t0) : 64;
        unsigned lg[16];
#pragma unroll
        for (int i = 0; i < 16; ++i) lg[i] = lgn[i];
#pragma unroll
        for (int i = 0; i < 16; ++i) { const int t = 16 * part + i; const float xc = cbv + xv[i] * cw0 + xv[i + 1] * cw1 + xv[i + 2] * cw2 + xv[i + 3] * cw3;
            *(LAS float*)(lds + LR_XF + (t * 128 + c) * 4) = xc; *(LAS bf16*)(lds + LR_XB + t * 272 + c * 2) = f2bf(xc); }
        __syncthreads();
        if (ch + 1 < nchunk) LRU_PREFETCH(ch + 1);
#pragma unroll
        for (int ti = 0; ti < 4; ++ti) { f32x4 ar = (f32x4){0.f, 0.f, 0.f, 0.f}, ai = (f32x4){0.f, 0.f, 0.f, 0.f};
#pragma unroll
            for (int ks = 0; ks < 4; ++ks) { const bf16x8 a = *(const LAS bf16x8*)(lds + LR_XB + (16 * ti + fr) * 272 + (32 * ks + 8 * fq) * 2); ar = MFMA16(a, Wf[0][ks], ar); ai = MFMA16(a, Wf[1][ks], ai); }
#pragma unroll
            for (int j = 0; j < 4; ++j) { const int t = 16 * ti + 4 * fq + j;
                const float r = sigmoidf_(ar[j] + bav), ig = sigmoidf_(ai[j] + bxv); const float la = r * sp8;
                float a_ = __expf(la); const float t2 = 2.0f * la;
                const float om = (t2 > -0.03f) ? -t2 * (1.0f + t2 * (0.5f + t2 * (0.16666667f + t2 * 0.041666668f))) : 1.0f - a_ * a_;
                float u = __builtin_amdgcn_sqrtf(fmaxf(om, 0.f)) * ig * *(const LAS float*)(lds + LR_XF + (t * 128 + cc) * 4);
                if (t >= nval) { a_ = 1.0f; u = 0.f; }
                *(LAS float*)(lds + LR_AA + (t * 128 + cc) * 4) = a_; *(LAS float*)(lds + LR_UU + (t * 128 + cc) * 4) = u; } }
        __syncthreads();
        if (tid < 128) {
#pragma unroll 16
            for (int t = 0; t < 64; ++t) { const float a_ = *(const LAS float*)(lds + LR_AA + (t * 128 + c) * 4); LAS float* up = (LAS float*)(lds + LR_UU + (t * 128 + c) * 4);
                hc = a_ * hc + *up; *up = hc; }
        }
        __syncthreads();
#pragma unroll
        for (int i = 0; i < 16; ++i) { const int t = 16 * part + i; const float ht = *(const LAS float*)(lds + LR_UU + (t * 128 + c) * 4);
            if (t < nval) { bf16* yb = A.Y + (rowc + t) * KBR; yb[c] = f2bf(ht * bf2f(lg[i])); } }
    }
#undef LRU_PREFETCH
    if (tid < 128) { A.newh[c] = hc;
#pragma unroll
        for (int j = 0; j < 3; ++j) A.newconv[j * BW + c] = A.LX[(size_t)(A.row0 + A.T - 3 + j) * BW + c]; }
    __syncthreads();
}

struct Args { const float* in[23]; float* out; unsigned char* ws; int ph_lo, ph_hi, use_bar, pad; };
enum { I_XP = 0, I_XS, I_SHG, I_SLH, I_SLC, I_SGL, I_NPRE, I_NPOST, I_WIN, I_LBL, I_HGN, I_CW, I_CB, I_WA, I_BA, I_WX, I_BX, I_LAM, I_W2, I_B2, I_GLN, I_WBR, I_WOU };
constexpr int NPHASE = 15;


#define WSZ() unsigned char* wsz = ws; asm volatile("" : "+s"(wsz))
#define wHQ ((bf16*)(wsz + WS_HQ))
#define wHG ((float*)(wsz + WS_HG))
#define wHV ((bf16*)(wsz + WS_HV))
#define wHGATE ((bf16*)(wsz + WS_HGATE))
#define wLX ((float*)(wsz + WS_LX))
#define wLGATE ((bf16*)(wsz + WS_LGATE))
#define wCQ ((bf16*)(wsz + WS_CQ))
#define wCK ((bf16*)(wsz + WS_CK))
#define wCV ((bf16*)(wsz + WS_CV))
#define wCGATE ((bf16*)(wsz + WS_CGATE))
#define wMG ((unsigned char*)(wsz + WS_MG))
#define wCLR ((float*)(wsz + WS_CLR))
#define wY ((bf16*)(wsz + WS_Y))
#define wOC ((bf16*)(wsz + WS_OC))
#define wSSQ ((float*)(wsz + WS_SSQ))
#define wGL ((float*)(wsz + WS_MERGED))
#define wMB ((bf16*)(wsz + WS_MB))
#define wOUT ((bf16*)(wsz + WS_OUT))
__global__ void __launch_bounds__(NTHR, 2) mega(Args args) {
    extern __shared__ __attribute__((aligned(16))) unsigned char lds_raw[];
    LAS unsigned char* lds = (LAS unsigned char*)lds_raw;
    const int wave = __builtin_amdgcn_readfirstlane((int)threadIdx.x >> 6);
#define tid ((int)threadIdx.x)
#define lane ((int)(threadIdx.x & 63u))
    const int G = gridDim.x, bx = blockIdx.x;
    const int gw = bx * NWAVES + wave, NGW = G * NWAVES;
#define chain (gridDim.x == 256u)
#define MM (chain ? MP : MT)
    unsigned char* ws = args.ws;
    volatile LAS unsigned* MISC = (volatile LAS unsigned*)(lds + MISC_OFF);
    if (tid < 64) MISC[tid] = 0u;
    __syncthreads();
    XcdBarrier bar; bar.bar = (unsigned*)(ws + WS_CTL) + CW_BAR; bar.x = 0; bar.st = nullptr;
    if (args.use_bar) bar = xcd_barrier_post((unsigned*)(ws + WS_CTL) + CW_BAR, MISC);
    const int lo = args.ph_lo, hi = args.ph_hi;
#define IN(k) (lo <= (k) && (k) < hi)
#define SEAM(k) do { if (IN(k) && IN((k) + 1)) xcd_barrier(bar); } while (0)
    const float* xp = args.in[I_XP]; const float* xs = args.in[I_XS];
    bf16* Z = (bf16*)(ws + WS_Z);
    bf16* X1 = (bf16*)(ws + WS_X1);

    for (int rep_ = 0; rep_ < REP_P0; ++rep_) if (IN(0) && (PHM & 64)) {
        { int lz = lane, gz = gw; asm volatile("" : "+v"(lz), "+s"(gz));
          convert_items(lds, args.in[I_WIN], args.in[I_WBR], args.in[I_WOU], ws, 0, 0, CV_IN, gz, NGW, lz); }
        norm_rows(xp, xs, args.in[I_NPRE], Z, ws + WS_Z8, gw, NGW, lane);
        __syncthreads();
    }
    SEAM(0);
    for (int l = 0; l < 2; ++l) {
        const int pb = 1 + 7 * l;
        for (int rp_ = 0; rp_ < REP_IN; ++rp_) if (IN(pb) && (PHM & 1)) { WSZ();
            const NoDrain<EpiInProj> E{{wHQ, wHV, wHGATE, wLGATE, wCQ, wCK, wCV, wCGATE, wMG, wHG, wLX, wCLR, args.in[I_LBL], l, 0.015625f}};
            { pg8::Gemm g{Z, (const bf16*)(ws + WS_WIN + l * SZ_WIN), MT, NIN, DM, DM, DM}; int bz = bx; asm volatile("" : "+s"(bz)); InOrderA SA; SA.S.init(MT, 73 * 256, G, bz);
              af4 acc[2][2][4][2]; zero_acc(acc); pg8::gemm_phase<NoDrain<EpiInProj>, InOrderA, GEMM_ALIGN, GEMM_SP2, false>(lds, g, SA, E, acc); }
            { pg8::Gemm g{(const bf16*)(ws + WS_Z8), (const bf16*)(ws + WS_W8 + l * SZ_W8) - (size_t)72 * 256 * 2048, MT, 12288, 2048, 2048, 2048}; InOrder8 S8; int bz = bx; asm volatile("" : "+s"(bz)); S8.S.init(MT, 48 * 256, G, G == 256 ? ((bz + 48) & 255) : bz);
              af4 acc[2][2][4][2]; zero_acc(acc); pg8::gemm_phase<NoDrain<EpiInProj>, InOrder8, GEMM_ALIGN, GEMM_SP2, true>(lds, g, S8, E, acc); }
            if (G == 256) { if (bx >= 105 && bx < 208) { int lz = lane; asm volatile("" : "+v"(lz)); convert_items(lds, args.in[I_WIN], args.in[I_WBR], args.in[I_WOU], ws, l, CV_IN, CV_L, (bx - 105) * NWAVES + wave, 103 * NWAVES, lz); } }
            else { int lz = lane; asm volatile("" : "+v"(lz)); convert_items(lds, args.in[I_WIN], args.in[I_WBR], args.in[I_WOU], ws, l, CV_IN, CV_L, bx * NWAVES + wave, G * NWAVES, lz); }
        }
        SEAM(pb);
        if (!chain) {
            if (IN(pb + 1)) { WSZ();
                const GPrep P{wCQ, wCK, wCLR, args.in[I_W2] + (size_t)l * 16 * 1024, args.in[I_B2] + l * 1024, (bf16*)(wsz + WS_GQT), (bf16*)(wsz + WS_GKT), (bf16*)(wsz + WS_GKH), (float*)(wsz + WS_GER), (float*)(wsz + WS_GEB)};
                for (int it = bx; it < NCHK * 4; it += G) gla_prep(lds, tid, P, it >> 2, it & 3);
            }
            SEAM(pb + 1);
        }
        for (int rep_ = 0; rep_ < REP_SCAN; ++rep_) if (IN(pb + 2) && (PHM & 2)) { WSZ();
            constexpr int NLONG = 192;
            const bool split = G > NLONG;
            const int mytype = split ? (bx < NLONG ? bx / 64 : -1) : -2;
            const int sw = bx - NLONG, nsw = G - NLONG;
            if (chain && mytype != 2) {
                const GPrep P{wCQ, wCK, wCLR, args.in[I_W2] + (size_t)l * 16 * 1024, args.in[I_B2] + l * 1024, (bf16*)(wsz + WS_GQT), (bf16*)(wsz + WS_GKT), (bf16*)(wsz + WS_GKH), (float*)(wsz + WS_GER), (float*)(wsz + WS_GEB)};
                for (int it = (bx < 128 ? bx : bx - 64); it < NCHK * 4; it += 192) gla_prep(lds, tid, P, it >> 2, it & 3);
                if (mytype == 1) team_arrive((unsigned*)(ws + WS_CTL) + CW_TEAM + 2048 + l * 64 + rep_ * 16);
                else team_barrier((unsigned*)(ws + WS_CTL) + CW_TEAM + 2048 + l * 64 + rep_ * 16, 192u);
            }
#define JOB_RANGE(TYPE, j0, j1, js) int j0, j1, js; \
            if (mytype == -2) { j0 = bx; j1 = 192; js = G; } else if (mytype == (TYPE)) { j0 = bx - 64 * (TYPE); j1 = j0 + 1; js = 1; } else if (mytype == -1) { j0 = 64 + sw; j1 = 192; js = nsw; } else { j0 = 0; j1 = 0; js = 1; }
#define JOB_DECODE(idx) const int seq = (idx) < 64 ? (idx) / 16 : 4 + ((idx) - 64) / 16; const int sub = (idx) % 16; const bool smp = seq >= 4; const int sb = smp ? seq - 4 : seq; \
            const int row0 = smp ? MP + sb * 32 : sb * 2048, T = smp ? 32 : 2048;
            for (int rj_ = 0; rj_ < REP_J0; ++rj_) if (JOBM & 1) { JOB_RANGE(0, j0, j1, js)
                for (int idx = j0; idx < j1; idx += js) { JOB_DECODE(idx)
                    const int hd = sub >> 2, sl = sub & 3;
                    GArgs A; A.QT = (const bf16*)(wsz + WS_GQT) + hd * 256; A.KT = (const bf16*)(wsz + WS_GKT) + hd * 256; A.KH = (const bf16*)(wsz + WS_GKH) + (size_t)hd * 256 * 64;
                    A.ER = (const float*)(wsz + WS_GER) + hd * 256; A.EB = (const float*)(wsz + WS_GEB) + hd * 256; A.ci0 = smp ? 128 + sb : sb * 32;
                    A.V = wCV + hd * 512 + sl * 128; A.row0 = row0; A.T = T;
                    const size_t so = ((size_t)hd * 256) * 512 + sl * 128;
                    A.S0 = smp ? args.in[I_SGL] + ((size_t)l * 8 + sb) * 4 * 256 * 512 + so : nullptr;
                    A.S1 = args.out + (smp ? O_GLS + ((size_t)l * 8 + sb) * 4 * 256 * 512 : O_GLP + ((size_t)l * 4 + sb) * 4 * 256 * 512) + so; A.lds = 512;
                    A.OA = wOC + BW + hd * 512 + sl * 128; A.SSQ = wSSQ + 16 + hd * 4 + sl;
                    gla_job(lds, tid, A);
                    __syncthreads(); } }
            for (int rj_ = 0; rj_ < REP_J1; ++rj_) if (JOBM & 2) { JOB_RANGE(1, j0, j1, js)
                for (int idx = j0; idx < j1; idx += js) { JOB_DECODE(idx)
                    const int h = sub;
                    LaArgs A; A.Q = wHQ + h * 128; A.ldq = BW; A.G = wHG + h * 128; A.ldg = BW; A.K = nullptr;
                    A.V = wHV + h * 128; A.row0 = row0; A.T = T;
                    A.S0 = smp ? args.in[I_SHG] + (((size_t)l * 8 + sb) * 16 + h) * 16384 : nullptr;
                    A.S1 = args.out + (smp ? O_HGS + (((size_t)l * 8 + sb) * 16 + h) * 16384 : O_HGP + (((size_t)l * 4 + sb) * 16 + h) * 16384); A.lds = 128;
                    A.nw = args.in[I_HGN] + l * BW + h * 128; A.gate = wHGATE + h * 128; A.Y = wY + h * 128;
                    la_job<128, false>(lds, tid, A);
                    __syncthreads(); } }
            for (int rj_ = 0; rj_ < REP_J2; ++rj_) if (JOBM & 4) { JOB_RANGE(2, j0, j1, js)
                for (int idx = j0; idx < j1; idx += js) { JOB_DECODE(idx)
                    const int hb = sub;
                    LruArgs A; A.LX = wLX + hb * 128; A.row0 = row0; A.T = T;
                    A.cst = smp ? args.in[I_SLC] + ((size_t)l * 8 + sb) * 3 * BW + hb * 128 : nullptr;
                    A.h0 = smp ? args.in[I_SLH] + ((size_t)l * 8 + sb) * BW + hb * 128 : nullptr;
                    A.cw = args.in[I_CW] + (size_t)l * 4 * BW + hb * 128; A.cb = args.in[I_CB] + l * BW + hb * 128;
                    A.wa = args.in[I_WA] + ((size_t)l * 16 + hb) * 16384; A.ba = args.in[I_BA] + l * BW + hb * 128;
                    A.wx = args.in[I_WX] + ((size_t)l * 16 + hb) * 16384; A.bx = args.in[I_BX] + l * BW + hb * 128;
                    A.lam = args.in[I_LAM] + l * BW + hb * 128; A.lgate = wLGATE + hb * 128; A.Y = wY + BW + hb * 128;
                    A.newh = args.out + (smp ? O_LHS + ((size_t)l * 8 + sb) * BW : O_LHP + ((size_t)l * 4 + sb) * BW) + hb * 128;
                    A.newconv = args.out + (smp ? O_LCS + ((size_t)l * 8 + sb) * 3 * BW : O_LCP + ((size_t)l * 4 + sb) * 3 * BW) + hb * 128;
                    lru_job(lds, tid, A);
                    __syncthreads(); } }
            if (chain && bx >= 192) {
                const int sw = bx - 192;
                unsigned* tb = (unsigned*)(ws + WS_CTL) + CW_TEAM + (l * 4) * 64 + rep_ * 16;
                team_barrier(tb, 64u);
                mix_fix_rows(wOC, wSSQ, args.in[I_HGN] + l * BW, wHGATE, args.in[I_GLN] + l * BW, wCGATE, wY, MP, MT, sw * NWAVES + wave, 64 * NWAVES, lane);
                team_barrier(tb + 64, 64u);
                if (sw < 48) {
                    const int pn = sw / 3, seg = sw - 3 * pn;
                    const FixedUnit FU{pg8::Unit{MP / 256, pn}};
                    af4 acc[2][2][4][2]; zero_acc(acc); const bf16* WB = (const bf16*)(ws + WS_WBR + l * SZ_WBR);
                    pg8::Gemm g{wY + seg * BW, WB + seg * BW, MT, DM, BW, KBR, KBR}; EpiGateSlab E{wMG, (float*)(wsz + WS_PB), seg};
                    pg8::gemm_phase<EpiGateSlab, FixedUnit, false, GEMM_SP2>(lds, g, FU, E, acc);
                }
                team_barrier(tb + 128, 64u);
                sum_slabs_rows((const float*)(wsz + WS_PB), wMB, sw * NWAVES + wave, 64 * NWAVES, lane);
                team_barrier(tb + 192, 64u);
                {
                    const int pn = sw >> 2, kq = sw & 3;
                    const FixedUnit FU{pg8::Unit{MP / 256, pn}};
                    af4 acc[2][2][4][2]; zero_acc(acc);
                    pg8::Gemm g{wMB + kq * 1024, (const bf16*)(ws + WS_WOU + l * SZ_WOU) + kq * 1024, MT, DM, 1024, DM, DM};
                    EpiF32 E{(float*)(wsz + WS_PO) + (size_t)kq * 256 * DM - (size_t)MP * DM, DM};
                    pg8::gemm_phase<EpiF32, FixedUnit, false, GEMM_SP2>(lds, g, FU, E, acc);
                }
                if (l == 0) {
                    int lz = lane; asm volatile("" : "+v"(lz));
                    convert_items(lds, args.in[I_WIN], args.in[I_WBR], args.in[I_WOU], ws, 1, 0, CVX, sw * NWAVES + wave, 64 * NWAVES, lz);
                }
            }
        }
        SEAM(pb + 2);
        for (int rp_ = 0; rp_ < REP_FIN; ++rp_) if (IN(pb + 3) && (PHM & 4)) { WSZ(); mix_fix_rows(wOC, wSSQ, args.in[I_HGN] + l * BW, wHGATE, args.in[I_GLN] + l * BW, wCGATE, wY, 0, MM, gw, NGW, lane); }
        SEAM(pb + 3);
        for (int rp_ = 0; rp_ < REP_BR; ++rp_) if (IN(pb + 4) && (PHM & 8)) { WSZ();
            const bf16* WB = (const bf16*)(ws + WS_WBR + l * SZ_WBR);
            BranchOrder BO; BO.S.init(MM, DM, G, bx);
            { af4 acc[2][2][4][2]; zero_acc(acc); pg8::Gemm g{wY, WB, MT, DM, BW, KBR, KBR}; const NoDrain<EpiBranchSeg> E{{wMG, wMB, 0}};
              pg8::gemm_phase<NoDrain<EpiBranchSeg>, BranchOrder, GEMM_ALIGN, GEMM_SP2>(lds, g, BO, E, acc); }
            if (l == 0) tail_convert(lds, args.in[I_WIN], args.in[I_WBR], args.in[I_WOU], ws, 1, chain ? CVX : 0, CV_IN, (MM / 256) * (DM / 256), G, bx, wave, lane);
        }
        SEAM(pb + 4);
        for (int rp_ = 0; rp_ < REP_OUT; ++rp_) if (IN(pb + 5) && (PHM & 16)) { WSZ();
            pg8::Gemm g{wMB, (const bf16*)(ws + WS_WOU + l * SZ_WOU), MT, DM, DM, DM, DM}; pg8::StaticOrder S; S.init(MM, DM, G, bx);
            EpiBf E{wOUT, DM}; if (GEMM_STREAM & 2) gemm_stream<EpiBf>(lds, g, S, E); else gemm_units<EpiBf>(lds, g, S, E);
        }
        SEAM(pb + 5);
        for (int rp_ = 0; rp_ < REP_FIN; ++rp_) if (IN(pb + 6) && (PHM & 32)) { WSZ();
            if (l == 0) final_rows<false, true>(xp, xs, wOUT, chain ? (const float*)(wsz + WS_PO) : nullptr, args.in[I_NPOST], X1, args.in[I_NPRE] + DM, Z, ws + WS_Z8, gw, NGW, lane);
            else        final_rows<true, false>(X1, X1 + (size_t)MP * DM, wOUT, chain ? (const float*)(wsz + WS_PO) : nullptr, args.in[I_NPOST] + DM, args.out, nullptr, nullptr, nullptr, gw, NGW, lane);
        }
        if (l == 0) SEAM(pb + 6);
    }
}

#undef tid
#undef lane
#undef chain
#undef MM
#ifndef PHM
#define PHM 127
#endif
#ifndef N_LAUNCH_MODE
#define N_LAUNCH_MODE 0
#endif
extern "C" void kernel_launch(void* const* d_in, const int* in_sizes, int n_in, void* d_out, int out_size, void* d_ws, size_t ws_size, hipStream_t stream) {
    static int grid = 0;
    if (grid == 0) {
        if (n_in != 23 || (size_t)out_size != O_END || ws_size < WS_END) { fprintf(stderr, "kernel_launch: unexpected shapes (n_in %d out %d ws %zu need %zu)\n", n_in, out_size, ws_size, (size_t)WS_END); grid = -1; return; }
        int dev = 0, cus = 0, per_cu = 0;
        if (hipGetDevice(&dev) != hipSuccess || hipDeviceGetAttribute(&cus, hipDeviceAttributeMultiprocessorCount, dev) != hipSuccess) { grid = -1; return; }
        if (hipFuncSetAttribute((const void*)mega, hipFuncAttributeMaxDynamicSharedMemorySize, LDS_BYTES) != hipSuccess) { fprintf(stderr, "kernel_launch: hipFuncSetAttribute failed\n"); grid = -1; return; }
        if (hipOccupancyMaxActiveBlocksPerMultiprocessor(&per_cu, (const void*)mega, NTHR, LDS_BYTES) != hipSuccess || per_cu < 1) { fprintf(stderr, "kernel_launch: occupancy query says %d\n", per_cu); grid = -1; return; }
        grid = cus;
    }
    if (grid < 0) return;
    hipMemsetAsync((char*)d_ws + WS_CTL, 0, CTL_ZERO_BYTES, stream);
    Args a{};
    for (int i = 0; i < 23; ++i) a.in[i] = (const float*)d_in[i];
    a.out = (float*)d_out; a.ws = (unsigned char*)d_ws; a.pad = 0;
#if N_LAUNCH_MODE == 1
    a.ph_lo = 0; a.ph_hi = NPHASE; a.use_bar = 1;
    hipLaunchKernelGGL(mega, dim3(grid), dim3(NTHR), LDS_BYTES, stream, a);
#else
    for (int p = 0; p < NPHASE; ++p) { a.ph_lo = p; a.ph_hi = p + 1; a.use_bar = 0; hipLaunchKernelGGL(mega, dim3(grid), dim3(NTHR), LDS_BYTES, stream, a); }
#endif
}
```
